# Optimizing an MI355X kernel written in HIP

```python
import math
import jax, jax.numpy as jnp
from jax import lax
import numpy as np

D_MODEL = 2048
BATCH = 8
SEQ = 4096
DEPTH = 4

N_MIXERS = 3
N_SC = (DEPTH + 2) // 3
N_HY = (DEPTH + 1) // 3
N_MLA = DEPTH // 3
EPS = 1e-6

CONV_WIDTH = 3

HY_EMB = 33
HY_BANDS = (HY_EMB - 1) // 2
HY_FH = 64
HY_N_HID = 2
HY_FAST_DECAY = 0.3
HY_SLOW_DECAY = 1.5
HY_TARGET = 1e-2
HY_OUT_SCALE = 0.1

MLA_HEADS = D_MODEL // 128
Q_RANK = D_MODEL // 4
KV_RANK = D_MODEL // 4
D_NOPE = 128
D_ROPE = 64
D_V = 128
D_QK = D_NOPE + D_ROPE
ROPE_THETA = 10000.0
Q_BLOCK = 128

N_GROUPS = 8
EXPERTS_PER_GROUP = 4
N_EXPERTS = N_GROUPS * EXPERTS_PER_GROUP
TOP_K = 2
D_FF_EXPERT = D_MODEL // 4
MOE_BLOCK = 128

kernel_name = "hybrid_conv_hyena_mla_hiermoe_encoder"


def rms_norm(x, g):
    x32 = x.astype(jnp.float32)
    y = x32 * lax.rsqrt(jnp.mean(x32 * x32, axis=-1, keepdims=True) + EPS)
    return (y * g.astype(jnp.float32)).astype(x.dtype)


def centred_conv3(x, w):
    xp = jnp.pad(x, ((0, 0), (1, 1), (0, 0)))
    return xp[:, :-2] * w[0] + xp[:, 1:-1] * w[1] + xp[:, 2:] * w[2]


def short_conv_mixer(x, w_in, conv_w, w_out):
    bcx = x @ w_in
    b_gate, c_gate, xv = jnp.split(bcx, 3, axis=-1)
    y = b_gate * centred_conv3(c_gate * xv, conv_w)
    return y @ w_out


def hyena_filters(L, f_w1, f_b1, f_w_hid, f_b_hid, f_freq, f_w_out):
    f32 = jnp.float32
    t = jnp.linspace(0.0, 1.0, L, dtype=f32)[:, None]
    bands = jnp.linspace(1e-4, HY_BANDS - 1, HY_BANDS, dtype=f32)[None]
    w = 2.0 * math.pi * jnp.arange(L, dtype=f32)[:, None] / L
    z = jnp.concatenate([t, jnp.cos(bands * w), -jnp.sin(bands * w)], axis=-1)
    freq = f_freq.astype(f32)
    h = jnp.sin(freq[0] * (z @ f_w1.astype(f32) + f_b1.astype(f32)))
    for l in range(HY_N_HID):
        h = jnp.sin(freq[l + 1] * (h @ f_w_hid[l].astype(f32) + f_b_hid[l].astype(f32)))
    h = h @ f_w_out.astype(f32)
    d = h.shape[-1] // 2
    max_decay = math.log(HY_TARGET) / HY_FAST_DECAY
    min_decay = math.log(HY_TARGET) / HY_SLOW_DECAY
    deltas = jnp.abs(jnp.linspace(min_decay, max_decay, d, dtype=f32))
    decay = jnp.exp(-t * deltas[None])
    h = h.reshape(L, 2, d) * decay[:, None, :]
    return h[:, 0], h[:, 1]


def hyena_mixer(x, w_in, conv_w, conv_b, f_w1, f_b1, f_w_hid, f_b_hid, f_freq, f_w_out, skip, w_out):
    L = x.shape[1]
    u = centred_conv3(x @ w_in, conv_w) + conv_b
    x0, x1, v = jnp.split(u, 3, axis=-1)
    v = v * x1
    h_fwd, h_bwd = hyena_filters(L, f_w1, f_b1, f_w_hid, f_b_hid, f_freq, f_w_out)
    kern = jnp.concatenate([h_fwd, jnp.zeros_like(h_fwd[:1]), h_bwd[:0:-1]], axis=0)
    v32 = v.astype(jnp.float32)
    y = jnp.fft.irfft(jnp.fft.rfft(v32, n=2 * L, axis=1) * jnp.fft.rfft(kern, axis=0)[None],
                      n=2 * L, axis=1)[:, :L]
    y = (y + v32 * skip.astype(jnp.float32)).astype(x.dtype)
    return (y * x0) @ w_out


def rope_tables(L):
    inv = ROPE_THETA ** (-jnp.arange(0, D_ROPE, 2, dtype=jnp.float32) / D_ROPE)
    ang = jnp.arange(L, dtype=jnp.float32)[:, None] * inv[None]
    return jnp.cos(ang), jnp.sin(ang)


def apply_rope(x, cos, sin):
    x1, x2 = jnp.split(x, 2, axis=-1)
    c, s = cos[None, :, None, :], sin[None, :, None, :]
    return jnp.concatenate([x1 * c - x2 * s, x2 * c + x1 * s], axis=-1).astype(x.dtype)


def dense_attention(q, k, v):
    B_, L, H, dk = q.shape
    scale = dk ** -0.5
    qb = q.reshape(B_, L // Q_BLOCK, Q_BLOCK, H, dk).transpose(1, 0, 2, 3, 4)

    def one_block(q_blk):
        s = jnp.einsum('bqhd,bkhd->bhqk', q_blk, k).astype(jnp.float32) * scale
        p = jax.nn.softmax(s, axis=-1).astype(v.dtype)
        return jnp.einsum('bhqk,bkhd->bqhd', p, v)

    o = lax.map(one_block, qb)
    return o.transpose(1, 0, 2, 3, 4).reshape(B_, L, H, v.shape[-1])


def mla_mixer(x, w_down, q_norm, kv_norm, w_uq, w_ukv, q_gain, k_gain, w_o):
    B_, L, _ = x.shape
    down = x @ w_down
    c_q = rms_norm(down[..., :Q_RANK], q_norm)
    c_kv = rms_norm(down[..., Q_RANK:Q_RANK + KV_RANK], kv_norm)
    k_rope = down[..., Q_RANK + KV_RANK:]
    q = (c_q @ w_uq).reshape(B_, L, MLA_HEADS, D_QK)
    kv = (c_kv @ w_ukv).reshape(B_, L, MLA_HEADS, D_NOPE + D_V)
    k_nope, v = kv[..., :D_NOPE], kv[..., D_NOPE:]
    k = jnp.concatenate([k_nope, jnp.broadcast_to(k_rope[:, :, None, :], (B_, L, MLA_HEADS, D_ROPE))], axis=-1)
    q = rms_norm(q, q_gain)
    k = rms_norm(k, k_gain)
    cos, sin = rope_tables(L)
    q = jnp.concatenate([q[..., :D_NOPE], apply_rope(q[..., D_NOPE:], cos, sin)], axis=-1)
    k = jnp.concatenate([k[..., :D_NOPE], apply_rope(k[..., D_NOPE:], cos, sin)], axis=-1)
    o = dense_attention(q, k, v)
    return o.reshape(B_, L, MLA_HEADS * D_V) @ w_o


def hier_moe(x, w_group, b_group, w_expert, b_expert, w_up, w_down):
    B_, L, D_ = x.shape
    xf = x.reshape(-1, D_)
    N = xf.shape[0]
    f32 = jnp.float32
    x32 = xf.astype(f32)
    tok = jnp.arange(N)
    g_logits = x32 @ w_group.astype(f32) + b_group.astype(f32)
    g_prob = jax.nn.softmax(g_logits, axis=-1)
    g_sel = jnp.argmax(g_logits, axis=-1).astype(jnp.int32)
    e_logits = (x32 @ w_expert.astype(f32) + b_expert.astype(f32)).reshape(N, N_GROUPS, EXPERTS_PER_GROUP)
    e_in = e_logits[tok, g_sel]
    top_val, top_idx = lax.top_k(e_in, TOP_K)
    gate = g_prob[tok, g_sel][:, None] * jax.nn.softmax(top_val, axis=-1)
    expert_id = g_sel[:, None] * EXPERTS_PER_GROUP + top_idx.astype(jnp.int32)

    A = N * TOP_K
    flat_e = expert_id.reshape(A)
    flat_tok = jnp.repeat(jnp.arange(N, dtype=jnp.int32), TOP_K)
    flat_w = gate.reshape(A)
    order = jnp.argsort(flat_e)
    sorted_e = flat_e[order]
    counts = jnp.bincount(flat_e, length=N_EXPERTS)
    starts = jnp.cumsum(counts) - counts
    padded = (counts + MOE_BLOCK - 1) // MOE_BLOCK * MOE_BLOCK
    pend = jnp.cumsum(padded)
    pstart = pend - padded
    dest = pstart[sorted_e] + (jnp.arange(A) - starts[sorted_e])
    n_rows = A + N_EXPERTS * MOE_BLOCK
    n_blocks = n_rows // MOE_BLOCK
    row_tok = jnp.zeros((n_rows,), jnp.int32).at[dest].set(flat_tok[order])
    row_w = jnp.zeros((n_rows,), f32).at[dest].set(flat_w[order])
    block_e = jnp.minimum(jnp.searchsorted(pend, jnp.arange(n_blocks) * MOE_BLOCK, side='right'),
                          N_EXPERTS - 1)

    def expert_block(args):
        tok_b, e = args
        xb = xf[tok_b]
        hg, hu = jnp.split(xb @ w_up[e], 2, axis=-1)
        return (jax.nn.silu(hg) * hu) @ w_down[e]

    y_rows = lax.map(expert_block, (row_tok.reshape(n_blocks, MOE_BLOCK), block_e)).reshape(n_rows, D_)
    y_rows = y_rows * row_w[:, None].astype(y_rows.dtype)
    out = jax.ops.segment_sum(y_rows, row_tok, num_segments=N)
    return out.reshape(B_, L, D_)


def setup_inputs(seed: int = 0) -> dict:
    key = jax.random.key(seed)
    ks = iter(jax.random.split(key, 64))
    D = D_MODEL

    def nrm(shape, scale):
        return jax.random.normal(next(ks), shape, jnp.float32) * scale

    def gain(shape):
        return 1.0 + nrm(shape, 0.01)

    return {
        "x": nrm((BATCH, SEQ, D), 1.0),
        "norm_mix": gain((DEPTH, D)),
        "norm_ffn": gain((DEPTH, D)),
        "sc_w_in": nrm((N_SC, D, 3 * D), D ** -0.5),
        "sc_conv_w": nrm((N_SC, CONV_WIDTH, D), CONV_WIDTH ** -0.5),
        "sc_w_out": nrm((N_SC, D, D), D ** -0.5),
        "hy_w_in": nrm((N_HY, D, 3 * D), D ** -0.5),
        "hy_conv_w": nrm((N_HY, CONV_WIDTH, 3 * D), CONV_WIDTH ** -0.5),
        "hy_conv_b": nrm((N_HY, 3 * D), 0.01),
        "hy_filt_w1": nrm((N_HY, HY_EMB, HY_FH), HY_EMB ** -0.5),
        "hy_filt_b1": nrm((N_HY, HY_FH), 0.1),
        "hy_filt_w_hid": nrm((N_HY, HY_N_HID, HY_FH, HY_FH), HY_FH ** -0.5),
        "hy_filt_b_hid": nrm((N_HY, HY_N_HID, HY_FH), 0.1),
        "hy_filt_freq": gain((N_HY, HY_N_HID + 1, HY_FH)),
        "hy_filt_w_out": nrm((N_HY, HY_FH, 2 * D), HY_OUT_SCALE * HY_FH ** -0.5),
        "hy_skip": nrm((N_HY, D), 1.0),
        "hy_w_out": nrm((N_HY, D, D), D ** -0.5),
        "mla_w_down": nrm((N_MLA, D, Q_RANK + KV_RANK + D_ROPE), D ** -0.5),
        "mla_q_norm": gain((N_MLA, Q_RANK)),
        "mla_kv_norm": gain((N_MLA, KV_RANK)),
        "mla_w_uq": nrm((N_MLA, Q_RANK, MLA_HEADS * D_QK), Q_RANK ** -0.5),
        "mla_w_ukv": nrm((N_MLA, KV_RANK, MLA_HEADS * (D_NOPE + D_V)), KV_RANK ** -0.5),
        "mla_q_gain": gain((N_MLA, D_QK)),
        "mla_k_gain": gain((N_MLA, D_QK)),
        "mla_w_o": nrm((N_MLA, MLA_HEADS * D_V, D), (MLA_HEADS * D_V) ** -0.5),
        "router_w_group": nrm((DEPTH, D, N_GROUPS), D ** -0.5),
        "router_b_group": nrm((DEPTH, N_GROUPS), 0.01),
        "router_w_expert": nrm((DEPTH, D, N_EXPERTS), D ** -0.5),
        "router_b_expert": nrm((DEPTH, N_EXPERTS), 0.01),
        "moe_w_up": nrm((DEPTH, N_EXPERTS, D, 2 * D_FF_EXPERT), D ** -0.5),
        "moe_w_down": nrm((DEPTH, N_EXPERTS, D_FF_EXPERT, D), D_FF_EXPERT ** -0.5),
    }


def reference(x, norm_mix, norm_ffn,
              sc_w_in, sc_conv_w, sc_w_out,
              hy_w_in, hy_conv_w, hy_conv_b, hy_filt_w1, hy_filt_b1, hy_filt_w_hid, hy_filt_b_hid,
              hy_filt_freq, hy_filt_w_out, hy_skip, hy_w_out,
              mla_w_down, mla_q_norm, mla_kv_norm, mla_w_uq, mla_w_ukv, mla_q_gain, mla_k_gain, mla_w_o,
              router_w_group, router_b_group, router_w_expert, router_b_expert, moe_w_up, moe_w_down):
    for i in range(DEPTH):
        m = i % N_MIXERS
        j = i // N_MIXERS
        h = rms_norm(x, norm_mix[i])
        if m == 0:
            y = short_conv_mixer(h, sc_w_in[j], sc_conv_w[j], sc_w_out[j])
        elif m == 1:
            y = hyena_mixer(h, hy_w_in[j], hy_conv_w[j], hy_conv_b[j], hy_filt_w1[j], hy_filt_b1[j],
                            hy_filt_w_hid[j], hy_filt_b_hid[j], hy_filt_freq[j], hy_filt_w_out[j],
                            hy_skip[j], hy_w_out[j])
        else:
            y = mla_mixer(h, mla_w_down[j], mla_q_norm[j], mla_kv_norm[j], mla_w_uq[j], mla_w_ukv[j],
                          mla_q_gain[j], mla_k_gain[j], mla_w_o[j])
        x = x + y
        h = rms_norm(x, norm_ffn[i])
        x = x + hier_moe(h, router_w_group[i], router_b_group[i], router_w_expert[i], router_b_expert[i],
                         moe_w_up[i], moe_w_down[i])
    return x
```

```cpp
#include <hip/hip_runtime.h>
#include <cstdio>
#include <cstdint>

#define LAS __attribute__((address_space(3)))
#define GAS __attribute__((address_space(1)))
typedef unsigned short bf16;
typedef short bf16x8 __attribute__((ext_vector_type(8)));
typedef short s16x4 __attribute__((ext_vector_type(4)));
typedef float f32x4 __attribute__((ext_vector_type(4)));
typedef float f32x2 __attribute__((ext_vector_type(2)));
typedef float f32x16 __attribute__((ext_vector_type(16)));
typedef unsigned u32x4 __attribute__((ext_vector_type(4)));
typedef unsigned u32x2 __attribute__((ext_vector_type(2)));

constexpr int NTOK = 32768, DM = 2048, SEQ = 4096, NBATCH = 8;
constexpr int NH = 16, DQK = 192, DNOPE = 128, DROPE = 64, DV = 128, QRANK = 512, KVRANK = 512, NDOWN = 1088, NDOWNP = 1280;
constexpr int NEXP = 32, NGRP = 8, EPG = 4, DFF = 512;
constexpr int NTHREADS = 512, NWAVES = 8;
constexpr float EPS = 1e-6f;

constexpr size_t MiB = 1u << 20;
constexpr size_t WS_CTL = 0, CTL_ZERO_BYTES = 1 * MiB;
constexpr size_t WS_SCIN = 4 * MiB;
constexpr size_t WS_SCOUT = 52 * MiB;
constexpr size_t WS_HYIN = 68 * MiB;
constexpr size_t WS_HYOUT = 92 * MiB;
constexpr size_t WS_MDOWN = 100 * MiB;
constexpr size_t WS_MUQ = 106 * MiB;
constexpr size_t WS_MUKV = 109 * MiB;
constexpr size_t WS_MWO = 113 * MiB;
constexpr size_t WS_MOEUP = 128 * MiB;
constexpr size_t WS_MOEDN = 640 * MiB;
constexpr size_t WS_KERN = 896 * MiB;
constexpr size_t WS_H = 960 * MiB;
constexpr size_t WS_BIG = 1088 * MiB;
constexpr size_t WS_KVRAW = WS_BIG + 192 * MiB;
constexpr size_t WS_YB = 1600 * MiB;
constexpr size_t WS_X0 = 1728 * MiB;
constexpr size_t WS_VT = 1856 * MiB;
constexpr size_t WS_YST = 1984 * MiB;
constexpr size_t WS_DOWN = 2112 * MiB;
constexpr size_t WS_CQ = 2272 * MiB;
constexpr size_t WS_CKV = 2304 * MiB;
constexpr size_t WS_Q = 2336 * MiB;
constexpr size_t WS_K = 2528 * MiB;
constexpr size_t WS_LIST = 2720 * MiB;
constexpr size_t WS_GATE = 3064 * MiB;
constexpr size_t WS_ACT = 2726 * MiB;
constexpr size_t WS_YM = 2800 * MiB;
constexpr size_t WS_RSTD = 3068 * MiB;
constexpr size_t WS_WRS = 3058 * MiB;
constexpr size_t WS_ROPE = 3062 * MiB;
constexpr size_t WS_REC = 3072 * MiB;
constexpr size_t WS_END = 3092 * MiB;
constexpr int CW_CNT = 8192;
constexpr int CW_CNTB = 16384;
constexpr int CW_CVT = 40960;
constexpr int CW_BAR = 4096;

constexpr int SCR_BYTES = 131072;
constexpr int MISC_OFF = SCR_BYTES + 320;
constexpr int LDS_BYTES = 147456;

__device__ __forceinline__ unsigned f2bf(float f) { unsigned u = __builtin_bit_cast(unsigned, f); return (u + 0x7fffu + ((u >> 16) & 1u)) >> 16; }
__device__ __forceinline__ unsigned pk2(float lo, float hi) { unsigned r; asm("v_cvt_pk_bf16_f32 %0, %1, %2" : "=v"(r) : "v"(lo), "v"(hi)); return r; }
__device__ __forceinline__ float bf2f(unsigned short b) { return __builtin_bit_cast(float, ((unsigned)b) << 16); }
__device__ __forceinline__ float bflo(unsigned w) { return __builtin_bit_cast(float, w << 16); }
__device__ __forceinline__ float bfhi(unsigned w) { return __builtin_bit_cast(float, w & 0xffff0000u); }
__device__ __forceinline__ int opaque_i(int x) { asm volatile("" : "+v"(x)); return x; }
__device__ __forceinline__ int lane_mb() { int l; asm volatile("v_mbcnt_lo_u32_b32 %0, -1, 0\n\tv_mbcnt_hi_u32_b32 %0, -1, %0" : "=v"(l)); return l; }
#define TIDX opaque_i((wv_ << 6) | lane_mb())
__device__ __forceinline__ float wave_sum(float v) {
#pragma unroll
    for (int o = 1; o < 64; o <<= 1) v += __shfl_xor(v, o);
    return v;
}
__device__ __forceinline__ int crow(int r, int hi) { return (r & 3) + 8 * (r >> 2) + 4 * hi; }

#define XB_TMO      128
#define XB_XCNT(j)  (256  + 64 * (j))
#define XB_XSUB(j)  (1280 + 64 * (j))
#define XB_XGEN(j)  (2304 + 64 * (j))
#define XB_TOP      3328
#define XB_TOPGEN   3392
#define XCD_BAR_WORDS 3456
#define XB_SPIN_CAP (1u << 22)
__device__ __forceinline__ unsigned xb_ld(unsigned* p)              { return __hip_atomic_load(p, __ATOMIC_RELAXED, __HIP_MEMORY_SCOPE_AGENT); }
__device__ __forceinline__ unsigned xb_add(unsigned* p, unsigned v) { return __hip_atomic_fetch_add(p, v, __ATOMIC_RELAXED, __HIP_MEMORY_SCOPE_AGENT); }
__device__ __forceinline__ unsigned xb_xcc_id() { return (unsigned)__builtin_amdgcn_s_getreg((3 << 11) | 20) & 0xFu; }
#define XB_SPIN(cond, bar) do { unsigned _sp = 0; while (cond) { __builtin_amdgcn_s_sleep(1); \
    if ((++_sp & 255u) == 0u) { if (xb_ld(&(bar)[XB_TMO])) break; if (_sp > XB_SPIN_CAP) { atomicAdd(&(bar)[XB_TMO], 1u); break; } } } } while (0)
struct XcdBarrier { unsigned* bar; unsigned x; volatile LAS unsigned* st; };
__device__ __forceinline__ XcdBarrier xcd_barrier_post(const int wv_, unsigned* bar, volatile LAS unsigned* st) {
    XcdBarrier b; b.bar = bar; b.x = xb_xcc_id(); b.st = st;
    if (TIDX == 0) (void)xb_add(&bar[XB_XCNT(b.x)], 1u);
    return b;
}
__device__ __forceinline__ void xcd_barrier_complete(unsigned* bar, unsigned x, unsigned& nloc, unsigned& nx) {
    const unsigned G = gridDim.x * gridDim.y * gridDim.z;
    unsigned sum, cnt, mine, sp = 0u;
    for (;;) {
        sum = 0u; cnt = 0u; mine = 0u;
#pragma unroll
        for (unsigned j = 0; j < 16; ++j) { const unsigned c = xb_ld(&bar[XB_XCNT(j)]); sum += c; cnt += (c > 0u) ? 1u : 0u; mine = (j == x) ? c : mine; }
        if (sum == G) break;
        __builtin_amdgcn_s_sleep(1);
        if ((++sp & 255u) == 0u) { if (xb_ld(&bar[XB_TMO])) break; if (sp > XB_SPIN_CAP) { atomicAdd(&bar[XB_TMO], 1u); break; } }
    }
    nloc = mine > 0u ? mine : 1u; nx = cnt > 0u ? cnt : 1u;
}
__device__ __forceinline__ void xcd_barrier(const int wv_, const XcdBarrier& b) {
    asm volatile("s_waitcnt vmcnt(0)" ::: "memory");
    __syncthreads();
    if (TIDX == 0) {
        unsigned* bar = b.bar;
        __builtin_amdgcn_s_waitcnt(0);
        unsigned nloc = b.st[0], nx = b.st[1];
        if (nloc == 0u) { xcd_barrier_complete(bar, b.x, nloc, nx); b.st[0] = nloc; b.st[1] = nx; }
        const unsigned old = xb_add(&bar[XB_XSUB(b.x)], 1u);
        const unsigned gen = old / nloc;
        if (old + 1u == (gen + 1u) * nloc) {
            __builtin_amdgcn_fence(__ATOMIC_RELEASE, "agent");
            asm volatile("s_waitcnt vmcnt(0)" ::: "memory");
            const unsigned og = xb_add(&bar[XB_TOP], 1u);
            const unsigned tg = og / nx;
            if (og + 1u == (tg + 1u) * nx) xb_add(&bar[XB_TOPGEN], 1u);
            else XB_SPIN(xb_ld(&bar[XB_TOPGEN]) == tg, bar);
            __builtin_amdgcn_fence(__ATOMIC_ACQUIRE, "agent");
            xb_add(&bar[XB_XGEN(b.x)], 1u);
            asm volatile("s_waitcnt vmcnt(0)" ::: "memory");
        } else {
            XB_SPIN(xb_ld(&bar[XB_XGEN(b.x)]) == gen, bar);
            __builtin_amdgcn_fence(__ATOMIC_ACQUIRE, "agent");
            asm volatile("s_waitcnt vmcnt(0)" ::: "memory");
        }
    }
    __syncthreads();
}

constexpr int CV_CH = 8;
template <int MODE, bool GAIN = false, bool DYN = false>
__device__ __forceinline__ void cvt_mats(const float* W, int nmat, int K, int N, int NP, bf16* WT, LAS float* scr, int gw, int NGW, int lane, const float* gain = nullptr, int gms = 0, unsigned* ctr = nullptr) {
    const int nkb = K / 64, nnb = NP / 32, per = nkb * nnb; const long total = (long)nmat * per;
    f32x4 va[8], vb[8], vc[8]; size_t da = 0, db = 0, dc = 0; float ga[8], gb[8], gc[8];
#define CV_ISSUE(v_, d_, g_, it_) do { const long itx = (it_); if (itx < total) { \
        const int m = (int)(itx / per), r = (int)(itx % per), kb = r / nnb, nb = r % nnb, n0d = nb * 32; int n0s; \
        if (MODE == 2) { const int pn = n0d / 256, bj = (n0d / 128) & 1, i = n0d % 128; n0s = bj * 512 + 128 * pn + i; } \
        else if (MODE == 3) { if (n0d < DM) n0s = n0d; else { const int q = (n0d - DM) / 256, bj = ((n0d - DM) / 128) & 1, i = n0d % 128; n0s = DM + bj * DM + 128 * q + i; } } \
        else n0s = n0d < N ? n0d : -1; \
        d_ = (size_t)m * NP * K + (size_t)n0d * K + kb * 64; \
        if constexpr (GAIN) { _Pragma("unroll") for (int i = 0; i < 8; ++i) g_[i] = gain[m * gms + kb * 64 + (lane >> 3) + 8 * i]; } \
        if (n0s >= 0) { const float* src = W + (size_t)m * K * N + (size_t)(kb * 64 + (lane >> 3)) * N + n0s + (lane & 7) * 4; \
            _Pragma("unroll") for (int i = 0; i < 8; ++i) v_[i] = *(const f32x4*)(src + (size_t)(8 * i) * N); } \
        else { _Pragma("unroll") for (int i = 0; i < 8; ++i) v_[i] = (f32x4){0.f, 0.f, 0.f, 0.f}; } } } while (0)
#define CV_PROC(v_, d_, g_) do { \
        _Pragma("unroll") for (int i = 0; i < 8; ++i) { LAS float* d = scr + ((lane >> 3) + 8 * i) * 33 + (lane & 7) * 4; const f32x4 vv = GAIN ? v_[i] * g_[i] : v_[i]; d[0] = vv[0]; d[1] = vv[1]; d[2] = vv[2]; d[3] = vv[3]; } \
        asm volatile("s_waitcnt lgkmcnt(0)" ::: "memory"); \
        const int c = lane & 7; \
        _Pragma("unroll") for (int j = 0; j < 4; ++j) { const int n = (lane >> 3) + 8 * j; const LAS float* sp = scr + (8 * c) * 33 + n; \
            u32x4 o; o.x = pk2(sp[0 * 33], sp[1 * 33]); o.y = pk2(sp[2 * 33], sp[3 * 33]); o.z = pk2(sp[4 * 33], sp[5 * 33]); o.w = pk2(sp[6 * 33], sp[7 * 33]); \
            *(u32x4*)(WT + (d_) + (size_t)n * K + 8 * c) = o; } \
        asm volatile("s_waitcnt lgkmcnt(0)" ::: "memory"); } while (0)
    if constexpr (DYN) {
        long cur = 0, cend = 0;
#define CV_NEXT(dst_) do { if (cur >= cend) { unsigned b_ = 0; if (lane == 0) b_ = __hip_atomic_fetch_add(ctr, (unsigned)CV_CH, __ATOMIC_RELAXED, __HIP_MEMORY_SCOPE_AGENT); \
            b_ = __builtin_amdgcn_readfirstlane(b_); cur = b_; cend = cur + CV_CH; } dst_ = cur++; } while (0)
        long ia, ib, ic; CV_NEXT(ia); CV_NEXT(ib); CV_NEXT(ic);
        CV_ISSUE(va, da, ga, ia); CV_ISSUE(vb, db, gb, ib); CV_ISSUE(vc, dc, gc, ic);
        while (ia < total || ib < total || ic < total) {
            if (ia < total) { CV_PROC(va, da, ga); CV_NEXT(ia); CV_ISSUE(va, da, ga, ia); }
            if (ib < total) { CV_PROC(vb, db, gb); CV_NEXT(ib); CV_ISSUE(vb, db, gb, ib); }
            if (ic < total) { CV_PROC(vc, dc, gc); CV_NEXT(ic); CV_ISSUE(vc, dc, gc, ic); }
        }
#undef CV_NEXT
    } else {
    long it = gw;
    CV_ISSUE(va, da, ga, it); CV_ISSUE(vb, db, gb, it + NGW); CV_ISSUE(vc, dc, gc, it + 2L * NGW);
    while (it < total) {
        CV_PROC(va, da, ga); CV_ISSUE(va, da, ga, it + 3L * NGW);
        if (it + NGW < total) { CV_PROC(vb, db, gb); CV_ISSUE(vb, db, gb, it + 4L * NGW); }
        if (it + 2L * NGW < total) { CV_PROC(vc, dc, gc); CV_ISSUE(vc, dc, gc, it + 5L * NGW); }
        it += 3L * NGW;
    }
    }
#undef CV_ISSUE
#undef CV_PROC
}

__device__ __forceinline__ void filter_phase(const int wv_, const float* w1, const float* b1, const float* whid, const float* bhid, const float* freq, const float* wout, bf16* KRB, LAS unsigned char* lds) {
    LAS float* z = (LAS float*)lds;
    LAS float* ha = z + 16 * 33;
    LAS float* hb = ha + 16 * 64;
    LAS float* hc = hb + 16 * 64;
    const int tid = TIDX;
    for (int pb = blockIdx.x; pb < SEQ / 16; pb += gridDim.x) {
        const int l0 = pb * 16;
        __syncthreads();
        for (int i = tid; i < 16 * 33; i += NTHREADS) {
            const int p = i / 33, f = i % 33, l = l0 + p; float v;
            if (f == 0) v = (float)l / (float)(SEQ - 1);
            else { const int j = (f - 1) & 15; const float band = 1e-4f + (float)j * ((15.0f - 1e-4f) / 15.0f); const float w = 6.283185307179586f * (float)l / (float)SEQ; const float a = band * w;
                v = (f <= 16) ? cosf(a) : -sinf(a); }
            z[i] = v;
        }
        __syncthreads();
        for (int i = tid; i < 16 * 64; i += NTHREADS) { const int p = i >> 6, j = i & 63; float s = b1[j];
            for (int k = 0; k < 33; ++k) s += z[p * 33 + k] * w1[k * 64 + j];
            ha[i] = sinf(freq[j] * s); }
        __syncthreads();
        for (int i = tid; i < 16 * 64; i += NTHREADS) { const int p = i >> 6, j = i & 63; float s = bhid[j];
            for (int k = 0; k < 64; ++k) s += ha[p * 64 + k] * whid[k * 64 + j];
            hb[i] = sinf(freq[64 + j] * s); }
        __syncthreads();
        for (int i = tid; i < 16 * 64; i += NTHREADS) { const int p = i >> 6, j = i & 63; float s = bhid[64 + j];
            for (int k = 0; k < 64; ++k) s += hb[p * 64 + k] * whid[4096 + k * 64 + j];
            hc[j * 16 + p] = sinf(freq[128 + j] * s); }
        __syncthreads();
#pragma unroll 1
        for (int qh = 0; qh < 2; ++qh) {
        float acc[4][16];
#pragma unroll
        for (int q = 0; q < 4; ++q)
#pragma unroll
            for (int p = 0; p < 16; ++p) acc[q][p] = 0.f;
#pragma unroll 1
        for (int k0 = 0; k0 < 64; k0 += 2) { float w[2][4];
#pragma unroll
            for (int kk = 0; kk < 2; ++kk)
#pragma unroll
                for (int q = 0; q < 4; ++q) w[kk][q] = wout[(size_t)(k0 + kk) * 4096 + tid + NTHREADS * (qh * 4 + q)];
#pragma unroll
            for (int kk = 0; kk < 2; ++kk) { const LAS f32x4* hp = (const LAS f32x4*)(hc + (k0 + kk) * 16); const f32x4 h0 = hp[0], h1 = hp[1], h2 = hp[2], h3 = hp[3];
#pragma unroll
                for (int q = 0; q < 4; ++q) { const float wv = w[kk][q];
#pragma unroll
                    for (int p = 0; p < 4; ++p) { acc[q][p] += h0[p] * wv; acc[q][4 + p] += h1[p] * wv; acc[q][8 + p] += h2[p] * wv; acc[q][12 + p] += h3[p] * wv; } } } }
        LAS bf16* T = (LAS bf16*)(lds + 16384);
        __syncthreads();
#pragma unroll
        for (int q = 0; q < 4; ++q) {
            const int c = tid + NTHREADS * (qh * 4 + q), d = c & (DM - 1);
            const float mind = -3.0701134573253946f, maxd = -15.350567286626973f;
            const float delta = fabsf(mind + (float)d * ((maxd - mind) / (float)(DM - 1)));
            unsigned pk[8];
#pragma unroll
            for (int p = 0; p < 16; p += 2) { const float t0 = (float)(l0 + p) / (float)(SEQ - 1), t1 = (float)(l0 + p + 1) / (float)(SEQ - 1);
                pk[p >> 1] = f2bf(acc[q][p] * expf(-t0 * delta)) | (f2bf(acc[q][p + 1] * expf(-t1 * delta)) << 16); }
            *(LAS u32x4*)(T + (size_t)d * 16) = (u32x4){pk[0], pk[1], pk[2], pk[3]}; *(LAS u32x4*)(T + (size_t)d * 16 + 8) = (u32x4){pk[4], pk[5], pk[6], pk[7]};
        }
        __syncthreads();
        { const bool bwd = qh == 1;
            for (int e = tid; e < DM * 16; e += NTHREADS) { const int d = e >> 4, p = e & 15, l = l0 + p; const bf16 hv = T[e];
                const int m = bwd ? 4095 + l : 4095 - l;
                if (!bwd || l > 0) { KRB[(size_t)d * 8192 + m] = hv; if (m >= 1) KRB[(size_t)DM * 8192 + (size_t)d * 8192 + m - 1] = hv; } } }
        }
    }
}

template <bool COMBINE>
__device__ __forceinline__ void norm_phase(const int wv_, const float* xin, float* xout, const bf16* ym, const float* g, bf16* H) {
    const int tid = TIDX, lane = tid & 63, wid = wv_;
    constexpr int NR = 4;
    for (int rg = blockIdx.x * NWAVES + wid; rg < NTOK / NR; rg += gridDim.x * NWAVES) {
        f32x4 v[NR][8]; float rstd[NR];
#pragma unroll
        for (int r = 0; r < NR; ++r) { const size_t row = (size_t)rg * NR + r; float ss = 0.f;
#pragma unroll
            for (int j = 0; j < 8; ++j) { const int col = j * 256 + lane * 4; f32x4 x = *(const f32x4*)(xin + row * DM + col);
                if (COMBINE) { const u32x2 a = *(const u32x2*)(ym + row * DM + col);
                    x[0] += bflo(a.x); x[1] += bfhi(a.x); x[2] += bflo(a.y); x[3] += bfhi(a.y);
                    *(f32x4*)(xout + row * DM + col) = x; }
                v[r][j] = x; ss += x[0] * x[0] + x[1] * x[1] + x[2] * x[2] + x[3] * x[3]; }
            ss = wave_sum(ss); rstd[r] = 1.0f / sqrtf(ss * (1.0f / DM) + EPS); }
#pragma unroll
        for (int j = 0; j < 8; ++j) { const int col = j * 256 + lane * 4; const f32x4 gv = *(const f32x4*)(g + col);
#pragma unroll
            for (int r = 0; r < NR; ++r) { const size_t row = (size_t)rg * NR + r; const f32x4 x = v[r][j] * rstd[r] * gv;
                u32x2 o; o.x = pk2(x[0], x[1]); o.y = pk2(x[2], x[3]); *(u32x2*)(H + row * DM + col) = o; } }
    }
}

__device__ __forceinline__ void x0_phase(const int wv_, const float* xin, bf16* XBo, float* RSTD) {
    const int tid = TIDX, lane = tid & 63, wid = wv_;
    constexpr int NR = 4;
    for (int rg = blockIdx.x * NWAVES + wid; rg < NTOK / NR; rg += gridDim.x * NWAVES) {
        f32x4 v[NR][8];
#pragma unroll
        for (int r = 0; r < NR; ++r) { const size_t row = (size_t)rg * NR + r;
#pragma unroll
            for (int j = 0; j < 8; ++j) v[r][j] = *(const f32x4*)(xin + row * DM + j * 256 + lane * 4); }
#pragma unroll
        for (int r = 0; r < NR; ++r) { const size_t row = (size_t)rg * NR + r; float ss = 0.f;
#pragma unroll
            for (int j = 0; j < 8; ++j) { const f32x4 x = v[r][j]; ss += x[0] * x[0] + x[1] * x[1] + x[2] * x[2] + x[3] * x[3];
                u32x2 o; o.x = pk2(x[0], x[1]); o.y = pk2(x[2], x[3]); *(u32x2*)(XBo + row * DM + j * 256 + lane * 4) = o; }
            ss = wave_sum(ss); if (lane == 0) RSTD[row] = 1.0f / sqrtf(ss * (1.0f / DM) + EPS); }
    }
}

constexpr int RT_BUF = 96 * 512, RT_LSCR = 2 * RT_BUF;
__device__ __forceinline__ unsigned cvtpk_(float lo, float hi) { unsigned r; asm volatile("v_cvt_pk_bf16_f32 %0, %1, %2" : "=v"(r) : "v"(lo), "v"(hi)); return r; }
__device__ __forceinline__ void router_phase(const int wv_, const bf16* X, const bf16* WTs, const float* bg, const float* be,
                                             unsigned* cnt, unsigned* cntB, unsigned* list, u32x4* rec, LAS unsigned char* lds) {
    const int tid = TIDX, lane = tid & 63, wid = wv_, i16 = lane & 15, kq = lane >> 4;
    LAS float* lscr = (LAS float*)lds + wid * (16 * 48);
    LAS unsigned* lcnt = (LAS unsigned*)(lds + RT_LSCR + 8192); LAS unsigned* lbase = lcnt + 32; LAS unsigned* lcntB = lcnt + 64; LAS unsigned* lbaseB = lcnt + 128;
    if (tid < 32) lcnt[tid] = 0u;
    if (tid < 48) lcntB[tid] = 0u;
    const unsigned voffW = (unsigned)(((2 * wid + (lane >> 5)) * DM + (((lane & 31) ^ ((2 * wid + (lane >> 5)) & 7)) * 8)) * 2);
    const int s7 = i16 & 7, d64 = (s7 & 4) ? 64 : 0, rb0 = i16 * 512 + 16 * (kq ^ (s7 & 3)), rbE = rb0 + d64, rbO = rb0 - d64;
    for (int it = blockIdx.x; it < NTOK / 128; it += gridDim.x) {
        const size_t row = (size_t)it * 128 + wid * 16 + i16;
        const bf16* xp = X + row * DM + 8 * kq;
        f32x4 acc[3]; float ss = 0.f;
#pragma unroll
        for (int n = 0; n < 3; ++n) acc[n] = (f32x4){0.f, 0.f, 0.f, 0.f};
        u32x4 xa[4], xb[4];
#define RT_LOADX(dst, c, h) do { _Pragma("unroll") for (int ks = 0; ks < 4; ++ks) dst[ks] = *(const u32x4*)(xpc + (c) * 256 + ((h) * 4 + ks) * 32); } while (0)
#define RT_DMAW(c, buf) do { _Pragma("unroll") for (int i = 0; i < 6; ++i) \
        __builtin_amdgcn_global_load_lds((const unsigned*)(wpc + (size_t)(c) * 512 + (size_t)i * 16 * DM * 2), (LAS unsigned*)(lds + (buf) * RT_BUF + (i * 8 + wid) * 1024), 16, 0, 0); asm volatile("" ::: "memory"); } while (0)
#define RT_COMPUTE(xr, c, h, buf) do { _Pragma("unroll") for (int ks4 = 0; ks4 < 4; ++ks4) { const int ks = (h) * 4 + ks4; const u32x4 xh = xr[ks4]; \
            { const float q0 = bflo(xh.x), q1 = bfhi(xh.x), q2 = bflo(xh.y), q3 = bfhi(xh.y), q4 = bflo(xh.z), q5 = bfhi(xh.z), q6 = bflo(xh.w), q7 = bfhi(xh.w); \
              ss += q0 * q0 + q1 * q1 + q2 * q2 + q3 * q3 + q4 * q4 + q5 * q5 + q6 * q6 + q7 * q7; } \
            const bf16x8 ah = __builtin_bit_cast(bf16x8, xh); \
            _Pragma("unroll") for (int n = 0; n < 3; ++n) { const LAS unsigned char* wp = lds + (buf) * RT_BUF + n * 16 * 512 + ((ks & 1) ? rbO : rbE) + 64 * ks; \
                const bf16x8 bh = *(const LAS bf16x8*)wp, bl = *(const LAS bf16x8*)(wp + 48 * 512); \
                acc[n] = __builtin_amdgcn_mfma_f32_16x16x32_bf16(bh, ah, acc[n], 0, 0, 0); \
                acc[n] = __builtin_amdgcn_mfma_f32_16x16x32_bf16(bl, ah, acc[n], 0, 0, 0); } __builtin_amdgcn_sched_barrier(0); } } while (0)
        const bf16* xpc = xp; const char* wpc = (const char*)WTs + voffW;
        __syncthreads();
        RT_DMAW(0, 0); RT_LOADX(xa, 0, 0); RT_LOADX(xb, 0, 1);
        for (int c = 0; c < 8; c += 2) {
            asm volatile("s_waitcnt vmcnt(4)" ::: "memory"); __syncthreads();
            RT_DMAW(1, 1);
            RT_COMPUTE(xa, 0, 0, 0); RT_LOADX(xa, 1, 0);
            RT_COMPUTE(xb, 0, 1, 0); RT_LOADX(xb, 1, 1);
            asm volatile("s_waitcnt vmcnt(4)" ::: "memory"); __syncthreads();
            if (c + 2 < 8) RT_DMAW(2, 0);
            RT_COMPUTE(xa, 1, 0, 1); if (c + 2 < 8) RT_LOADX(xa, 2, 0);
            RT_COMPUTE(xb, 1, 1, 1); if (c + 2 < 8) RT_LOADX(xb, 2, 1);
            xpc += 512; wpc += 1024;
            asm volatile("" : "+v"(xpc));
        }
#undef RT_LOADX
#undef RT_DMAW
#undef RT_COMPUTE
        ss += __shfl_xor(ss, 16); ss += __shfl_xor(ss, 32);
        const float rstd = 1.0f / sqrtf(ss * (1.0f / DM) + EPS);
#pragma unroll
        for (int n = 0; n < 3; ++n)
#pragma unroll
            for (int j = 0; j < 4; ++j) lscr[i16 * 48 + n * 16 + kq * 4 + j] = acc[n][j] * rstd;
        asm volatile("s_waitcnt lgkmcnt(0)" ::: "memory");
        unsigned e1 = 0, e2 = 0, l1 = 0, l2 = 0, bk = 0, lB = 0, h1 = 0; float g1 = 0.f, g2 = 0.f;
        if (lane < 16) { const LAS float* lg = lscr + lane * 48;
            int gs = 0; float gl_[8]; gl_[0] = lg[0] + bg[0]; float gm = gl_[0];
            for (int j = 1; j < 8; ++j) { gl_[j] = lg[j] + bg[j]; if (gl_[j] > gm) { gm = gl_[j]; gs = j; } }
            float den = 0.f; for (int j = 0; j < 8; ++j) den += expf(gl_[j] - gm);
            const float gp = 1.0f / den;
            float el[4]; for (int i = 0; i < 4; ++i) el[i] = lg[8 + gs * 4 + i] + be[gs * 4 + i];
            int i1 = 0; for (int i = 1; i < 4; ++i) if (el[i] > el[i1]) i1 = i;
            int i2 = (i1 == 0) ? 1 : 0; for (int i = 0; i < 4; ++i) if (i != i1 && el[i] > el[i2]) i2 = i;
            const float ex = expf(el[i2] - el[i1]); const float p1 = 1.0f / (1.0f + ex), p2 = ex / (1.0f + ex);
            e1 = gs * 4 + i1; e2 = gs * 4 + i2; g1 = gp * p1; g2 = gp * p2;
            const int lo = i1 < i2 ? i1 : i2, hi = i1 < i2 ? i2 : i1, pidx = lo == 0 ? hi - 1 : (lo == 1 ? hi + 1 : 5);
            bk = gs * 6 + pidx; h1 = (i1 == hi) ? 1u : 0u;
            l1 = __hip_atomic_fetch_add(lcnt + e1, 1u, __ATOMIC_RELAXED, __HIP_MEMORY_SCOPE_WORKGROUP);
            l2 = __hip_atomic_fetch_add(lcnt + e2, 1u, __ATOMIC_RELAXED, __HIP_MEMORY_SCOPE_WORKGROUP);
            lB = __hip_atomic_fetch_add(lcntB + bk, 1u, __ATOMIC_RELAXED, __HIP_MEMORY_SCOPE_WORKGROUP); }
        __syncthreads();
        if (tid < 32) { const unsigned c = lcnt[tid]; lbase[tid] = c ? __hip_atomic_fetch_add(cnt + tid * 64, c, __ATOMIC_RELAXED, __HIP_MEMORY_SCOPE_AGENT) : 0u; }
        else if (tid >= 64 && tid < 112) { const unsigned b = tid - 64, c = lcntB[b]; lbaseB[b] = c ? __hip_atomic_fetch_add(cntB + b * 64, c, __ATOMIC_RELAXED, __HIP_MEMORY_SCOPE_AGENT) : 0u; }
        __syncthreads();
        if (lane < 16) { const unsigned r = (unsigned)row; const size_t o1 = (size_t)e1 * NTOK + lbase[e1] + l1, o2 = (size_t)e2 * NTOK + lbase[e2] + l2;
            const unsigned slot = lbaseB[bk] + lB, c1 = (bk << 20) | (h1 << 19) | slot, c2 = (bk << 20) | ((1u - h1) << 19) | slot;
            list[o1] = r; list[o2] = r; const unsigned rb = __float_as_uint(rstd);
            rec[o1] = (u32x4){rb, __float_as_uint(g1), c1, r}; rec[o2] = (u32x4){rb, __float_as_uint(g2), c2, r}; }
        __syncthreads();
        if (tid < 32) lcnt[tid] = 0u;
        if (tid < 48) lcntB[tid] = 0u;
        asm volatile("s_waitcnt vmcnt(0) lgkmcnt(0)" ::: "memory");
    }
}


namespace pg8 {
constexpr int BM = 256, BK = 64, HALF = 128, HTB = HALF * BK * 2, STAGE_BYTES = 8 * HTB, NXCD = 8, WGM = 8;
__host__ __device__ __forceinline__ int lds_byte(int r, int c) { const int st = (r >> 4) * 2 + (c >> 5), rr = r & 15, cc = c & 31, ob = rr * 64 + cc * 2; return st * 1024 + (ob ^ (((ob >> 9) & 1) << 5)); }
__host__ __device__ __forceinline__ void stage_rc(int b, int& R, int& C) { const int st = b / 1024, sb = b % 1024, swz = sb ^ (((sb >> 9) & 1) << 5); R = (st >> 1) * 16 + swz / 64; C = (st & 1) * 32 + (swz % 64) / 2; }
__host__ __device__ __forceinline__ int perm32(int rho) { const int n = rho >> 4, i = rho & 15; return 8 * (i >> 2) + 4 * n + (i & 3); }
struct Unit { int pm, pn, e, r0, rows; };
__device__ __forceinline__ unsigned cvt_pk_bf16(float lo, float hi) { unsigned r; asm volatile("v_cvt_pk_bf16_f32 %0, %1, %2" : "=v"(r) : "v"(lo), "v"(hi)); return r; }

__device__ __forceinline__ void tile_of(int wgid, int nM, int nN, int& pm, int& pn) {
    const int nwg = nM * nN; { const int q = nwg / NXCD, r = nwg % NXCD, xcd = wgid % NXCD, off = wgid / NXCD; wgid = (xcd < r ? xcd * (q + 1) : r * (q + 1) + (xcd - r) * q) + off; }
    const int nig = WGM * nN, gid = wgid / nig, fm = gid * WGM, gsz = (nM - fm) < WGM ? (nM - fm) : WGM;
    pm = fm + ((wgid % nig) % gsz); pn = (wgid % nig) / gsz;
}
struct DenseOrder { static constexpr bool GATHER = false, SPLITB = false;
    const bf16* A; const bf16* Bt; int K, nM, nN, G, c;
    __device__ __forceinline__ void init(const bf16* A_, const bf16* Bt_, int M, int N, int K_) { A = A_; Bt = Bt_; K = K_; nM = M / BM; nN = N / BM; G = gridDim.x; c = blockIdx.x; }
    __device__ __forceinline__ bool next(int i, Unit& u) const { const long L = (long)i * G + c; if (L >= (long)nM * nN) return false; tile_of((int)L, nM, nN, u.pm, u.pn); u.e = 0; u.r0 = 0; u.rows = BM; return true; }
    __device__ __forceinline__ const char* abase(const Unit& u) const { return (const char*)A + (size_t)u.pm * BM * K * 2; }
    __device__ __forceinline__ const char* bbase(const Unit& u) const { return (const char*)Bt + (size_t)u.pn * BM * K * 2; }
    __device__ __forceinline__ int kb() const { return K; }
    __device__ __forceinline__ const char* bbase2(const Unit& u) const { return bbase(u) + K; }
    __device__ __forceinline__ void a_offs(const Unit&, unsigned (&vo)[2][2], const int (&R)[2], const int (&C)[2]) const {
#pragma unroll
        for (int h = 0; h < 2; ++h)
#pragma unroll
            for (int i = 0; i < 2; ++i) vo[h][i] = (unsigned)((R[i] + HALF * h) * K + C[i]) * 2u; }
};
struct MoeOrder { static constexpr bool GATHER = false, SPLITB = false;
    const bf16* A; const bf16* Bt; int K, N, nN, G, c; const LAS int* tstart; const LAS int* cnts;
    __device__ __forceinline__ void init(const bf16* A_, const bf16* Bt_, int N_, int K_, const LAS int* ts, const LAS int* cn) { A = A_; Bt = Bt_; K = K_; N = N_; nN = N_ / BM; G = gridDim.x; c = blockIdx.x; tstart = ts; cnts = cn; }
    __device__ __forceinline__ bool next(int i, Unit& u) const { const int nM = tstart[32]; const long L = (long)i * G + c; if (L >= (long)nM * nN) return false; tile_of((int)L, nM, nN, u.pm, u.pn);
        const int e = tstart[128 + u.pm]; u.e = e; u.r0 = (u.pm - tstart[e]) * BM; const int left = cnts[e] - u.r0; u.rows = left < BM ? left : BM; return true; }
    __device__ __forceinline__ const char* abase(const Unit& u) const { return (const char*)A + (size_t)u.pm * BM * K * 2; }
    __device__ __forceinline__ const char* bbase(const Unit& u) const { return (const char*)Bt + ((size_t)u.e * N + (size_t)u.pn * BM) * K * 2; }
    __device__ __forceinline__ int kb() const { return K; }
    __device__ __forceinline__ const char* bbase2(const Unit& u) const { return bbase(u) + K; }
    __device__ __forceinline__ void a_offs(const Unit&, unsigned (&vo)[2][2], const int (&R)[2], const int (&C)[2]) const {
#pragma unroll
        for (int h = 0; h < 2; ++h)
#pragma unroll
            for (int i = 0; i < 2; ++i) vo[h][i] = (unsigned)((R[i] + HALF * h) * K + C[i]) * 2u; }
};
struct MoeGatherOrder : MoeOrder { static constexpr bool GATHER = true;
    const unsigned* list;
    __device__ __forceinline__ const char* abase(const Unit&) const { return (const char*)A; }
    __device__ __forceinline__ void a_offs(const Unit& u, unsigned (&vo)[2][2], const int (&R)[2], const int (&C)[2]) const {
#pragma unroll
        for (int h = 0; h < 2; ++h)
#pragma unroll
            for (int i = 0; i < 2; ++i) { const int rl = R[i] + HALF * h, rc = rl < u.rows ? rl : u.rows - 1; const unsigned tok = list[(size_t)u.e * NTOK + u.r0 + rc]; vo[h][i] = (tok * (unsigned)K + (unsigned)C[i]) * 2u; } }
};
struct MoeBucketOrder { static constexpr bool GATHER = false, SPLITB = true;
    const bf16* A; const bf16* Bt; int nN, G, c; const LAS int* tab;
    __device__ __forceinline__ void init(const bf16* A_, const bf16* Bt_, const LAS int* t) { A = A_; Bt = Bt_; nN = DM / BM; G = gridDim.x; c = blockIdx.x; tab = t; }
    __device__ __forceinline__ bool next(int i, Unit& u) const { const int nM = tab[448 + 48]; const long L = (long)i * G + c; if (L >= (long)nM * nN) return false; tile_of((int)L, nM, nN, u.pm, u.pn);
        const int bk = tab[576 + u.pm], g = bk / 6, px = bk % 6, lo = px < 3 ? 0 : (px < 5 ? 1 : 2), hi = px < 3 ? px + 1 : (px < 5 ? px - 1 : 3);
        u.e = (g * 4 + lo) | ((g * 4 + hi) << 8); u.r0 = (u.pm - tab[448 + bk]) * BM; const int left = tab[512 + bk] - u.r0; u.rows = left < BM ? left : BM; return true; }
    __device__ __forceinline__ const char* abase(const Unit& u) const { return (const char*)A + (size_t)u.pm * BM * (2 * DFF) * 2; }
    __device__ __forceinline__ const char* bbase(const Unit& u) const { return (const char*)Bt + ((size_t)(u.e & 255) * DM + (size_t)u.pn * BM) * DFF * 2; }
    __device__ __forceinline__ const char* bbase2(const Unit& u) const { return (const char*)Bt + ((size_t)(u.e >> 8) * DM + (size_t)u.pn * BM) * DFF * 2; }
    __device__ __forceinline__ int kb() const { return DFF; }
    __device__ __forceinline__ void a_offs(const Unit&, unsigned (&vo)[2][2], const int (&R)[2], const int (&C)[2]) const {
#pragma unroll
        for (int h = 0; h < 2; ++h)
#pragma unroll
            for (int i = 0; i < 2; ++i) vo[h][i] = (unsigned)((R[i] + HALF * h) * (2 * DFF) + C[i]) * 2u; }
};
struct EpiBf16 { static constexpr bool PERM = true; bf16* O; int ldc;
    __device__ __forceinline__ void operator()(const f32x4 (&acc)[2][2][4][2], const Unit& u, int wr, int wc, int fr, int fq) const {
        const int row0 = u.pm * BM + wr * 64 + fr, col0 = u.pn * BM + wc * 32 + 8 * fq;
#pragma unroll
        for (int ai = 0; ai < 2; ++ai)
#pragma unroll
            for (int m = 0; m < 4; ++m) { bf16* rowp = O + (size_t)(row0 + ai * HALF + m * 16) * ldc + col0;
#pragma unroll
                for (int bj = 0; bj < 2; ++bj) { const f32x4 v0 = acc[ai][bj][m][0], v1 = acc[ai][bj][m][1];
                    u32x4 w; w.x = cvt_pk_bf16(v0[0], v0[1]); w.y = cvt_pk_bf16(v0[2], v0[3]); w.z = cvt_pk_bf16(v1[0], v1[1]); w.w = cvt_pk_bf16(v1[2], v1[3]);
                    *(u32x4*)(rowp + bj * HALF) = w; } }
    } };
struct EpiF32 { static constexpr bool PERM = false; float* C; int ldc;
    __device__ __forceinline__ void operator()(const f32x4 (&acc)[2][2][4][2], const Unit& u, int wr, int wc, int fr, int fq) const {
        const int row0 = u.pm * BM + wr * 64 + fr, col0 = u.pn * BM + wc * 32 + 4 * fq;
#pragma unroll
        for (int ai = 0; ai < 2; ++ai)
#pragma unroll
            for (int m = 0; m < 4; ++m) { float* rowp = C + (size_t)(row0 + ai * HALF + m * 16) * ldc + col0;
#pragma unroll
                for (int bj = 0; bj < 2; ++bj)
#pragma unroll
                    for (int n = 0; n < 2; ++n) *(f32x4*)(rowp + bj * HALF + n * 16) = acc[ai][bj][m][n]; }
    } };
struct EpiRes { static constexpr bool PERM = true; const bf16* res; bf16* out;
    __device__ __forceinline__ void operator()(const f32x4 (&acc)[2][2][4][2], const Unit& u, int wr, int wc, int fr, int fq) const {
        const int row0 = u.pm * BM + wr * 64 + fr, col0 = u.pn * BM + wc * 32 + 8 * fq;
#pragma unroll
        for (int ai = 0; ai < 2; ++ai) { u32x4 b[4][2];
#pragma unroll
            for (int m = 0; m < 4; ++m) { const size_t off = (size_t)(row0 + ai * HALF + m * 16) * DM + col0;
#pragma unroll
                for (int bj = 0; bj < 2; ++bj) b[m][bj] = *(const u32x4*)(res + off + bj * HALF); }
            asm volatile("" ::: "memory");
#pragma unroll
            for (int m = 0; m < 4; ++m) { const size_t off = (size_t)(row0 + ai * HALF + m * 16) * DM + col0;
#pragma unroll
                for (int bj = 0; bj < 2; ++bj) { const u32x4 r = b[m][bj]; const f32x4 a0 = acc[ai][bj][m][0], a1 = acc[ai][bj][m][1];
                    u32x4 w; w.x = cvt_pk_bf16(bflo(r.x) + a0[0], bfhi(r.x) + a0[1]); w.y = cvt_pk_bf16(bflo(r.y) + a0[2], bfhi(r.y) + a0[3]);
                    w.z = cvt_pk_bf16(bflo(r.z) + a1[0], bfhi(r.z) + a1[1]); w.w = cvt_pk_bf16(bflo(r.w) + a1[2], bfhi(r.w) + a1[3]);
                    *(u32x4*)(out + off + bj * HALF) = w; } }
            asm volatile("" ::: "memory"); }
    } };
struct EpiSC { static constexpr bool PERM = true; bf16* Bg; bf16* P;
    __device__ __forceinline__ void operator()(const f32x4 (&acc)[2][2][4][2], const Unit& u, int wr, int wc, int fr, int fq) const {
        const int row0 = u.pm * BM + wr * 64 + fr;
        if (u.pn < 8) { const int col0 = u.pn * BM + wc * 32 + 8 * fq;
#pragma unroll
            for (int ai = 0; ai < 2; ++ai)
#pragma unroll
                for (int m = 0; m < 4; ++m) { bf16* rowp = Bg + (size_t)(row0 + ai * HALF + m * 16) * DM + col0;
#pragma unroll
                    for (int bj = 0; bj < 2; ++bj) { const f32x4 v0 = acc[ai][bj][m][0], v1 = acc[ai][bj][m][1];
                        u32x4 w; w.x = cvt_pk_bf16(v0[0], v0[1]); w.y = cvt_pk_bf16(v0[2], v0[3]); w.z = cvt_pk_bf16(v1[0], v1[1]); w.w = cvt_pk_bf16(v1[2], v1[3]);
                        *(u32x4*)(rowp + bj * HALF) = w; } }
        } else { const int col0 = (u.pn - 8) * HALF + wc * 32 + 8 * fq;
#pragma unroll
            for (int ai = 0; ai < 2; ++ai)
#pragma unroll
                for (int m = 0; m < 4; ++m) { const f32x4 v0 = acc[ai][0][m][0] * acc[ai][1][m][0], v1 = acc[ai][0][m][1] * acc[ai][1][m][1];
                    u32x4 w; w.x = cvt_pk_bf16(v0[0], v0[1]); w.y = cvt_pk_bf16(v0[2], v0[3]); w.z = cvt_pk_bf16(v1[0], v1[1]); w.w = cvt_pk_bf16(v1[2], v1[3]);
                    *(u32x4*)(P + (size_t)(row0 + ai * HALF + m * 16) * DM + col0) = w; }
        }
    } };
struct EpiSwiglu { static constexpr bool PERM = true; bf16* ACT2; const u32x4* REC; const LAS int* tab;
    __device__ __forceinline__ void operator()(const f32x4 (&acc)[2][2][4][2], const Unit& u, int wr, int wc, int fr, int fq) const {
        const int col0 = u.pn * HALF + wc * 32 + 8 * fq; const u32x4* rp = REC + (size_t)u.e * NTOK + u.r0 + wr * 64 + fr;
#pragma unroll
        for (int ai = 0; ai < 2; ++ai) {
            u32x4 rc[4];
#pragma unroll
            for (int m = 0; m < 4; ++m) rc[m] = rp[ai * HALF + m * 16];
#pragma unroll
            for (int m = 0; m < 4; ++m) { const int rl = ai * HALF + wr * 64 + m * 16 + fr;
                if (rl < u.rows) { float o[8]; const float rs = __uint_as_float(rc[m].x), gt = __uint_as_float(rc[m].y); const unsigned cd = rc[m].z;
                    const unsigned doff = (((unsigned)tab[448 + (cd >> 20)] * (unsigned)BM + (cd & 0x7FFFFu)) * (unsigned)(2 * DFF) + ((cd >> 19) & 1u) * (unsigned)DFF + (unsigned)col0) * 2u;
#pragma unroll
                    for (int n = 0; n < 2; ++n)
#pragma unroll
                        for (int j = 0; j < 4; ++j) { const float g = acc[ai][0][m][n][j] * rs, up = acc[ai][1][m][n][j] * rs;
                            o[n * 4 + j] = g * __builtin_amdgcn_rcpf(1.0f + __builtin_amdgcn_exp2f(-1.4426950408889634f * g)) * up * gt; }
                    u32x4 w; w.x = cvt_pk_bf16(o[0], o[1]); w.y = cvt_pk_bf16(o[2], o[3]); w.z = cvt_pk_bf16(o[4], o[5]); w.w = cvt_pk_bf16(o[6], o[7]);
                    *(u32x4*)((char*)ACT2 + doff) = w;
                } }
            asm volatile("" ::: "memory"); }
    } };
template <bool NEXT>
struct EpiDown { static constexpr bool PERM = true; const unsigned* TOKOF; bf16* XS; float* OUT; float* PART;
    __device__ __forceinline__ void operator()(const f32x4 (&acc)[2][2][4][2], const Unit& u, int wr, int wc, int fr, int fq) const {
        const int col0 = u.pn * BM + wc * 32 + 8 * fq;
        unsigned tk[2][4];
#pragma unroll
        for (int ai = 0; ai < 2; ++ai)
#pragma unroll
            for (int m = 0; m < 4; ++m) { const int rl = ai * HALF + wr * 64 + m * 16 + fr; tk[ai][m] = TOKOF[(size_t)u.pm * BM + rl]; }
#pragma unroll
        for (int ai = 0; ai < 2; ++ai) { u32x4 b[4][2];
#pragma unroll
            for (int m = 0; m < 4; ++m) { const int rl = ai * HALF + wr * 64 + m * 16 + fr; const unsigned t = rl < u.rows ? tk[ai][m] : 0u;
                const bf16* rowp = XS + (size_t)t * DM + col0;
#pragma unroll
                for (int bj = 0; bj < 2; ++bj) b[m][bj] = *(const u32x4*)(rowp + bj * HALF); }
            asm volatile("" ::: "memory");
#pragma unroll
            for (int m = 0; m < 4; ++m) { const int rl = ai * HALF + wr * 64 + m * 16 + fr; const bool ok = rl < u.rows; const size_t ro = (size_t)tk[ai][m] * DM + col0;
                float ss = 0.f;
#pragma unroll
                for (int bj = 0; bj < 2; ++bj) { const u32x4 r = b[m][bj];
                    const f32x4 x0 = (f32x4){bflo(r.x), bfhi(r.x), bflo(r.y), bfhi(r.y)} + acc[ai][bj][m][0], x1 = (f32x4){bflo(r.z), bfhi(r.z), bflo(r.w), bfhi(r.w)} + acc[ai][bj][m][1];
                    if constexpr (NEXT) {
                        ss += x0[0] * x0[0] + x0[1] * x0[1] + x0[2] * x0[2] + x0[3] * x0[3] + x1[0] * x1[0] + x1[1] * x1[1] + x1[2] * x1[2] + x1[3] * x1[3];
                        u32x4 w; w.x = cvt_pk_bf16(x0[0], x0[1]); w.y = cvt_pk_bf16(x0[2], x0[3]); w.z = cvt_pk_bf16(x1[0], x1[1]); w.w = cvt_pk_bf16(x1[2], x1[3]);
                        if (ok) *(u32x4*)(XS + ro + bj * HALF) = w;
                    } else { if (ok) { *(f32x4*)(OUT + ro + bj * HALF) = x0; *(f32x4*)(OUT + ro + bj * HALF + 4) = x1; } } }
                if constexpr (NEXT) { ss += __shfl_xor(ss, 16); ss += __shfl_xor(ss, 32);
                    if (ok && fq == 0) PART[(size_t)tk[ai][m] * 32 + u.pn * 4 + wc] = ss; } }
            asm volatile("" ::: "memory"); }
    } };

template <class Epi, class Sched, bool ALIGN_EPI = true>
__device__ __forceinline__ void gemm_phase(const int wv_, LAS unsigned char* lds, const int K, const Sched& S, const Epi& E) {
    const int tid = TIDX, wid = wv_, lane = tid & 63, wr = wid >> 2, wc = wid & 3, fr = lane & 15, fq = lane >> 4;
    const int nt = K / BK;
    unsigned voffB[2]; int Ra[2], Ca[2];
#pragma unroll
    for (int i = 0; i < 2; ++i) { int R, C; stage_rc(tid * 16 + i * 8192, R, C); const int Rb = Epi::PERM ? ((R & ~31) + perm32(R & 31)) : R;
        Ra[i] = R; Ca[i] = C; voffB[i] = (unsigned)(Rb * S.kb() + C) * 2u; }
    unsigned vAc[2][2], vAn[2][2];
    const size_t kstep = (size_t)(BK * 2);
    const size_t hstep = (size_t)HALF * S.kb() * 2;
    const int nth = nt / 2;
    const unsigned ldsw = (unsigned)wid * 1024u;
    const int aoff = lds_byte(wr * 64 + fr, fq * 8), boff = lds_byte(wc * 32 + fr, fq * 8);
#define PG8_SA(b, h) (((b) * 2 + (h)) * HTB)
#define PG8_SB(b, h) ((4 + (b) * 2 + (h)) * HTB)
#define PG8_STAGE(bufoff, gbase, voff) do { _Pragma("unroll") for (int _i = 0; _i < 2; ++_i) \
        __builtin_amdgcn_global_load_lds((const unsigned*)((const char*)(gbase) + (voff)[_i]), (LAS unsigned*)(lds + (bufoff) + ldsw + _i * 8192), 16, 0, 0); } while (0)
#define PG8_LDA(dst, b, h) do { _Pragma("unroll") for (int m = 0; m < 4; ++m) _Pragma("unroll") for (int k = 0; k < 2; ++k) dst[m][k] = *(const LAS bf16x8*)(lds + PG8_SA(b, h) + aoff + m * 2048 + k * 1024); } while (0)
#define PG8_LDB(dst, b, h) do { _Pragma("unroll") for (int n = 0; n < 2; ++n) _Pragma("unroll") for (int k = 0; k < 2; ++k) dst[n][k] = *(const LAS bf16x8*)(lds + PG8_SB(b, h) + boff + n * 2048 + k * 1024); } while (0)
#define PG8_MMA(ai, bj, At, Bt) do { __builtin_amdgcn_s_setprio(1); _Pragma("unroll") for (int m = 0; m < 4; ++m) _Pragma("unroll") for (int n = 0; n < 2; ++n) _Pragma("unroll") for (int k = 0; k < 2; ++k) \
        acc[ai][bj][m][n] = __builtin_amdgcn_mfma_f32_16x16x32_bf16(Bt[n][k], At[m][k], acc[ai][bj][m][n], 0, 0, 0); __builtin_amdgcn_s_setprio(0); } while (0)
#define PG8_WAIT_V(n) asm volatile("s_waitcnt vmcnt(" #n ")" ::: "memory")
#define PG8_WAIT_L(n) asm volatile("s_waitcnt lgkmcnt(" #n ")" ::: "memory")
#define PG8_BAR __builtin_amdgcn_s_barrier()
#define PG8_SCHED __builtin_amdgcn_sched_barrier(0)
    Unit cur, nxt; int ui = 0;
    if (!S.next(0, cur)) return;
    f32x4 acc[2][2][4][2];
#pragma unroll
    for (int a = 0; a < 2; ++a)
#pragma unroll
        for (int b = 0; b < 2; ++b)
#pragma unroll
            for (int m = 0; m < 4; ++m)
#pragma unroll
                for (int n = 0; n < 2; ++n) acc[a][b][m][n] = (f32x4){0.f, 0.f, 0.f, 0.f};
    bf16x8 At[4][2], B0[2][2], B1[2][2];
    const char* cA = S.abase(cur); const char* cB = S.bbase(cur); long dB2 = 0;
    if constexpr (Sched::SPLITB) dB2 = (S.bbase2(cur) - cB) - (long)nth * (long)kstep;
    S.a_offs(cur, vAc, Ra, Ca);
    PG8_STAGE(PG8_SB(0, 0), cB, voffB); PG8_STAGE(PG8_SB(0, 1), cB + hstep, voffB); PG8_STAGE(PG8_SA(0, 0), cA, vAc[0]); PG8_STAGE(PG8_SA(0, 1), cA, vAc[1]);
    if (wr == 1) PG8_BAR;
    PG8_WAIT_V(2); PG8_BAR;
    PG8_STAGE(PG8_SB(1, 0), cB + kstep, voffB); PG8_STAGE(PG8_SA(1, 0), cA + kstep, vAc[0]); PG8_STAGE(PG8_SB(1, 1), cB + hstep + kstep, voffB);
    PG8_WAIT_V(6); PG8_BAR;
    for (;;) {
        const bool has_next = S.next(ui + 1, nxt);
        const char* nA = has_next ? S.abase(nxt) : cA; const char* nB = has_next ? S.bbase(nxt) : cB;
        if constexpr (Sched::GATHER) {
            if (has_next) S.a_offs(nxt, vAn, Ra, Ca);
            else {
#pragma unroll
                for (int h = 0; h < 2; ++h)
#pragma unroll
                    for (int i = 0; i < 2; ++i) vAn[h][i] = vAc[h][i]; } }
        for (int t = 0; t < nt; t += 2) {
            const bool last = (t == nt - 2);
            const char* a1 = cA + (size_t)(t + 1) * kstep;
            const char* a2 = last ? nA : cA + (size_t)(t + 2) * kstep; const char* b2 = last ? nB : cB + (size_t)(t + 2) * kstep;
            if constexpr (Sched::SPLITB) { if (!last && t + 2 >= nth) b2 += dB2; }
            const char* a3 = a2 + kstep; const char* b3 = b2 + kstep;
            unsigned v0[2], v1[2];
#pragma unroll
            for (int i = 0; i < 2; ++i) { v0[i] = (Sched::GATHER && last) ? vAn[0][i] : vAc[0][i]; v1[i] = (Sched::GATHER && last) ? vAn[1][i] : vAc[1][i]; }
            PG8_LDB(B0, 0, 0); PG8_LDB(B1, 0, 1); PG8_SCHED; PG8_LDA(At, 0, 0); PG8_STAGE(PG8_SA(1, 1), a1, vAc[1]);
            PG8_WAIT_V(8); PG8_WAIT_L(0); PG8_BAR; PG8_MMA(0, 0, At, B0); PG8_MMA(0, 1, At, B1); PG8_BAR; PG8_SCHED;
            PG8_LDA(At, 0, 1); PG8_STAGE(PG8_SB(0, 0), b2, voffB); PG8_STAGE(PG8_SB(0, 1), b2 + hstep, voffB); PG8_STAGE(PG8_SA(0, 0), a2, v0);
            PG8_WAIT_V(8); PG8_WAIT_L(0); PG8_BAR; PG8_MMA(1, 0, At, B0); PG8_MMA(1, 1, At, B1); PG8_BAR; PG8_SCHED;
            PG8_LDB(B0, 1, 0); PG8_LDB(B1, 1, 1); PG8_SCHED; PG8_LDA(At, 1, 0); PG8_STAGE(PG8_SA(0, 1), a2, v1);
            PG8_WAIT_V(8); PG8_WAIT_L(0); PG8_BAR; PG8_MMA(0, 0, At, B0); PG8_MMA(0, 1, At, B1); PG8_BAR; PG8_SCHED;
            PG8_LDA(At, 1, 1); PG8_STAGE(PG8_SB(1, 0), b3, voffB); PG8_STAGE(PG8_SB(1, 1), b3 + hstep, voffB); PG8_STAGE(PG8_SA(1, 0), a3, v0);
            PG8_WAIT_V(8); PG8_WAIT_L(0); PG8_BAR; PG8_MMA(1, 0, At, B0); PG8_MMA(1, 1, At, B1); PG8_BAR; PG8_SCHED;
        }
        if constexpr (ALIGN_EPI) { if (wr == 0) PG8_BAR; }
        E(acc, cur, wr, wc, fr, fq);
        if (!has_next) break;
#pragma unroll
        for (int a = 0; a < 2; ++a)
#pragma unroll
            for (int b = 0; b < 2; ++b)
#pragma unroll
                for (int m = 0; m < 4; ++m)
#pragma unroll
                    for (int n = 0; n < 2; ++n) acc[a][b][m][n] = (f32x4){0.f, 0.f, 0.f, 0.f};
        cur = nxt; cA = nA; cB = nB; ++ui;
        if constexpr (Sched::SPLITB) dB2 = (S.bbase2(cur) - cB) - (long)nth * (long)kstep;
        if constexpr (Sched::GATHER) {
#pragma unroll
            for (int h = 0; h < 2; ++h)
#pragma unroll
                for (int i = 0; i < 2; ++i) vAc[h][i] = vAn[h][i]; }
        if constexpr (ALIGN_EPI) { if (wr == 1) PG8_BAR; }
    }
    PG8_WAIT_V(0);
    if constexpr (!ALIGN_EPI) { if (wr == 0) PG8_BAR; }
    PG8_BAR;
#undef PG8_SA
#undef PG8_SB
#undef PG8_STAGE
#undef PG8_LDA
#undef PG8_LDB
#undef PG8_MMA
#undef PG8_WAIT_V
#undef PG8_WAIT_L
#undef PG8_BAR
#undef PG8_SCHED
}
}


constexpr int MOE_TAB_OFF = SCR_BYTES + 1024;
__device__ __forceinline__ void moe_tables256(const int wv_, LAS unsigned char* lds, unsigned* cnt, unsigned* cntB) {
    LAS int* tstart = (LAS int*)(lds + MOE_TAB_OFF); LAS int* cnts = tstart + 64;
    __syncthreads();
    if (TIDX < 32) cnts[TIDX] = (int)__hip_atomic_load(cnt + TIDX * 64, __ATOMIC_RELAXED, __HIP_MEMORY_SCOPE_AGENT);
    else if (TIDX >= 64 && TIDX < 112) tstart[512 + TIDX - 64] = (int)__hip_atomic_load(cntB + (TIDX - 64) * 64, __ATOMIC_RELAXED, __HIP_MEMORY_SCOPE_AGENT);
    __syncthreads();
    if (TIDX == 0) { int t = 0; for (int e = 0; e < 32; ++e) { tstart[e] = t; t += (cnts[e] + 255) / 256; } tstart[32] = t; }
    else if (TIDX == 64) { int t = 0; for (int b = 0; b < 48; ++b) { tstart[448 + b] = t; t += (tstart[512 + b] + 255) / 256; } tstart[448 + 48] = t; }
    __syncthreads();
    for (int t = TIDX; t < tstart[32]; t += NTHREADS) { int e = 0; for (int k = 1; k < 32; ++k) e += (tstart[k] <= t) ? 1 : 0; tstart[128 + t] = e; }
    for (int t = TIDX; t < tstart[448 + 48]; t += NTHREADS) { int b = 0; for (int k = 1; k < 48; ++k) b += (tstart[448 + k] <= t) ? 1 : 0; tstart[576 + t] = b; }
    __syncthreads();
}
__device__ __forceinline__ void moe_up_phase256(const int wv_, LAS unsigned char* lds, const bf16* Hu, const u32x4* REC, const bf16* WupT, unsigned* cnt, unsigned* cntB, const unsigned* list, bf16* ACT2, unsigned* TOKOF,
                                                const float* cw_up, const float* cw_dn, bf16* cw_upT, bf16* cw_dnT, const float* cw_gain) {
    LAS int* tstart = (LAS int*)(lds + MOE_TAB_OFF); LAS int* cnts = tstart + 64;
    moe_tables256(wv_, lds, cnt, cntB);
    pg8::MoeGatherOrder S; S.init(Hu, WupT, 2 * DFF, DM, tstart, cnts); S.list = list;
    for (int o = blockIdx.x * NTHREADS + TIDX; o < NEXP * NTOK; o += gridDim.x * NTHREADS) { const int e = o >> 15, r = o & (NTOK - 1);
        if (r < cnts[e]) { const u32x4 rc = REC[o]; TOKOF[(size_t)tstart[448 + (rc.z >> 20)] * 256 + (rc.z & 0x7FFFFu)] = rc.w; } }
    pg8::EpiSwiglu E{ACT2, REC, tstart};
    pg8::gemm_phase<pg8::EpiSwiglu, pg8::MoeGatherOrder, false>(wv_, lds, DM, S, E);
    if (cw_up) {
        const int G = gridDim.x, units = tstart[32] * 4, rem = units % G; int first_idle = rem;
        if (rem == 0 || G - rem < G / 4) first_idle = 0;
        const int c = blockIdx.x;
        if (c >= first_idle) { const int wid = wv_, lane = TIDX & 63; LAS float* scr = (LAS float*)(lds + wid * 16384);
            const int gw = (c - first_idle) * NWAVES + wid, NGW = (G - first_idle) * NWAVES;
            cvt_mats<2, true>(cw_up, NEXP, DM, 2 * DFF, 2 * DFF, cw_upT, scr, gw, NGW, lane, cw_gain, 0);
            cvt_mats<0>(cw_dn, NEXP, DFF, DM, DM, cw_dnT, scr, gw, NGW, lane); }
    }
}
template <bool NEXT>
__device__ __forceinline__ void moe_down_phase256(const int wv_, LAS unsigned char* lds, const bf16* ACT2, const bf16* WdnT, unsigned* cnt, unsigned* cntB, const unsigned* TOKOF, bf16* XS, float* OUT, float* PART) {
    LAS int* tstart = (LAS int*)(lds + MOE_TAB_OFF);
    moe_tables256(wv_, lds, cnt, cntB);
    pg8::MoeBucketOrder S; S.init(ACT2, WdnT, tstart);
    pg8::EpiDown<NEXT> E{TOKOF, XS, OUT, PART};
    pg8::gemm_phase<pg8::EpiDown<NEXT>, pg8::MoeBucketOrder, false>(wv_, lds, 2 * DFF, S, E);
}
template <class Epi, bool ALIGN_EPI = true>
__device__ __forceinline__ void gemm_dense256(const int wv_, LAS unsigned char* lds, const bf16* A, const bf16* Bt, int M, int N, int K, const Epi& E, int G_ = 0, int c_ = 0) {
    pg8::DenseOrder S; S.init(A, Bt, M, N, K);
    if (G_ > 0) { S.G = G_; S.c = c_; }
    pg8::gemm_phase<Epi, pg8::DenseOrder, ALIGN_EPI>(wv_, lds, K, S, E);
}

__device__ __forceinline__ void rstd_prepass(const int wv_, const float* PART, float* RSTD) {
    const int tid = TIDX;
    for (int row = blockIdx.x * (NTHREADS / 4) + (tid >> 2); row < NTOK; row += gridDim.x * (NTHREADS / 4)) {
        const f32x4 a = *(const f32x4*)(PART + (size_t)row * 32 + (tid & 3) * 8), b = *(const f32x4*)(PART + (size_t)row * 32 + (tid & 3) * 8 + 4);
        float s = ((a[0] + a[1]) + (a[2] + a[3])) + ((b[0] + b[1]) + (b[2] + b[3]));
        s += __shfl_xor(s, 1); s += __shfl_xor(s, 2);
        if ((tid & 3) == 0) RSTD[row] = 1.0f / sqrtf(s * (1.0f / DM) + EPS);
    }
}
template <bool RS>
__device__ __forceinline__ void sc_thin_phase(const int wv_, const bf16* Bg, const bf16* P, const float* cw  , bf16* Y, const float* RSTD) {
    const size_t total = (size_t)NTOK * (DM / 8), stride = (size_t)gridDim.x * NTHREADS;
    constexpr int NU = 4;
    for (size_t i0 = (size_t)blockIdx.x * NTHREADS + TIDX; i0 < total; i0 += NU * stride) {
        u32x4 p[NU][3], bb[NU]; float rr[NU][3];
#pragma unroll
        for (int k = 0; k < NU; ++k) { const size_t i = i0 + k * stride; const bool ok = i < total; const int n = ok ? (int)(i / (DM / 8)) : 0, d0 = ok ? (int)(i % (DM / 8)) * 8 : 0, t = n & (SEQ - 1);
#pragma unroll
            for (int j = 0; j < 3; ++j) { const int tt = t + j - 1; p[k][j] = (tt >= 0 && tt < SEQ) ? *(const u32x4*)(P + (size_t)(n + j - 1) * DM + d0) : (u32x4){0u, 0u, 0u, 0u};
                if constexpr (RS) rr[k][j] = (tt >= 0 && tt < SEQ) ? RSTD[n + j - 1] : 0.f; }
            bb[k] = *(const u32x4*)(Bg + (size_t)n * DM + d0); }
#pragma unroll
        for (int k = 0; k < NU; ++k) { const size_t i = i0 + k * stride; if (i >= total) continue; const int n = (int)(i / (DM / 8)), d0 = (int)(i % (DM / 8)) * 8;
            float acc[8];
#pragma unroll
            for (int q = 0; q < 8; ++q) acc[q] = 0.f;
#pragma unroll
            for (int j = 0; j < 3; ++j) { const u32x4 pp = p[k][j];
                f32x4 w0 = *(const f32x4*)(cw + j * DM + d0), w1 = *(const f32x4*)(cw + j * DM + d0 + 4);
                if constexpr (RS) { const float s2 = rr[k][j] * rr[k][j]; w0 *= s2; w1 *= s2; }
                acc[0] += bflo(pp.x) * w0[0]; acc[1] += bfhi(pp.x) * w0[1]; acc[2] += bflo(pp.y) * w0[2]; acc[3] += bfhi(pp.y) * w0[3];
                acc[4] += bflo(pp.z) * w1[0]; acc[5] += bfhi(pp.z) * w1[1]; acc[6] += bflo(pp.w) * w1[2]; acc[7] += bfhi(pp.w) * w1[3]; }
            const u32x4 b_ = bb[k];
            if constexpr (RS) {
#pragma unroll
                for (int q = 0; q < 8; ++q) acc[q] *= rr[k][1]; }
            u32x4 o; o.x = pk2(bflo(b_.x) * acc[0], bfhi(b_.x) * acc[1]); o.y = pk2(bflo(b_.y) * acc[2], bfhi(b_.y) * acc[3]);
            o.z = pk2(bflo(b_.z) * acc[4], bfhi(b_.z) * acc[5]); o.w = pk2(bflo(b_.w) * acc[6], bfhi(b_.w) * acc[7]);
            *(u32x4*)(Y + (size_t)n * DM + d0) = o; }
    }
}

__device__ __forceinline__ s16x4 tr_rd(unsigned addr) { s16x4 r; asm volatile("ds_read_b64_tr_b16 %0, %1" : "=v"(r) : "v"(addr) : "memory"); return r; }
__device__ __forceinline__ void hy_thin1_phase(const int wv_, const bf16* Z, const float* cw  , const float* cb  , bf16* X0, bf16* VT, LAS unsigned char* lds, const float* RSTD) {
    const int tid = TIDX, tl = tid >> 3, dc = tid & 7, lane = tid & 63, wv = wv_, grp = lane >> 4, li = lane & 15;
    const int items = (NTOK / 64) * (DM / 64);
    u32x4 z[3][3]; float zr[3];
#define T1_LOAD(it_) do { const int nt_ = (it_) / (DM / 64), db_ = (it_) % (DM / 64), n_ = nt_ * 64 + tl, t_ = n_ & (SEQ - 1), d0_ = db_ * 64 + dc * 8; \
        _Pragma("unroll") for (int j = 0; j < 3; ++j) { const int tt = t_ + j - 1; zr[j] = (tt >= 0 && tt < SEQ) ? RSTD[n_ + j - 1] : 0.f; } \
        _Pragma("unroll") for (int gI = 1; gI < 3; ++gI) _Pragma("unroll") for (int j = 0; j < 3; ++j) { const int tt = t_ + j - 1; \
            z[gI][j] = (tt >= 0 && tt < SEQ) ? *(const u32x4*)(Z + (size_t)(n_ + j - 1) * (3 * DM) + gI * DM + d0_) : (u32x4){0u, 0u, 0u, 0u}; } } while (0)
    if ((int)blockIdx.x < items) T1_LOAD(blockIdx.x);
    for (int it = blockIdx.x; it < items; it += gridDim.x) {
        const int nt = it / (DM / 64), db = it % (DM / 64), n = nt * 64 + tl, d0 = db * 64 + dc * 8;
        float u[3][8];
#pragma unroll
        for (int gI = 1; gI < 3; ++gI) { const int c0 = gI * DM + d0;
            const f32x4 b0 = *(const f32x4*)(cb + c0), b1 = *(const f32x4*)(cb + c0 + 4);
#pragma unroll
            for (int k = 0; k < 4; ++k) { u[gI][k] = b0[k]; u[gI][4 + k] = b1[k]; }
#pragma unroll
            for (int j = 0; j < 3; ++j) { const u32x4 zz = z[gI][j];
                const f32x4 w0 = *(const f32x4*)(cw + j * 3 * DM + c0) * zr[j], w1 = *(const f32x4*)(cw + j * 3 * DM + c0 + 4) * zr[j];
                u[gI][0] += bflo(zz.x) * w0[0]; u[gI][1] += bfhi(zz.x) * w0[1]; u[gI][2] += bflo(zz.y) * w0[2]; u[gI][3] += bfhi(zz.y) * w0[3];
                u[gI][4] += bflo(zz.z) * w1[0]; u[gI][5] += bfhi(zz.z) * w1[1]; u[gI][6] += bflo(zz.w) * w1[2]; u[gI][7] += bfhi(zz.w) * w1[3]; } }
        u32x4 vx; vx.x = pk2(u[2][0] * u[1][0], u[2][1] * u[1][1]); vx.y = pk2(u[2][2] * u[1][2], u[2][3] * u[1][3]); vx.z = pk2(u[2][4] * u[1][4], u[2][5] * u[1][5]); vx.w = pk2(u[2][6] * u[1][6], u[2][7] * u[1][7]);
        __syncthreads();
        *(LAS u32x4*)(lds + tl * 144 + dc * 16) = vx;
        if (it + (int)gridDim.x < items) T1_LOAD(it + gridDim.x);
        __syncthreads();
        { const unsigned a0 = (unsigned)(size_t)(lds + (32 * (wv >> 2) + 8 * grp + (li >> 2)) * 144 + (16 * (wv & 3) + 4 * (li & 3)) * 2);
            s16x4 lo = tr_rd(a0), hi = tr_rd(a0 + 4 * 144);
            asm volatile("s_waitcnt lgkmcnt(0)" : "+v"(lo), "+v"(hi) :: "memory");
            const int bidx = (nt * 64) / SEQ, t0 = (nt * 64) & (SEQ - 1);
            const bf16x8 ov = (bf16x8){lo[0], lo[1], lo[2], lo[3], hi[0], hi[1], hi[2], hi[3]};
            *(bf16x8*)(VT + ((size_t)bidx * DM + db * 64 + 16 * (wv & 3) + li) * SEQ + t0 + 32 * (wv >> 2) + 8 * grp) = ov; }
    }
#undef T1_LOAD
}

constexpr int LC_KR0 = 0, LC_KR1 = 16384 + 64, LC_V = 33024, LC_VROW = 2176;
__device__ __forceinline__ int lc_vrow_byte(int b) { return (b * LC_VROW + 4 * (b & 3)) * 4; }
__device__ __forceinline__ bf16x8 lc_ld_a(const LAS unsigned char* p) {
    const unsigned w0 = *(const LAS unsigned*)(p), w1 = *(const LAS unsigned*)(p + 4), w2 = *(const LAS unsigned*)(p + 8), w3 = *(const LAS unsigned*)(p + 12);
    u32x4 w = {w0, w1, w2, w3}; return __builtin_bit_cast(bf16x8, w);
}
__device__ __forceinline__ void longconv_phase(const int wv_, const bf16* KRB, const bf16* VT, const float* skip, bf16* YST, LAS unsigned char* lds) {
    const int tid = TIDX, lane = tid & 63, wid = wv_, r32 = lane & 31, hi = lane >> 5;
    for (int i = tid; i < 8 * 192; i += NTHREADS) { const int b = i / 192, j = i % 192, sp = j < 96 ? j : 4096 + j;
        *(LAS bf16*)(lds + LC_V + lc_vrow_byte(b) + 2 * sp) = 0; }
    const int T0 = 512 * wid, P = 4095 - T0 - r32 + 8 * hi, cpy = P & 1;
    const int Al = (cpy ? LC_KR1 : LC_KR0) + 2 * (P - cpy) - 960;
    const int q = r32 >> 3, bb = r32 & 7, Vl = LC_V + lc_vrow_byte(bb) + 64 * q + 16 * hi;
    u32x4 pk0, pk1, pk2_, pk3, vr[8];
#define LC_LOAD(dd) do { const u32x4* k0 = (const u32x4*)(KRB + (size_t)(dd) * 8192), * k1 = (const u32x4*)(KRB + (size_t)DM * 8192 + (size_t)(dd) * 8192); \
        pk0 = k0[tid]; pk1 = k0[tid + 512]; pk2_ = k1[tid]; pk3 = k1[tid + 512]; \
        _Pragma("unroll") for (int i = 0; i < 8; ++i) vr[i] = *((const u32x4*)(VT + ((size_t)i * DM + (dd)) * SEQ) + tid); } while (0)
    if ((int)blockIdx.x < DM) LC_LOAD(blockIdx.x);
    for (int d = blockIdx.x; d < DM; d += gridDim.x) {
        __syncthreads();
        *(LAS u32x4*)(lds + LC_KR0 + tid * 16) = pk0; *(LAS u32x4*)(lds + LC_KR0 + (tid + 512) * 16) = pk1;
        *(LAS u32x4*)(lds + LC_KR1 + tid * 16) = pk2_; *(LAS u32x4*)(lds + LC_KR1 + (tid + 512) * 16) = pk3;
#pragma unroll
        for (int i = 0; i < 8; ++i) *(LAS u32x4*)(lds + LC_V + lc_vrow_byte(i) + 192 + tid * 16) = vr[i];
        __syncthreads();
        if (d + (int)gridDim.x < DM) LC_LOAD(d + gridDim.x);
        f32x16 acc[4];
#pragma unroll
        for (int g = 0; g < 4; ++g)
#pragma unroll
            for (int r = 0; r < 16; ++r) acc[g][r] = 0.f;
        for (int a = 0; a < 8; ++a) {
            const LAS unsigned char* ab = lds + Al + 1024 * a; const LAS unsigned char* vb = lds + Vl + 1024 * a;
#pragma unroll
            for (int u = 0; u < 8; ++u) {
                bf16x8 At[7], Bt[4];
#pragma unroll
                for (int jp = 0; jp < 7; ++jp) At[jp] = lc_ld_a(ab + 768 + 32 * u - 256 * (jp - 3));
#pragma unroll
                for (int h = 0; h < 4; ++h) Bt[h] = *(const LAS bf16x8*)(vb + 32 * u + 256 * h);
#pragma unroll
                for (int h = 0; h < 4; ++h)
#pragma unroll
                    for (int g = 0; g < 4; ++g) acc[g] = __builtin_amdgcn_mfma_f32_32x32x16_bf16(At[g - h + 3], Bt[h], acc[g], 0, 0, 0);
            }
        }
        { const LAS unsigned char* ab = lds + Al + 8192; const LAS unsigned char* vb = lds + Vl + 8192;
#pragma unroll
            for (int u = 0; u < 6; ++u) {
                const bf16x8 B0 = *(const LAS bf16x8*)(vb + 32 * u);
#pragma unroll
                for (int g = 0; g < 4; ++g) { const bf16x8 A0 = lc_ld_a(ab + 768 + 32 * u - 256 * g); acc[g] = __builtin_amdgcn_mfma_f32_32x32x16_bf16(A0, B0, acc[g], 0, 0, 0); }
            } }
        const float sk = skip[d];
#pragma unroll
        for (int g = 0; g < 4; ++g)
#pragma unroll
            for (int rr = 0; rr < 4; ++rr) { const int t = T0 + 128 * g + 32 * q + 8 * rr + 4 * hi;
                const u32x2 vv = *(const LAS u32x2*)(lds + LC_V + lc_vrow_byte(bb) + (96 + t) * 2);
                u32x2 o; o.x = pk2(acc[g][4 * rr + 0] + bflo(vv.x) * sk, acc[g][4 * rr + 1] + bfhi(vv.x) * sk); o.y = pk2(acc[g][4 * rr + 2] + bflo(vv.y) * sk, acc[g][4 * rr + 3] + bfhi(vv.y) * sk);
                *(u32x2*)(YST + ((size_t)bb * DM + d) * SEQ + t) = o; }
    }
#undef LC_LOAD
}

__device__ __forceinline__ void hy_thin2_phase(const int wv_, const bf16* YST, const bf16* Z, const float* cw  , const float* cb  , const float* RSTD, bf16* G, LAS unsigned char* lds) {
    const int tid = TIDX, dl = tid >> 3, tc = tid & 7, lane = tid & 63, wv = wv_, grp = lane >> 4, li = lane & 15;
    constexpr int items = (NTOK / 64) * (DM / 64), NI = 4, TILE = 64 * 144;
    u32x4 yv[NI];
#define T2_LOAD(g_) do { _Pragma("unroll") for (int k = 0; k < NI; ++k) { const int it_ = (g_) * NI + k; if (it_ < items) { const int nt_ = it_ / (DM / 64), db_ = it_ % (DM / 64), bi_ = (nt_ * 64) / SEQ, t0_ = (nt_ * 64) & (SEQ - 1); \
        yv[k] = *(const u32x4*)(YST + ((size_t)bi_ * DM + db_ * 64 + dl) * SEQ + t0_ + tc * 8); } } } while (0)
    if ((int)blockIdx.x * NI < items) T2_LOAD(blockIdx.x);
    for (int gi = blockIdx.x; gi * NI < items; gi += gridDim.x) {
        u32x4 zq[NI][3]; float zs[NI][3]; size_t goff[NI]; int dq[NI];
#pragma unroll
        for (int k = 0; k < NI; ++k) { const int it = gi * NI + k < items ? gi * NI + k : items - 1; const int nt = it / (DM / 64), db = it % (DM / 64);
            const int n = nt * 64 + 16 * (wv & 3) + li, t = n & (SEQ - 1); dq[k] = db * 64 + 32 * (wv >> 2) + 8 * grp; goff[k] = (size_t)n * DM + dq[k];
#pragma unroll
            for (int j = 0; j < 3; ++j) { const int tt = t + j - 1; const bool ok = tt >= 0 && tt < SEQ;
                zq[k][j] = ok ? *(const u32x4*)(Z + (size_t)(n + j - 1) * (3 * DM) + dq[k]) : (u32x4){0u, 0u, 0u, 0u}; zs[k][j] = ok ? RSTD[n + j - 1] : 0.f; } }
        __syncthreads();
#pragma unroll
        for (int k = 0; k < NI; ++k) *(LAS u32x4*)(lds + k * TILE + dl * 144 + tc * 16) = yv[k];
        if ((gi + (int)gridDim.x) * NI < items) T2_LOAD(gi + gridDim.x);
        __syncthreads();
        const unsigned a0 = (unsigned)(size_t)(lds + (32 * (wv >> 2) + 8 * grp + (li >> 2)) * 144 + (16 * (wv & 3) + 4 * (li & 3)) * 2);
#pragma unroll
        for (int k = 0; k < NI; ++k) {
            s16x4 lo = tr_rd(a0 + k * TILE), hi = tr_rd(a0 + k * TILE + 4 * 144);
            asm volatile("s_waitcnt lgkmcnt(0)" : "+v"(lo), "+v"(hi) :: "memory");
            const u32x2 l2 = __builtin_bit_cast(u32x2, lo), h2 = __builtin_bit_cast(u32x2, hi);
            float x[8]; { const f32x4 b0 = *(const f32x4*)(cb + dq[k]), b1 = *(const f32x4*)(cb + dq[k] + 4);
#pragma unroll
                for (int e = 0; e < 4; ++e) { x[e] = b0[e]; x[4 + e] = b1[e]; } }
#pragma unroll
            for (int j = 0; j < 3; ++j) { const u32x4 zz = zq[k][j]; const f32x4 w0 = *(const f32x4*)(cw + j * 3 * DM + dq[k]) * zs[k][j], w1 = *(const f32x4*)(cw + j * 3 * DM + dq[k] + 4) * zs[k][j];
                x[0] += bflo(zz.x) * w0[0]; x[1] += bfhi(zz.x) * w0[1]; x[2] += bflo(zz.y) * w0[2]; x[3] += bfhi(zz.y) * w0[3];
                x[4] += bflo(zz.z) * w1[0]; x[5] += bfhi(zz.z) * w1[1]; x[6] += bflo(zz.w) * w1[2]; x[7] += bfhi(zz.w) * w1[3]; }
            u32x4 o; o.x = pk2(bflo(l2.x) * x[0], bfhi(l2.x) * x[1]); o.y = pk2(bflo(l2.y) * x[2], bfhi(l2.y) * x[3]);
            o.z = pk2(bflo(h2.x) * x[4], bfhi(h2.x) * x[5]); o.w = pk2(bflo(h2.y) * x[6], bfhi(h2.y) * x[7]);
            if (gi * NI + k < items) *(u32x4*)(G + goff[k]) = o; }
    }
#undef T2_LOAD
}

__device__ __forceinline__ void mla_thin1_phase(const int wv_, const bf16* DOWN, const float* qn, const float* kvn, bf16* CQ, bf16* CKV, const float* RSTD) {
    const int lane = TIDX & 63, wid = wv_;
    constexpr int NR = 4;
    for (int rg = blockIdx.x * NWAVES + wid; rg < NTOK / NR; rg += gridDim.x * NWAVES) {
        u32x2 va[NR][2], vb[NR][2];
#pragma unroll
        for (int r = 0; r < NR; ++r)
#pragma unroll
            for (int part = 0; part < 2; ++part) { const bf16* dp = DOWN + (size_t)(rg * NR + r) * NDOWNP + part * 512; va[r][part] = *(const u32x2*)(dp + lane * 4); vb[r][part] = *(const u32x2*)(dp + 256 + lane * 4); }
#pragma unroll
        for (int r = 0; r < NR; ++r)
#pragma unroll
            for (int part = 0; part < 2; ++part) { const int row = rg * NR + r; const float rsx = RSTD[row]; const u32x2 ua = va[r][part], ub = vb[r][part];
                const f32x4 a = (f32x4){bflo(ua.x), bfhi(ua.x), bflo(ua.y), bfhi(ua.y)} * rsx, b = (f32x4){bflo(ub.x), bfhi(ub.x), bflo(ub.y), bfhi(ub.y)} * rsx;
                float ss = a[0] * a[0] + a[1] * a[1] + a[2] * a[2] + a[3] * a[3] + b[0] * b[0] + b[1] * b[1] + b[2] * b[2] + b[3] * b[3];
                ss = wave_sum(ss); const float rs = 1.0f / sqrtf(ss * (1.0f / 512.0f) + EPS);
                const float* gn = part ? kvn : qn; const f32x4 ga = *(const f32x4*)(gn + lane * 4), gb = *(const f32x4*)(gn + 256 + lane * 4);
                bf16* o = (part ? CKV : CQ) + (size_t)row * 512;
                u32x2 oa, ob; oa.x = pk2(a[0] * rs * ga[0], a[1] * rs * ga[1]); oa.y = pk2(a[2] * rs * ga[2], a[3] * rs * ga[3]);
                ob.x = pk2(b[0] * rs * gb[0], b[1] * rs * gb[1]); ob.y = pk2(b[2] * rs * gb[2], b[3] * rs * gb[3]);
                *(u32x2*)(o + lane * 4) = oa; *(u32x2*)(o + 256 + lane * 4) = ob; }
    }
}
__device__ __forceinline__ void mla_thin2_phase(const int wv_, const bf16* QRAW, const bf16* KVRAW, const bf16* DOWN, const float* qg, const float* kg, const f32x2* ROPE, bf16* Q, bf16* K, const float* RSTD) {
    const int lane = TIDX & 63, wid = wv_, grp = lane >> 5, j = lane & 31, jc = j < 24 ? j : 23;
    const bool act = j < 24, isrope = j >= 16 && j < 24, isx2 = j >= 20;
    float qgv[8], kgv[8];
#pragma unroll
    for (int k = 0; k < 8; ++k) { qgv[k] = qg[8 * jc + k]; kgv[k] = kg[8 * jc + k]; }
    for (int row = blockIdx.x * NWAVES + wid; row < NTOK; row += gridDim.x * NWAVES) {
        const int t = row & (SEQ - 1);
        float cs[8], sn[8], kr[8];
#pragma unroll
        for (int k = 0; k < 8; ++k) { cs[k] = 1.f; sn[k] = 0.f; kr[k] = 0.f; }
        if (isrope) { const f32x4* rp = (const f32x4*)(ROPE + (size_t)t * 32 + 8 * ((j - 16) & 3));
            const f32x4 r0 = rp[0], r1 = rp[1], r2 = rp[2], r3 = rp[3];
            cs[0] = r0[0]; sn[0] = r0[1]; cs[1] = r0[2]; sn[1] = r0[3]; cs[2] = r1[0]; sn[2] = r1[1]; cs[3] = r1[2]; sn[3] = r1[3];
            cs[4] = r2[0]; sn[4] = r2[1]; cs[5] = r2[2]; sn[5] = r2[3]; cs[6] = r3[0]; sn[6] = r3[1]; cs[7] = r3[2]; sn[7] = r3[3];
            const u32x4 k0 = *(const u32x4*)(DOWN + (size_t)row * NDOWNP + 1024 + 8 * (j - 16));
            kr[0] = bflo(k0.x); kr[1] = bfhi(k0.x); kr[2] = bflo(k0.y); kr[3] = bfhi(k0.y); kr[4] = bflo(k0.z); kr[5] = bfhi(k0.z); kr[6] = bflo(k0.w); kr[7] = bfhi(k0.w);
            { const float rsx = RSTD[row];
#pragma unroll
                for (int k = 0; k < 8; ++k) kr[k] *= rsx; }
            if (!isx2) {
#pragma unroll
                for (int k = 0; k < 8; ++k) sn[k] = -sn[k]; } }
        u32x4 kx[NH / 2];
#pragma unroll
        for (int hp = 0; hp < NH / 2; ++hp) { const int h = 2 * hp + grp;
            kx[hp] = *(const u32x4*)(KVRAW + (size_t)row * 4096 + h * 256 + 8 * (j < 16 ? j : 0)); }
#pragma unroll
        for (int hp = 0; hp < NH / 2; ++hp) {
            const int h = 2 * hp + grp;
#pragma unroll
            for (int qk = 1; qk < 2; ++qk) {
                float v[8]; const u32x4 x = kx[hp];
                v[0] = bflo(x.x); v[1] = bfhi(x.x); v[2] = bflo(x.y); v[3] = bfhi(x.y); v[4] = bflo(x.z); v[5] = bfhi(x.z); v[6] = bflo(x.w); v[7] = bfhi(x.w);
                if (qk == 1 && j >= 16) {
#pragma unroll
                    for (int k = 0; k < 8; ++k) v[k] = kr[k]; }
                float ss = 0.f;
#pragma unroll
                for (int k = 0; k < 8; ++k) ss += v[k] * v[k];
                ss = act ? ss : 0.f;
                ss += __shfl_xor(ss, 1); ss += __shfl_xor(ss, 2); ss += __shfl_xor(ss, 4); ss += __shfl_xor(ss, 8); ss += __shfl_xor(ss, 16);
                const float rs = 1.0f / sqrtf(ss * (1.0f / 192.0f) + EPS);
                float o[8];
#pragma unroll
                for (int k = 0; k < 8; ++k) { const float n = v[k] * rs * (qk == 0 ? qgv[k] : kgv[k]); const float pr = __shfl_xor(n, 4); o[k] = n * cs[k] + pr * sn[k]; }
                if (act) { u32x4 w; w.x = pk2(o[0], o[1]); w.y = pk2(o[2], o[3]); w.z = pk2(o[4], o[5]); w.w = pk2(o[6], o[7]);
                    *(u32x4*)((qk == 0 ? Q : K) + (size_t)row * 3072 + h * DQK + 8 * j) = w; }
            }
        }
    }
}

namespace attn {
constexpr int KVBLK = 64, QBLK = 32;
constexpr float SCALE = 0.07216878364870322f;
constexpr float THR = 8.f;
constexpr int LDQ = 3072, LDK = 3072, LDV = 4096, LDO = 2048;
constexpr int SHM_V = KVBLK * DV * 2, SHM_K = KVBLK * DQK * 2;
#define KSWZ(row, colB) ((row) * 384 + ((colB) ^ ((((row) >> 1) & 7) << 4)))
#define SBAR() __builtin_amdgcn_sched_barrier(0)
__device__ __forceinline__ unsigned cvtpk(float lo, float hi) { unsigned r; asm volatile("v_cvt_pk_bf16_f32 %0, %1, %2" : "=v"(r) : "v"(lo), "v"(hi)); return r; }
__device__ __forceinline__ void partialSM(f32x16& p0, f32x16& p1, float& m_reg, float& mn, float& alpha) {
    constexpr float C = SCALE * 1.4426950408889634f;
    float pmax = p0[0];
#pragma unroll
    for (int r = 1; r < 16; ++r) pmax = fmaxf(pmax, p0[r]);
#pragma unroll
    for (int r = 0; r < 16; ++r) pmax = fmaxf(pmax, p1[r]);
    { auto rr = __builtin_amdgcn_permlane32_swap(__float_as_uint(pmax), __float_as_uint(pmax), false, false);
      pmax = fmaxf(__uint_as_float(rr[0]), __uint_as_float(rr[1])); }
    if (__builtin_expect(__all(pmax - m_reg <= THR / SCALE), 1)) { mn = m_reg; alpha = 1.f; }
    else { mn = fmaxf(m_reg, pmax); alpha = __builtin_amdgcn_exp2f((m_reg - mn) * C); m_reg = mn; }
    const float mnC = -mn * C;
#pragma unroll
    for (int r = 0; r < 16; ++r) p0[r] = fmaf(p0[r], C, mnC);
#pragma unroll
    for (int r = 0; r < 16; ++r) p1[r] = fmaf(p1[r], C, mnC);
#pragma unroll
    for (int r = 0; r < 16; ++r) p0[r] = __builtin_amdgcn_exp2f(p0[r]);
}
__device__ __forceinline__ void finishSM(f32x16& p0, f32x16& p1, float alpha, float& l_reg, bf16x8& pa0, bf16x8& pa1, bf16x8& pa2, bf16x8& pa3) {
#pragma unroll
    for (int r = 0; r < 16; ++r) p1[r] = __builtin_amdgcn_exp2f(p1[r]);
    float ps = 0;
#pragma unroll
    for (int r = 0; r < 16; ++r) ps += p0[r];
#pragma unroll
    for (int r = 0; r < 16; ++r) ps += p1[r];
    { auto rr = __builtin_amdgcn_permlane32_swap(__float_as_uint(ps), __float_as_uint(ps), false, false);
      ps = __uint_as_float(rr[0]) + __uint_as_float(rr[1]); }
    l_reg = l_reg * alpha + ps;
#define PK4(P, BASE, OUT) do { unsigned a0 = cvtpk(P[BASE + 0], P[BASE + 1]), a1 = cvtpk(P[BASE + 2], P[BASE + 3]);   \
    unsigned b0 = cvtpk(P[BASE + 4], P[BASE + 5]), b1 = cvtpk(P[BASE + 6], P[BASE + 7]);                              \
    auto r0 = __builtin_amdgcn_permlane32_swap(a0, b0, false, false); auto r1 = __builtin_amdgcn_permlane32_swap(a1, b1, false, false); \
    u32x4 w = {r0[0], r1[0], r0[1], r1[1]}; OUT = __builtin_bit_cast(bf16x8, w); } while (0)
    PK4(p0, 0, pa0); PK4(p0, 8, pa1); PK4(p1, 0, pa2); PK4(p1, 8, pa3);
#undef PK4
}
__device__ __forceinline__ void qkt(f32x16& p0, f32x16& p1, const LAS unsigned char* Ks, const bf16x8* qr, int r32, int hi) {
#pragma unroll
    for (int i = 0; i < 16; ++i) { p0[i] = 0.f; p1[i] = 0.f; }
#pragma unroll
    for (int d0 = 0; d0 < 12; ++d0) { const int cb = (d0 * 16 + hi * 8) * 2;
        const bf16x8 b0 = *(const LAS bf16x8*)(Ks + KSWZ(r32, cb));
        const bf16x8 b1 = *(const LAS bf16x8*)(Ks + KSWZ(32 + r32, cb));
        p0 = __builtin_amdgcn_mfma_f32_32x32x16_bf16(b0, qr[d0], p0, 0, 0, 0);
        p1 = __builtin_amdgcn_mfma_f32_32x32x16_bf16(b1, qr[d0], p1, 0, 0, 0); }
}
__device__ __forceinline__ int v_st(int k, int c) { const int kk = (k & ~0xC) | ((k & 4) << 1) | ((k & 8) >> 1); return ((kk >> 3) * 4 + (c >> 5)) * 512 + ((kk & 7) * 32 + (c & 31)) * 2; }
__device__ __forceinline__ int v_rd_base(int lane) { return ((lane & 3) << 3) | (((lane >> 2) & 3) << 6) | (((lane >> 4) & 1) << 5) | (((lane >> 5) & 1) << 8); }
constexpr int v_rd_off(int d0, int ks, int half) { return d0 * 512 + ks * 4096 + half * 2048; }
template <int OFF> __device__ __forceinline__ s16x4 tr_read(int vb) {
    s16x4 r; asm volatile("ds_read_b64_tr_b16 %0, %1 offset:%2" : "=&v"(r) : "v"(vb), "i"(OFF) : "memory"); return r;
}
template <int D0> __device__ __forceinline__ void pv_one(f32x16& od, int vb, bf16x8 pa0, bf16x8 pa1, bf16x8 pa2, bf16x8 pa3) {
    const s16x4 l0 = tr_read<v_rd_off(D0, 0, 0)>(vb), h0 = tr_read<v_rd_off(D0, 0, 1)>(vb), l1 = tr_read<v_rd_off(D0, 1, 0)>(vb), h1 = tr_read<v_rd_off(D0, 1, 1)>(vb);
    const s16x4 l2 = tr_read<v_rd_off(D0, 2, 0)>(vb), h2 = tr_read<v_rd_off(D0, 2, 1)>(vb), l3 = tr_read<v_rd_off(D0, 3, 0)>(vb), h3 = tr_read<v_rd_off(D0, 3, 1)>(vb);
    asm volatile("s_waitcnt lgkmcnt(0)" ::: "memory"); SBAR();
#define PKV(L, H) (bf16x8){L[0], L[1], L[2], L[3], H[0], H[1], H[2], H[3]}
    od = __builtin_amdgcn_mfma_f32_32x32x16_bf16(pa0, PKV(l0, h0), od, 0, 0, 0);
    od = __builtin_amdgcn_mfma_f32_32x32x16_bf16(pa1, PKV(l1, h1), od, 0, 0, 0);
    od = __builtin_amdgcn_mfma_f32_32x32x16_bf16(pa2, PKV(l2, h2), od, 0, 0, 0);
    od = __builtin_amdgcn_mfma_f32_32x32x16_bf16(pa3, PKV(l3, h3), od, 0, 0, 0);
#undef PKV
}
__device__ __forceinline__ void pv_d0(f32x16* o, int vb, bf16x8 pa0, bf16x8 pa1, bf16x8 pa2, bf16x8 pa3) {
    pv_one<0>(o[0], vb, pa0, pa1, pa2, pa3); pv_one<1>(o[1], vb, pa0, pa1, pa2, pa3); pv_one<2>(o[2], vb, pa0, pa1, pa2, pa3); pv_one<3>(o[3], vb, pa0, pa1, pa2, pa3);
}
__device__ __forceinline__ void unit(const int wv_, const bf16* __restrict__ Qb, const bf16* __restrict__ Kh, const bf16* __restrict__ Vh, bf16* __restrict__ Ob, int seq, LAS unsigned char* lds,
                                     const float* __restrict__ qg, const f32x2* __restrict__ ROPE, int t0) {
    const int tid = TIDX, wid = wv_, lane = tid & 63, r32 = lane & 31, hi = lane >> 5;
    LAS unsigned char* V_lds = lds; LAS unsigned char* K_lds = lds + 3 * SHM_V;
    LAS float* ws = (LAS float*)(lds + 3 * SHM_V + 3 * SHM_K) + wid * 64; LAS float* li_l = ws; LAS float* al_l = ws + 32;
    float m_reg = -1e30f, l_reg = 0; f32x16 o[4]; bf16x8 qr[12];
#pragma unroll
    for (int d = 0; d < 4; ++d)
#pragma unroll
        for (int r = 0; r < 16; ++r) o[d][r] = 0.f;
    const bf16* Qw = Qb + (long)(wid * QBLK + r32) * LDQ + hi * 8;
#pragma unroll
    for (int d0 = 0; d0 < 12; ++d0) qr[d0] = *(const bf16x8*)(Qw + d0 * 16);
    const int wu = wv_;
    int koff[3], voff[2];
#pragma unroll
    for (int i = 0; i < 3; ++i) { const int p = (i * 8 + wid) * 64 + lane, row = p / 24, cidx = p % 24; koff[i] = row * LDK + ((cidx ^ ((row >> 1) & 7)) * 8); }
#pragma unroll
    for (int i = 0; i < 2; ++i) { const int p = (i * 8 + wid) * 64 + lane, sub = p >> 5, q5 = p & 31, kk = (sub >> 2) * 8 + (q5 >> 2), k = (kk & ~0xC) | ((kk & 4) << 1) | ((kk & 8) >> 1), c = (sub & 3) * 32 + (q5 & 3) * 8;
        voff[i] = k * LDV + c; }
    const int vb0 = (int)(uintptr_t)V_lds + v_rd_base(lane);
#define DMA_TILE(b, k0) do { const bf16* Kt_ = Kh + (long)(k0) * LDK; const bf16* Vt_ = Vh + (long)(k0) * LDV; \
    _Pragma("unroll") for (int i = 0; i < 3; ++i) __builtin_amdgcn_global_load_lds((const GAS unsigned*)(Kt_ + koff[i]), (LAS unsigned*)(K_lds + (b) * SHM_K + (i * 8 + wu) * 1024), 16, 0, 0); \
    _Pragma("unroll") for (int i = 0; i < 2; ++i) __builtin_amdgcn_global_load_lds((const GAS unsigned*)(Vt_ + voff[i]), (LAS unsigned*)(V_lds + (b) * SHM_V + (i * 8 + wu) * 1024), 16, 0, 0); } while (0)
#define RESC(a) do { if (__any((a) < 1.f)) { if (hi == 0) al_l[r32] = (a); asm volatile("s_waitcnt lgkmcnt(0)" ::: "memory"); \
    _Pragma("unroll") for (int d = 0; d < 4; ++d) _Pragma("unroll") for (int r = 0; r < 16; ++r) o[d][r] *= al_l[crow(r, hi)]; } } while (0)
    f32x16 pA0, pA1, pB0, pB1; float mnA, mnB, alA, alB; bf16x8 pa0, pa1, pa2, pa3; const int NT = seq / KVBLK;
#define VMWAIT() asm volatile("s_waitcnt vmcnt(0)" ::: "memory")
    __syncthreads();
    DMA_TILE(0, 0);
    {
        float ss = 0.f;
#pragma unroll
        for (int d0 = 0; d0 < 12; ++d0) { const u32x4 w = __builtin_bit_cast(u32x4, qr[d0]);
            const float a0 = bflo(w.x), a1 = bfhi(w.x), a2 = bflo(w.y), a3 = bfhi(w.y), a4 = bflo(w.z), a5 = bfhi(w.z), a6 = bflo(w.w), a7 = bfhi(w.w);
            ss += a0 * a0 + a1 * a1 + a2 * a2 + a3 * a3 + a4 * a4 + a5 * a5 + a6 * a6 + a7 * a7; }
        ss += __shfl_xor(ss, 32);
        const float rs = 1.0f / sqrtf(ss * (1.0f / 192.0f) + EPS);
#pragma unroll
        for (int d0 = 0; d0 < 8; ++d0) { const u32x4 w = __builtin_bit_cast(u32x4, qr[d0]); const f32x4 g0 = *(const f32x4*)(qg + d0 * 16 + hi * 8) * rs, g1 = *(const f32x4*)(qg + d0 * 16 + hi * 8 + 4) * rs;
            u32x4 o_; o_.x = cvtpk(bflo(w.x) * g0[0], bfhi(w.x) * g0[1]); o_.y = cvtpk(bflo(w.y) * g0[2], bfhi(w.y) * g0[3]); o_.z = cvtpk(bflo(w.z) * g1[0], bfhi(w.z) * g1[1]); o_.w = cvtpk(bflo(w.w) * g1[2], bfhi(w.w) * g1[3]);
            qr[d0] = __builtin_bit_cast(bf16x8, o_); }
        const f32x2* rp = ROPE + (size_t)(t0 + wid * QBLK + r32) * 32 + hi * 8;
#pragma unroll
        for (int d0 = 8; d0 < 10; ++d0) { const u32x4 wa = __builtin_bit_cast(u32x4, qr[d0]), wb = __builtin_bit_cast(u32x4, qr[d0 + 2]);
            float a[8], b[8], oa[8], ob[8];
            a[0] = bflo(wa.x); a[1] = bfhi(wa.x); a[2] = bflo(wa.y); a[3] = bfhi(wa.y); a[4] = bflo(wa.z); a[5] = bfhi(wa.z); a[6] = bflo(wa.w); a[7] = bfhi(wa.w);
            b[0] = bflo(wb.x); b[1] = bfhi(wb.x); b[2] = bflo(wb.y); b[3] = bfhi(wb.y); b[4] = bflo(wb.z); b[5] = bfhi(wb.z); b[6] = bflo(wb.w); b[7] = bfhi(wb.w);
#pragma unroll
            for (int j4 = 0; j4 < 2; ++j4) { const f32x4 ga = *(const f32x4*)(qg + d0 * 16 + hi * 8 + 4 * j4) * rs, gb = *(const f32x4*)(qg + (d0 + 2) * 16 + hi * 8 + 4 * j4) * rs;
                const f32x4 c01 = *(const f32x4*)(rp + (d0 - 8) * 16 + 4 * j4), c23 = *(const f32x4*)(rp + (d0 - 8) * 16 + 4 * j4 + 2);
#pragma unroll
                for (int jj = 0; jj < 4; ++jj) { const int j = 4 * j4 + jj; const float cs = jj < 2 ? c01[2 * jj] : c23[2 * (jj - 2)], sn = jj < 2 ? c01[2 * jj + 1] : c23[2 * (jj - 2) + 1];
                    const float na = a[j] * ga[jj], nb = b[j] * gb[jj]; oa[j] = na * cs - nb * sn; ob[j] = nb * cs + na * sn; } }
            u32x4 pa_, pb_; pa_.x = cvtpk(oa[0], oa[1]); pa_.y = cvtpk(oa[2], oa[3]); pa_.z = cvtpk(oa[4], oa[5]); pa_.w = cvtpk(oa[6], oa[7]);
            pb_.x = cvtpk(ob[0], ob[1]); pb_.y = cvtpk(ob[2], ob[3]); pb_.z = cvtpk(ob[4], ob[5]); pb_.w = cvtpk(ob[6], ob[7]);
            qr[d0] = __builtin_bit_cast(bf16x8, pa_); qr[d0 + 2] = __builtin_bit_cast(bf16x8, pb_); }
    }
    VMWAIT(); __syncthreads();
    DMA_TILE(1, KVBLK);
    qkt(pA0, pA1, K_lds, qr, r32, hi); partialSM(pA0, pA1, m_reg, mnA, alA);
    VMWAIT(); __syncthreads();
    int bj = 1;
    for (int j = 1; j + 1 < NT; j += 2) {
        const int bp = bj == 0 ? 2 : bj - 1, bn = bj == 2 ? 0 : bj + 1, bnn = bn == 2 ? 0 : bn + 1;
        DMA_TILE(bn, (j + 1) * KVBLK);
        SBAR(); qkt(pB0, pB1, K_lds + bj * SHM_K, qr, r32, hi);
        finishSM(pA0, pA1, alA, l_reg, pa0, pa1, pa2, pa3); SBAR();
        pv_d0(o, vb0 + bp * SHM_V, pa0, pa1, pa2, pa3); partialSM(pB0, pB1, m_reg, mnB, alB);
        RESC(alB); VMWAIT(); __syncthreads();
        if (j + 2 < NT) DMA_TILE(bnn, (j + 2) * KVBLK);
        SBAR(); qkt(pA0, pA1, K_lds + bn * SHM_K, qr, r32, hi);
        finishSM(pB0, pB1, alB, l_reg, pa0, pa1, pa2, pa3); SBAR();
        pv_d0(o, vb0 + bj * SHM_V, pa0, pa1, pa2, pa3); partialSM(pA0, pA1, m_reg, mnA, alA);
        RESC(alA); VMWAIT(); __syncthreads();
        bj = bnn;
    }
    {
        const int bp = bj == 0 ? 2 : bj - 1;
        SBAR(); qkt(pB0, pB1, K_lds + bj * SHM_K, qr, r32, hi);
        finishSM(pA0, pA1, alA, l_reg, pa0, pa1, pa2, pa3); SBAR();
        pv_d0(o, vb0 + bp * SHM_V, pa0, pa1, pa2, pa3); partialSM(pB0, pB1, m_reg, mnB, alB);
        RESC(alB);
        finishSM(pB0, pB1, alB, l_reg, pa0, pa1, pa2, pa3); SBAR();
        pv_d0(o, vb0 + bj * SHM_V, pa0, pa1, pa2, pa3);
    }
#undef VMWAIT
    if (hi == 0) li_l[r32] = l_reg; asm volatile("s_waitcnt lgkmcnt(0)" ::: "memory");
    float rli[16];
#pragma unroll
    for (int r = 0; r < 16; ++r) rli[r] = __builtin_amdgcn_rcpf(li_l[crow(r, hi)]);
    bf16* Ow = Ob + (long)(wid * QBLK) * LDO;
#pragma unroll
    for (int r = 0; r < 16; ++r) { const int orow = crow(r, hi);
#pragma unroll
        for (int d0 = 0; d0 < 4; ++d0) Ow[(long)orow * LDO + d0 * 32 + r32] = (bf16)f2bf(o[d0][r] * rli[r]); }
#undef DMA_TILE
#undef RESC
}
}
__device__ __forceinline__ void attn_phase(const int wv_, const bf16* Q, const bf16* K, const bf16* KVRAW, bf16* O, LAS unsigned char* lds, const float* qg, const f32x2* ROPE) {
    const int G = gridDim.x, bx = blockIdx.x; const int vcu = (G % 8 == 0) ? (bx % 8) * (G / 8) + bx / 8 : bx;
    const int units = NBATCH * NH * (SEQ / 256);
    for (int u = vcu; u < units; u += G) {
        const int qb = u % 16, h = (u / 16) % NH, b = u / (16 * NH);
        const size_t row0 = (size_t)b * SEQ;
        attn::unit(wv_, Q + (row0 + qb * 256) * 3072 + h * DQK, K + row0 * 3072 + h * DQK, KVRAW + row0 * 4096 + h * 256 + 128, O + (row0 + qb * 256) * DM + h * DV, SEQ, lds, qg, ROPE, qb * 256);
    }
}

__device__ __forceinline__ void final_phase(const int wv_, float* X, const bf16* ym) {
    const size_t total = (size_t)NTOK * (DM / 4), stride = (size_t)gridDim.x * NTHREADS;
    for (size_t i0 = (size_t)blockIdx.x * NTHREADS + TIDX; i0 < total; i0 += 4 * stride) {
        f32x4 x[4]; u32x2 a[4];
#pragma unroll
        for (int k = 0; k < 4; ++k) { const size_t i = i0 + k * stride; if (i < total) { const size_t row = i / (DM / 4); const int col = (int)(i % (DM / 4)) * 4;
            x[k] = *(const f32x4*)(X + row * DM + col); a[k] = *(const u32x2*)(ym + row * DM + col); } }
#pragma unroll
        for (int k = 0; k < 4; ++k) { const size_t i = i0 + k * stride; if (i < total) { const size_t row = i / (DM / 4); const int col = (int)(i % (DM / 4)) * 4; f32x4 v = x[k];
            v[0] += bflo(a[k].x); v[1] += bfhi(a[k].x); v[2] += bflo(a[k].y); v[3] += bfhi(a[k].y);
            *(f32x4*)(X + row * DM + col) = v; } }
    }
}

struct Args { const float* in[31]; float* out; unsigned char* ws; int ph_lo, ph_hi; };
enum Phase { P_PRO = 0,
    P0_G1, P0_TH, P0_G2, P0_NR, P0_UP, P0_DN,
    P1_G1, P1_T1, P1_LC, P1_T2, P1_G2, P1_NR, P1_UP, P1_DN,
    P2_GD, P2_T1, P2_GU, P2_T2, P2_AT, P2_GO, P2_NR, P2_UP, P2_DN,
    P3_G1, P3_TH, P3_G2, P3_NR, P3_UP, P3_DN,
    N_PHASES };

__device__ __forceinline__ const float* kernarg_ptr(int i) {
    return (const float*)(((volatile const __attribute__((address_space(4))) unsigned long long*)__builtin_amdgcn_kernarg_segment_ptr())[i]);
}
#define INP(i) kernarg_ptr(i)
__global__ void __launch_bounds__(NTHREADS, 2) fwd(Args a) {
    extern __shared__ __attribute__((aligned(16))) unsigned char lds_raw[];
    LAS unsigned char* lds = (LAS unsigned char*)lds_raw;
    const int wv_ = __builtin_amdgcn_readfirstlane((int)threadIdx.x >> 6);
    volatile LAS unsigned* MISC = (volatile LAS unsigned*)(lds + MISC_OFF);
    const int tid = TIDX, lane = tid & 63, wid = wv_;
    unsigned char* ws = (unsigned char*)INP(32);
    unsigned* ctl = (unsigned*)(ws + WS_CTL);
    for (int u = tid; u < (LDS_BYTES - SCR_BYTES) / 4; u += NTHREADS) ((LAS unsigned*)(lds + SCR_BYTES))[u] = 0u;
    __syncthreads();
    XcdBarrier bar = xcd_barrier_post(wv_, ctl + CW_BAR, MISC + 8);
    const int lo = a.ph_lo, hi = a.ph_hi;
#ifndef ONLY_PHASE
#define ONLY_PHASE -1
#endif
#define IN(k) ((ONLY_PHASE < 0 || ONLY_PHASE == (k)) && lo <= (k) && (k) < hi)
#define SEAM(k) do { if (IN(k) && IN((k) + 1)) xcd_barrier(wv_, bar); } while (0)
#define x_in INP(0)
#define X ((float*)INP(31))
#define SCIN ((bf16*)(ws + WS_SCIN))
#define SCOUT ((bf16*)(ws + WS_SCOUT))
#define HYIN ((bf16*)(ws + WS_HYIN))
#define HYOUT ((bf16*)(ws + WS_HYOUT))
#define MDOWN ((bf16*)(ws + WS_MDOWN))
#define MUQ ((bf16*)(ws + WS_MUQ))
#define MUKV ((bf16*)(ws + WS_MUKV))
#define MWO ((bf16*)(ws + WS_MWO))
#define MOEUP ((bf16*)(ws + WS_MOEUP))
#define MOEDN ((bf16*)(ws + WS_MOEDN))
#define KERN ((bf16*)(ws + WS_KERN))
#define H ((bf16*)(ws + WS_H))
#define BIG ((bf16*)(ws + WS_BIG))
#define KVRAW ((bf16*)(ws + WS_KVRAW))
#define YB ((bf16*)(ws + WS_YB))
#define X0 ((bf16*)(ws + WS_X0))
#define VT ((bf16*)(ws + WS_VT))
#define YST ((bf16*)(ws + WS_YST))
#define DOWN ((bf16*)(ws + WS_DOWN))
#define CQ ((bf16*)(ws + WS_CQ))
#define CKV ((bf16*)(ws + WS_CKV))
#define QBUF ((bf16*)(ws + WS_Q))
#define KBUF ((bf16*)(ws + WS_K))
#define LIST ((unsigned*)(ws + WS_LIST))
#define GATE ((float*)(ws + WS_GATE))
#define ACT ((bf16*)(ws + WS_ACT))
#define YM ((bf16*)(ws + WS_YM))
#define RSTDB ((float*)(ws + WS_RSTD))
#define WRS ((bf16*)(ws + WS_WRS))
#define ROPEB ((f32x2*)(ws + WS_ROPE))
#define RECB ((u32x4*)(ws + WS_REC))
#define XS H
#define PARTB ((float*)(ws + WS_YM))
#define ACT2 BIG
#define TOKOF ((unsigned*)(ws + WS_ACT))

    if (IN(P_PRO)) {
        LAS float* scr = (LAS float*)(lds + wid * 16384);
        const int gw = blockIdx.x * NWAVES + wid, NGW = gridDim.x * NWAVES;
        cvt_mats<3, true>(INP(3), 1, DM, 3 * DM, 3 * DM, SCIN, scr, gw, NGW, lane, INP(1), 3 * DM);
        for (int i = blockIdx.x * NTHREADS + tid; i < 4 * 48 * DM; i += gridDim.x * NTHREADS) {
            const int d = i % DM, e = (i / DM) % 48, l = i / (DM * 48);
            float w = e < 8 ? INP(25)[((size_t)l * DM + d) * 8 + e] : (e < 40 ? INP(27)[((size_t)l * DM + d) * 32 + (e - 8)] : 0.f);
            w *= INP(2)[l * DM + d];
            const unsigned wh = f2bf(w); const float wr = w - __builtin_bit_cast(float, wh << 16);
            WRS[((size_t)(l * 2 + 0) * 48 + e) * DM + d] = (bf16)wh; WRS[((size_t)(l * 2 + 1) * 48 + e) * DM + d] = (bf16)f2bf(wr);
        }
        for (int i = blockIdx.x * NTHREADS + tid; i < SEQ * 32; i += gridDim.x * NTHREADS) { const int t = i >> 5, ii = i & 31;
            const float inv = exp2f(-(float)(2 * ii) * (13.287712379549449f / 64.0f)); float sn_, cs_; sincosf((float)t * inv, &sn_, &cs_); ROPEB[i] = (f32x2){cs_, sn_}; }
        __syncthreads();
        filter_phase(wv_, INP(9), INP(10), INP(11), INP(12), INP(13), INP(14), KERN, lds);
        __syncthreads();
        x0_phase(wv_, x_in, XS, RSTDB);
    }
    SEAM(P_PRO);

#define MOE_BLOCK(P, L) \
    if (IN(P)) router_phase(wv_, XS, WRS + (size_t)(L) * 2 * 48 * DM, INP(26) + (L) * 8, INP(28) + (L) * 32, ctl + CW_CNT + (L) * 2048, ctl + CW_CNTB + (L) * 4096, LIST, RECB, lds); \
    SEAM(P); \
    if (IN((P) + 1)) moe_up_phase256(wv_, lds, XS, RECB, MOEUP + (size_t)(L) * NEXP * 1024 * DM, ctl + CW_CNT + (L) * 2048, ctl + CW_CNTB + (L) * 4096, LIST, ACT2, TOKOF, \
        (L) < 3 ? INP(29) + (size_t)((L) + 1) * NEXP * DM * 2 * DFF : nullptr, (L) < 3 ? INP(30) + (size_t)((L) + 1) * NEXP * DFF * DM : nullptr, \
        MOEUP + (size_t)((L) + 1) * NEXP * 1024 * DM, MOEDN + (size_t)((L) + 1) * NEXP * DM * DFF, INP(2) + ((L) + 1) * DM); \
    SEAM((P) + 1); \
    if (IN((P) + 2)) moe_down_phase256<((L) < 3)>(wv_, lds, ACT2, MOEDN + (size_t)(L) * NEXP * DM * DFF, ctl + CW_CNT + (L) * 2048, ctl + CW_CNTB + (L) * 4096, TOKOF, XS, X, PARTB); \
    SEAM((P) + 2);

    if (IN(P0_G1)) {
        const int q_ = blockIdx.x >> 3, r_ = blockIdx.x & 7; const bool split = (gridDim.x & 63) == 0, conv_only = split && (q_ & 7) == 7;
        if (!conv_only) gemm_dense256<pg8::EpiSC, false>(wv_, lds, XS, SCIN, NTOK, 3 * DM, DM, pg8::EpiSC{BIG, BIG + (size_t)NTOK * DM}, split ? (int)gridDim.x / 8 * 7 : 0, ((q_ >> 3) * 7 + (q_ & 7)) * 8 + r_);
        LAS float* scr = (LAS float*)(lds + wid * 16384); unsigned* cj = ctl + CW_CVT;
        unsigned done[10];
#pragma unroll
        for (int j = 0; j < 10; ++j) done[j] = __hip_atomic_load(cj + j * 64, __ATOMIC_RELAXED, __HIP_MEMORY_SCOPE_AGENT);
#define CVT_JOB(j, MODE, GAIN, W, nmat, K, N, NP, WT, gain, gms) do { if (done[j] < (unsigned)((nmat) * ((K) / 64) * ((NP) / 32))) cvt_mats<MODE, GAIN, true>(W, nmat, K, N, NP, WT, scr, 0, 0, lane, gain, gms, cj + (j) * 64); } while (0)
        CVT_JOB(0, 0, false, INP(5), 2, DM, DM, DM, SCOUT, nullptr, 0);
        CVT_JOB(1, 2, true, INP(29), NEXP, DM, 2 * DFF, 2 * DFF, MOEUP, INP(2), 0);
        CVT_JOB(2, 0, false, INP(30), NEXP, DFF, DM, DM, MOEDN, nullptr, 0);
        CVT_JOB(3, 0, true, INP(6), 1, DM, 3 * DM, 3 * DM, HYIN, INP(1) + 1 * DM, 0);
        CVT_JOB(4, 0, false, INP(16), 1, DM, DM, DM, HYOUT, nullptr, 0);
        CVT_JOB(5, 0, true, INP(17), 1, DM, NDOWN, NDOWNP, MDOWN, INP(1) + 2 * DM, 0);
        CVT_JOB(6, 0, false, INP(20), 1, QRANK, NH * DQK, NH * DQK, MUQ, nullptr, 0);
        CVT_JOB(7, 0, false, INP(21), 1, KVRANK, NH * 256, NH * 256, MUKV, nullptr, 0);
        CVT_JOB(8, 0, false, INP(24), 1, DM, DM, DM, MWO, nullptr, 0);
        CVT_JOB(9, 3, true, INP(3) + (size_t)DM * 3 * DM, 1, DM, 3 * DM, 3 * DM, SCIN + (size_t)3 * DM * DM, INP(1) + 3 * DM, 0);
#undef CVT_JOB
    }
    SEAM(P0_G1);
    if (IN(P0_TH)) sc_thin_phase<true>(wv_, BIG, BIG + (size_t)NTOK * DM, INP(4), YB, RSTDB);
    SEAM(P0_TH);
    if (IN(P0_G2)) gemm_dense256<pg8::EpiRes, false>(wv_, lds, YB, SCOUT, NTOK, DM, DM, pg8::EpiRes{XS, XS});
    SEAM(P0_G2);
    MOE_BLOCK(P0_NR, 0)
    if (IN(P1_G1)) { rstd_prepass(wv_, PARTB, RSTDB); gemm_dense256<pg8::EpiBf16, false>(wv_, lds, XS, HYIN, NTOK, 3 * DM, DM, pg8::EpiBf16{BIG, 3 * DM}); }
    SEAM(P1_G1);
    if (IN(P1_T1)) hy_thin1_phase(wv_, BIG, INP(7), INP(8), X0, VT, lds, RSTDB);
    SEAM(P1_T1);
    if (IN(P1_LC)) longconv_phase(wv_, KERN, VT, INP(15), YST, lds);
    SEAM(P1_LC);
    if (IN(P1_T2)) hy_thin2_phase(wv_, YST, BIG, INP(7), INP(8), RSTDB, YB, lds);
    SEAM(P1_T2);
    if (IN(P1_G2)) gemm_dense256<pg8::EpiRes, false>(wv_, lds, YB, HYOUT, NTOK, DM, DM, pg8::EpiRes{XS, XS});
    SEAM(P1_G2);
    MOE_BLOCK(P1_NR, 1)
    if (IN(P2_GD)) { rstd_prepass(wv_, PARTB, RSTDB); gemm_dense256<pg8::EpiBf16, false>(wv_, lds, XS, MDOWN, NTOK, NDOWNP, DM, pg8::EpiBf16{DOWN, NDOWNP}); }
    SEAM(P2_GD);
    if (IN(P2_T1)) mla_thin1_phase(wv_, DOWN, INP(18), INP(19), CQ, CKV, RSTDB);
    SEAM(P2_T1);
    if (IN(P2_GU)) { gemm_dense256<pg8::EpiBf16, false>(wv_, lds, CQ, MUQ, NTOK, NH * DQK, QRANK, pg8::EpiBf16{BIG, NH * DQK}); gemm_dense256<pg8::EpiBf16, false>(wv_, lds, CKV, MUKV, NTOK, NH * 256, KVRANK, pg8::EpiBf16{KVRAW, NH * 256}); }
    SEAM(P2_GU);
    if (IN(P2_T2)) mla_thin2_phase(wv_, BIG, KVRAW, DOWN, INP(22), INP(23), ROPEB, QBUF, KBUF, RSTDB);
    SEAM(P2_T2);
    if (IN(P2_AT)) attn_phase(wv_, BIG, KBUF, KVRAW, YB, lds, INP(22), ROPEB);
    SEAM(P2_AT);
    if (IN(P2_GO)) gemm_dense256<pg8::EpiRes, false>(wv_, lds, YB, MWO, NTOK, DM, DM, pg8::EpiRes{XS, XS});
    SEAM(P2_GO);
    MOE_BLOCK(P2_NR, 2)
    if (IN(P3_G1)) { rstd_prepass(wv_, PARTB, RSTDB); gemm_dense256<pg8::EpiSC, false>(wv_, lds, XS, SCIN + (size_t)3 * DM * DM, NTOK, 3 * DM, DM, pg8::EpiSC{BIG, BIG + (size_t)NTOK * DM}); }
    SEAM(P3_G1);
    if (IN(P3_TH)) sc_thin_phase<true>(wv_, BIG, BIG + (size_t)NTOK * DM, INP(4) + 3 * DM, YB, RSTDB);
    SEAM(P3_TH);
    if (IN(P3_G2)) gemm_dense256<pg8::EpiRes, false>(wv_, lds, YB, SCOUT + (size_t)DM * DM, NTOK, DM, DM, pg8::EpiRes{XS, XS});
    SEAM(P3_G2);
    MOE_BLOCK(P3_NR, 3)
}

#ifndef N_LAUNCHES
#define N_LAUNCHES 1
#endif
extern "C" void kernel_launch(void* const* d_in, const int* in_sizes, int n_in, void* d_out, int out_size, void* d_ws, size_t ws_size, hipStream_t stream) {
    static int grid = 0;
    if (grid == 0) {
        if (n_in != 31 || out_size != NTOK * DM || ws_size < WS_END) { fprintf(stderr, "kernel_launch: bad shapes n_in %d out %d ws %zu (need %zu)\n", n_in, out_size, ws_size, (size_t)WS_END); grid = -1; return; }
        int dev = 0, cus = 0, per_cu = 0;
        if (hipGetDevice(&dev) != hipSuccess || hipDeviceGetAttribute(&cus, hipDeviceAttributeMultiprocessorCount, dev) != hipSuccess) { grid = -1; return; }
        if (hipFuncSetAttribute((const void*)fwd, hipFuncAttributeMaxDynamicSharedMemorySize, LDS_BYTES) != hipSuccess) { fprintf(stderr, "kernel_launch: hipFuncSetAttribute failed\n"); grid = -1; return; }
        if (hipOccupancyMaxActiveBlocksPerMultiprocessor(&per_cu, (const void*)fwd, NTHREADS, LDS_BYTES) != hipSuccess || per_cu < 1) fprintf(stderr, "kernel_launch: occupancy query says %d\n", per_cu);
        (void)hipGetLastError();
        grid = cus;
    }
    if (grid < 0) return;
    if (hipMemsetAsync((char*)d_ws + WS_CTL, 0, CTL_ZERO_BYTES, stream) != hipSuccess) return;
    Args a{};
    for (int i = 0; i < 31; ++i) a.in[i] = (const float*)d_in[i];
    a.out = (float*)d_out; a.ws = (unsigned char*)d_ws;
#if N_LAUNCHES == 1
    a.ph_lo = 0; a.ph_hi = N_PHASES;
    hipLaunchKernelGGL(fwd, dim3(grid), dim3(NTHREADS), LDS_BYTES, stream, a);
#else
    for (int p = 0; p < N_PHASES; ++p) { a.ph_lo = p; a.ph_hi = p + 1; hipLaunchKernelGGL(fwd, dim3(grid), dim3(NTHREADS), LDS_BYTES, stream, a); }
#endif
#ifdef PROBE_LO
    hipMemsetAsync((char*)d_ws + WS_CTL + CW_BAR * 4, 0, XCD_BAR_WORDS * 4, stream);
    a.ph_lo = PROBE_LO; a.ph_hi = PROBE_HI;
    hipLaunchKernelGGL(fwd, dim3(grid), dim3(NTHREADS), LDS_BYTES, stream, a);
#endif
    const hipError_t le = hipPeekAtLastError();
    if (le != hipSuccess) fprintf(stderr, "kernel_launch: launch failed: %s\n", hipGetErrorName(le));
}
```

```cpp
#include <hip/hip_runtime.h>
#include <cstdio>
#include <cstdint>

#define LAS __attribute__((address_space(3)))
#define GAS __attribute__((address_space(1)))
typedef unsigned short bf16;
typedef short bf16x8 __attribute__((ext_vector_type(8)));
typedef short s16x4 __attribute__((ext_vector_type(4)));
typedef float f32x4 __attribute__((ext_vector_type(4)));
typedef float f32x2 __attribute__((ext_vector_type(2)));
typedef float f32x16 __attribute__((ext_vector_type(16)));
typedef unsigned u32x4 __attribute__((ext_vector_type(4)));
typedef unsigned u32x2 __attribute__((ext_vector_type(2)));

constexpr int NTOK = 32768, DM = 2048, SEQ = 4096, NBATCH = 8;
constexpr int NH = 16, DQK = 192, DNOPE = 128, DROPE = 64, DV = 128, QRANK = 512, KVRANK = 512, NDOWN = 1088, NDOWNP = 1280;
constexpr int NEXP = 32, NGRP = 8, EPG = 4, DFF = 512;
constexpr int NTHREADS = 512, NWAVES = 8;
constexpr float EPS = 1e-6f;

constexpr size_t MiB = 1u << 20;
constexpr size_t WS_CTL = 0, CTL_ZERO_BYTES = 1 * MiB;
constexpr size_t WS_SCIN = 4 * MiB;
constexpr size_t WS_SCOUT = 52 * MiB;
constexpr size_t WS_HYIN = 68 * MiB;
constexpr size_t WS_HYOUT = 92 * MiB;
constexpr size_t WS_MDOWN = 100 * MiB;
constexpr size_t WS_MUQ = 106 * MiB;
constexpr size_t WS_MUKV = 109 * MiB;
constexpr size_t WS_MWO = 113 * MiB;
constexpr size_t WS_MOEUP = 128 * MiB;
constexpr size_t WS_MOEDN = 640 * MiB;
constexpr size_t WS_KERN = 896 * MiB;
constexpr size_t WS_H = 960 * MiB;
constexpr size_t WS_BIG = 1088 * MiB;
constexpr size_t WS_KVRAW = WS_BIG + 192 * MiB;
constexpr size_t WS_YB = 1600 * MiB;
constexpr size_t WS_X0 = 1728 * MiB;
constexpr size_t WS_VT = 1856 * MiB;
constexpr size_t WS_YST = 1984 * MiB;
constexpr size_t WS_DOWN = 2112 * MiB;
constexpr size_t WS_CQ = 2272 * MiB;
constexpr size_t WS_CKV = 2304 * MiB;
constexpr size_t WS_Q = 2336 * MiB;
constexpr size_t WS_K = 2528 * MiB;
constexpr size_t WS_LIST = 2720 * MiB;
constexpr size_t WS_GATE = 3064 * MiB;
constexpr size_t WS_ACT = 2726 * MiB;
constexpr size_t WS_YM = 2800 * MiB;
constexpr size_t WS_RSTD = 3068 * MiB;
constexpr size_t WS_WRS = 3058 * MiB;
constexpr size_t WS_ROPE = 3062 * MiB;
constexpr size_t WS_REC = 3072 * MiB;
constexpr size_t WS_END = 3092 * MiB;
constexpr int CW_CNT = 8192;
constexpr int CW_CNTB = 16384;
constexpr int CW_BAR = 4096;

constexpr int SCR_BYTES = 131072;
constexpr int MISC_OFF = SCR_BYTES + 320;
constexpr int LDS_BYTES = 147456;

__device__ __forceinline__ unsigned f2bf(float f) { unsigned u = __builtin_bit_cast(unsigned, f); return (u + 0x7fffu + ((u >> 16) & 1u)) >> 16; }
__device__ __forceinline__ unsigned pk2(float lo, float hi) { unsigned r; asm("v_cvt_pk_bf16_f32 %0, %1, %2" : "=v"(r) : "v"(lo), "v"(hi)); return r; }
__device__ __forceinline__ float bf2f(unsigned short b) { return __builtin_bit_cast(float, ((unsigned)b) << 16); }
__device__ __forceinline__ float bflo(unsigned w) { return __builtin_bit_cast(float, w << 16); }
__device__ __forceinline__ float bfhi(unsigned w) { return __builtin_bit_cast(float, w & 0xffff0000u); }
__device__ __forceinline__ int opaque_i(int x) { asm volatile("" : "+v"(x)); return x; }
__device__ __forceinline__ int lane_mb() { int l; asm volatile("v_mbcnt_lo_u32_b32 %0, -1, 0\n\tv_mbcnt_hi_u32_b32 %0, -1, %0" : "=v"(l)); return l; }
#define TIDX opaque_i((wv_ << 6) | lane_mb())
__device__ __forceinline__ float wave_sum(float v) {
#pragma unroll
    for (int o = 1; o < 64; o <<= 1) v += __shfl_xor(v, o);
    return v;
}
__device__ __forceinline__ int crow(int r, int hi) { return (r & 3) + 8 * (r >> 2) + 4 * hi; }

#define XB_TMO      128
#define XB_XCNT(j)  (256  + 64 * (j))
#define XB_XSUB(j)  (1280 + 64 * (j))
#define XB_XGEN(j)  (2304 + 64 * (j))
#define XB_TOP      3328
#define XB_TOPGEN   3392
#define XCD_BAR_WORDS 3456
#define XB_SPIN_CAP (1u << 22)
__device__ __forceinline__ unsigned xb_ld(unsigned* p)              { return __hip_atomic_load(p, __ATOMIC_RELAXED, __HIP_MEMORY_SCOPE_AGENT); }
__device__ __forceinline__ unsigned xb_add(unsigned* p, unsigned v) { return __hip_atomic_fetch_add(p, v, __ATOMIC_RELAXED, __HIP_MEMORY_SCOPE_AGENT); }
__device__ __forceinline__ unsigned xb_xcc_id() { return (unsigned)__builtin_amdgcn_s_getreg((3 << 11) | 20) & 0xFu; }
#define XB_SPIN(cond, bar) do { unsigned _sp = 0; while (cond) { __builtin_amdgcn_s_sleep(1); \
    if ((++_sp & 255u) == 0u) { if (xb_ld(&(bar)[XB_TMO])) break; if (_sp > XB_SPIN_CAP) { atomicAdd(&(bar)[XB_TMO], 1u); break; } } } } while (0)
struct XcdBarrier { unsigned* bar; unsigned x; volatile LAS unsigned* st; };
__device__ __forceinline__ XcdBarrier xcd_barrier_post(const int wv_, unsigned* bar, volatile LAS unsigned* st) {
    XcdBarrier b; b.bar = bar; b.x = xb_xcc_id(); b.st = st;
    if (TIDX == 0) (void)xb_add(&bar[XB_XCNT(b.x)], 1u);
    return b;
}
__device__ __forceinline__ void xcd_barrier_complete(unsigned* bar, unsigned x, unsigned& nloc, unsigned& nx) {
    const unsigned G = gridDim.x * gridDim.y * gridDim.z;
    unsigned sum, cnt, mine, sp = 0u;
    for (;;) {
        sum = 0u; cnt = 0u; mine = 0u;
#pragma unroll
        for (unsigned j = 0; j < 16; ++j) { const unsigned c = xb_ld(&bar[XB_XCNT(j)]); sum += c; cnt += (c > 0u) ? 1u : 0u; mine = (j == x) ? c : mine; }
        if (sum == G) break;
        __builtin_amdgcn_s_sleep(1);
        if ((++sp & 255u) == 0u) { if (xb_ld(&bar[XB_TMO])) break; if (sp > XB_SPIN_CAP) { atomicAdd(&bar[XB_TMO], 1u); break; } }
    }
    nloc = mine > 0u ? mine : 1u; nx = cnt > 0u ? cnt : 1u;
}
__device__ __forceinline__ void xcd_barrier(const int wv_, const XcdBarrier& b) {
    asm volatile("s_waitcnt vmcnt(0)" ::: "memory");
    __syncthreads();
    if (TIDX == 0) {
        unsigned* bar = b.bar;
        __builtin_amdgcn_s_waitcnt(0);
        unsigned nloc = b.st[0], nx = b.st[1];
        if (nloc == 0u) { xcd_barrier_complete(bar, b.x, nloc, nx); b.st[0] = nloc; b.st[1] = nx; }
        const unsigned old = xb_add(&bar[XB_XSUB(b.x)], 1u);
        const unsigned gen = old / nloc;
        if (old + 1u == (gen + 1u) * nloc) {
            __builtin_amdgcn_fence(__ATOMIC_RELEASE, "agent");
            asm volatile("s_waitcnt vmcnt(0)" ::: "memory");
            const unsigned og = xb_add(&bar[XB_TOP], 1u);
            const unsigned tg = og / nx;
            if (og + 1u == (tg + 1u) * nx) xb_add(&bar[XB_TOPGEN], 1u);
            else XB_SPIN(xb_ld(&bar[XB_TOPGEN]) == tg, bar);
            __builtin_amdgcn_fence(__ATOMIC_ACQUIRE, "agent");
            xb_add(&bar[XB_XGEN(b.x)], 1u);
            asm volatile("s_waitcnt vmcnt(0)" ::: "memory");
        } else {
            XB_SPIN(xb_ld(&bar[XB_XGEN(b.x)]) == gen, bar);
            __builtin_amdgcn_fence(__ATOMIC_ACQUIRE, "agent");
            asm volatile("s_waitcnt vmcnt(0)" ::: "memory");
        }
    }
    __syncthreads();
}

template <int MODE, bool GAIN = false>
__device__ __forceinline__ void cvt_mats(const float* W, int nmat, int K, int N, int NP, bf16* WT, LAS float* scr, int gw, int NGW, int lane, const float* gain = nullptr, int gms = 0) {
    const int nkb = K / 64, nnb = NP / 32, per = nkb * nnb; const long total = (long)nmat * per;
    f32x4 va[8], vb[8], vc[8]; size_t da = 0, db = 0, dc = 0; float ga[8], gb[8], gc[8];
#define CV_ISSUE(v_, d_, g_, it_) do { const long itx = (it_); if (itx < total) { \
        const int m = (int)(itx / per), r = (int)(itx % per), kb = r / nnb, nb = r % nnb, n0d = nb * 32; int n0s; \
        if (MODE == 2) { const int pn = n0d / 256, bj = (n0d / 128) & 1, i = n0d % 128; n0s = bj * 512 + 128 * pn + i; } \
        else if (MODE == 3) { if (n0d < DM) n0s = n0d; else { const int q = (n0d - DM) / 256, bj = ((n0d - DM) / 128) & 1, i = n0d % 128; n0s = DM + bj * DM + 128 * q + i; } } \
        else n0s = n0d < N ? n0d : -1; \
        d_ = (size_t)m * NP * K + (size_t)n0d * K + kb * 64; \
        if constexpr (GAIN) { _Pragma("unroll") for (int i = 0; i < 8; ++i) g_[i] = gain[m * gms + kb * 64 + (lane >> 3) + 8 * i]; } \
        if (n0s >= 0) { const float* src = W + (size_t)m * K * N + (size_t)(kb * 64 + (lane >> 3)) * N + n0s + (lane & 7) * 4; \
            _Pragma("unroll") for (int i = 0; i < 8; ++i) v_[i] = *(const f32x4*)(src + (size_t)(8 * i) * N); } \
        else { _Pragma("unroll") for (int i = 0; i < 8; ++i) v_[i] = (f32x4){0.f, 0.f, 0.f, 0.f}; } } } while (0)
#define CV_PROC(v_, d_, g_) do { \
        _Pragma("unroll") for (int i = 0; i < 8; ++i) { LAS float* d = scr + ((lane >> 3) + 8 * i) * 33 + (lane & 7) * 4; const f32x4 vv = GAIN ? v_[i] * g_[i] : v_[i]; d[0] = vv[0]; d[1] = vv[1]; d[2] = vv[2]; d[3] = vv[3]; } \
        asm volatile("s_waitcnt lgkmcnt(0)" ::: "memory"); \
        const int c = lane & 7; \
        _Pragma("unroll") for (int j = 0; j < 4; ++j) { const int n = (lane >> 3) + 8 * j; const LAS float* sp = scr + (8 * c) * 33 + n; \
            u32x4 o; o.x = pk2(sp[0 * 33], sp[1 * 33]); o.y = pk2(sp[2 * 33], sp[3 * 33]); o.z = pk2(sp[4 * 33], sp[5 * 33]); o.w = pk2(sp[6 * 33], sp[7 * 33]); \
            *(u32x4*)(WT + (d_) + (size_t)n * K + 8 * c) = o; } \
        asm volatile("s_waitcnt lgkmcnt(0)" ::: "memory"); } while (0)
    long it = gw;
    CV_ISSUE(va, da, ga, it); CV_ISSUE(vb, db, gb, it + NGW); CV_ISSUE(vc, dc, gc, it + 2L * NGW);
    while (it < total) {
        CV_PROC(va, da, ga); CV_ISSUE(va, da, ga, it + 3L * NGW);
        if (it + NGW < total) { CV_PROC(vb, db, gb); CV_ISSUE(vb, db, gb, it + 4L * NGW); }
        if (it + 2L * NGW < total) { CV_PROC(vc, dc, gc); CV_ISSUE(vc, dc, gc, it + 5L * NGW); }
        it += 3L * NGW;
    }
#undef CV_ISSUE
#undef CV_PROC
}

__device__ __forceinline__ void filter_phase(const int wv_, const float* w1, const float* b1, const float* whid, const float* bhid, const float* freq, const float* wout, bf16* KRB, LAS unsigned char* lds) {
    LAS float* z = (LAS float*)lds;
    LAS float* ha = z + 16 * 33;
    LAS float* hb = ha + 16 * 64;
    LAS float* hc = hb + 16 * 64;
    const int tid = TIDX;
    for (int pb = blockIdx.x; pb < SEQ / 16; pb += gridDim.x) {
        const int l0 = pb * 16;
        __syncthreads();
        for (int i = tid; i < 16 * 33; i += NTHREADS) {
            const int p = i / 33, f = i % 33, l = l0 + p; float v;
            if (f == 0) v = (float)l / (float)(SEQ - 1);
            else { const int j = (f - 1) & 15; const float band = 1e-4f + (float)j * ((15.0f - 1e-4f) / 15.0f); const float w = 6.283185307179586f * (float)l / (float)SEQ; const float a = band * w;
                v = (f <= 16) ? cosf(a) : -sinf(a); }
            z[i] = v;
        }
        __syncthreads();
        for (int i = tid; i < 16 * 64; i += NTHREADS) { const int p = i >> 6, j = i & 63; float s = b1[j];
            for (int k = 0; k < 33; ++k) s += z[p * 33 + k] * w1[k * 64 + j];
            ha[i] = sinf(freq[j] * s); }
        __syncthreads();
        for (int i = tid; i < 16 * 64; i += NTHREADS) { const int p = i >> 6, j = i & 63; float s = bhid[j];
            for (int k = 0; k < 64; ++k) s += ha[p * 64 + k] * whid[k * 64 + j];
            hb[i] = sinf(freq[64 + j] * s); }
        __syncthreads();
        for (int i = tid; i < 16 * 64; i += NTHREADS) { const int p = i >> 6, j = i & 63; float s = bhid[64 + j];
            for (int k = 0; k < 64; ++k) s += hb[p * 64 + k] * whid[4096 + k * 64 + j];
            hc[j * 16 + p] = sinf(freq[128 + j] * s); }
        __syncthreads();
#pragma unroll 1
        for (int qh = 0; qh < 2; ++qh) {
        float acc[4][16];
#pragma unroll
        for (int q = 0; q < 4; ++q)
#pragma unroll
            for (int p = 0; p < 16; ++p) acc[q][p] = 0.f;
#pragma unroll 1
        for (int k0 = 0; k0 < 64; k0 += 2) { float w[2][4];
#pragma unroll
            for (int kk = 0; kk < 2; ++kk)
#pragma unroll
                for (int q = 0; q < 4; ++q) w[kk][q] = wout[(size_t)(k0 + kk) * 4096 + tid + NTHREADS * (qh * 4 + q)];
#pragma unroll
            for (int kk = 0; kk < 2; ++kk) { const LAS f32x4* hp = (const LAS f32x4*)(hc + (k0 + kk) * 16); const f32x4 h0 = hp[0], h1 = hp[1], h2 = hp[2], h3 = hp[3];
#pragma unroll
                for (int q = 0; q < 4; ++q) { const float wv = w[kk][q];
#pragma unroll
                    for (int p = 0; p < 4; ++p) { acc[q][p] += h0[p] * wv; acc[q][4 + p] += h1[p] * wv; acc[q][8 + p] += h2[p] * wv; acc[q][12 + p] += h3[p] * wv; } } } }
        LAS bf16* T = (LAS bf16*)(lds + 16384);
        __syncthreads();
#pragma unroll
        for (int q = 0; q < 4; ++q) {
            const int c = tid + NTHREADS * (qh * 4 + q), d = c & (DM - 1);
            const float mind = -3.0701134573253946f, maxd = -15.350567286626973f;
            const float delta = fabsf(mind + (float)d * ((maxd - mind) / (float)(DM - 1)));
            unsigned pk[8];
#pragma unroll
            for (int p = 0; p < 16; p += 2) { const float t0 = (float)(l0 + p) / (float)(SEQ - 1), t1 = (float)(l0 + p + 1) / (float)(SEQ - 1);
                pk[p >> 1] = f2bf(acc[q][p] * expf(-t0 * delta)) | (f2bf(acc[q][p + 1] * expf(-t1 * delta)) << 16); }
            *(LAS u32x4*)(T + (size_t)d * 16) = (u32x4){pk[0], pk[1], pk[2], pk[3]}; *(LAS u32x4*)(T + (size_t)d * 16 + 8) = (u32x4){pk[4], pk[5], pk[6], pk[7]};
        }
        __syncthreads();
        { const bool bwd = qh == 1;
            for (int e = tid; e < DM * 16; e += NTHREADS) { const int d = e >> 4, p = e & 15, l = l0 + p; const bf16 hv = T[e];
                const int m = bwd ? 4095 + l : 4095 - l;
                if (!bwd || l > 0) { KRB[(size_t)d * 8192 + m] = hv; if (m >= 1) KRB[(size_t)DM * 8192 + (size_t)d * 8192 + m - 1] = hv; } } }
        }
    }
}

template <bool COMBINE>
__device__ __forceinline__ void norm_phase(const int wv_, const float* xin, float* xout, const bf16* ym, const float* g, bf16* H) {
    const int tid = TIDX, lane = tid & 63, wid = wv_;
    constexpr int NR = 4;
    for (int rg = blockIdx.x * NWAVES + wid; rg < NTOK / NR; rg += gridDim.x * NWAVES) {
        f32x4 v[NR][8]; float rstd[NR];
#pragma unroll
        for (int r = 0; r < NR; ++r) { const size_t row = (size_t)rg * NR + r; float ss = 0.f;
#pragma unroll
            for (int j = 0; j < 8; ++j) { const int col = j * 256 + lane * 4; f32x4 x = *(const f32x4*)(xin + row * DM + col);
                if (COMBINE) { const u32x2 a = *(const u32x2*)(ym + row * DM + col);
                    x[0] += bflo(a.x); x[1] += bfhi(a.x); x[2] += bflo(a.y); x[3] += bfhi(a.y);
                    *(f32x4*)(xout + row * DM + col) = x; }
                v[r][j] = x; ss += x[0] * x[0] + x[1] * x[1] + x[2] * x[2] + x[3] * x[3]; }
            ss = wave_sum(ss); rstd[r] = 1.0f / sqrtf(ss * (1.0f / DM) + EPS); }
#pragma unroll
        for (int j = 0; j < 8; ++j) { const int col = j * 256 + lane * 4; const f32x4 gv = *(const f32x4*)(g + col);
#pragma unroll
            for (int r = 0; r < NR; ++r) { const size_t row = (size_t)rg * NR + r; const f32x4 x = v[r][j] * rstd[r] * gv;
                u32x2 o; o.x = pk2(x[0], x[1]); o.y = pk2(x[2], x[3]); *(u32x2*)(H + row * DM + col) = o; } }
    }
}

__device__ __forceinline__ void x0_phase(const int wv_, const float* xin, bf16* XBo, float* RSTD) {
    const int tid = TIDX, lane = tid & 63, wid = wv_;
    constexpr int NR = 4;
    for (int rg = blockIdx.x * NWAVES + wid; rg < NTOK / NR; rg += gridDim.x * NWAVES) {
        f32x4 v[NR][8];
#pragma unroll
        for (int r = 0; r < NR; ++r) { const size_t row = (size_t)rg * NR + r;
#pragma unroll
            for (int j = 0; j < 8; ++j) v[r][j] = *(const f32x4*)(xin + row * DM + j * 256 + lane * 4); }
#pragma unroll
        for (int r = 0; r < NR; ++r) { const size_t row = (size_t)rg * NR + r; float ss = 0.f;
#pragma unroll
            for (int j = 0; j < 8; ++j) { const f32x4 x = v[r][j]; ss += x[0] * x[0] + x[1] * x[1] + x[2] * x[2] + x[3] * x[3];
                u32x2 o; o.x = pk2(x[0], x[1]); o.y = pk2(x[2], x[3]); *(u32x2*)(XBo + row * DM + j * 256 + lane * 4) = o; }
            ss = wave_sum(ss); if (lane == 0) RSTD[row] = 1.0f / sqrtf(ss * (1.0f / DM) + EPS); }
    }
}

constexpr int RT_BUF = 96 * 512, RT_LSCR = 2 * RT_BUF;
__device__ __forceinline__ unsigned cvtpk_(float lo, float hi) { unsigned r; asm volatile("v_cvt_pk_bf16_f32 %0, %1, %2" : "=v"(r) : "v"(lo), "v"(hi)); return r; }
__device__ __forceinline__ void router_phase(const int wv_, const bf16* X, const bf16* WTs, const float* bg, const float* be,
                                             unsigned* cnt, unsigned* cntB, unsigned* list, u32x4* rec, LAS unsigned char* lds) {
    const int tid = TIDX, lane = tid & 63, wid = wv_, i16 = lane & 15, kq = lane >> 4;
    LAS float* lscr = (LAS float*)lds + wid * (16 * 48);
    LAS unsigned* lcnt = (LAS unsigned*)(lds + RT_LSCR + 8192); LAS unsigned* lbase = lcnt + 32; LAS unsigned* lcntB = lcnt + 64; LAS unsigned* lbaseB = lcnt + 128;
    if (tid < 32) lcnt[tid] = 0u;
    if (tid < 48) lcntB[tid] = 0u;
    const unsigned voffW = (unsigned)(((2 * wid + (lane >> 5)) * DM + (((lane & 31) ^ ((2 * wid + (lane >> 5)) & 7)) * 8)) * 2);
    const int s7 = i16 & 7, d64 = (s7 & 4) ? 64 : 0, rb0 = i16 * 512 + 16 * (kq ^ (s7 & 3)), rbE = rb0 + d64, rbO = rb0 - d64;
    for (int it = blockIdx.x; it < NTOK / 128; it += gridDim.x) {
        const size_t row = (size_t)it * 128 + wid * 16 + i16;
        const bf16* xp = X + row * DM + 8 * kq;
        f32x4 acc[3]; float ss = 0.f;
#pragma unroll
        for (int n = 0; n < 3; ++n) acc[n] = (f32x4){0.f, 0.f, 0.f, 0.f};
        u32x4 xa[4], xb[4];
#define RT_LOADX(dst, c, h) do { _Pragma("unroll") for (int ks = 0; ks < 4; ++ks) dst[ks] = *(const GAS u32x4*)(xpc + (c) * 256 + ((h) * 4 + ks) * 32); } while (0)
#define RT_DMAW(c, buf) do { _Pragma("unroll") for (int i = 0; i < 6; ++i) \
        __builtin_amdgcn_global_load_lds((const unsigned*)(wpc + (size_t)(c) * 512 + (size_t)i * 16 * DM * 2), (LAS unsigned*)(lds + (buf) * RT_BUF + (i * 8 + wid) * 1024), 16, 0, 0); asm volatile("" ::: "memory"); } while (0)
#define RT_COMPUTE(xr, c, h, buf) do { _Pragma("unroll") for (int ks4 = 0; ks4 < 4; ++ks4) { const int ks = (h) * 4 + ks4; const u32x4 xh = xr[ks4]; \
            { const float q0 = bflo(xh.x), q1 = bfhi(xh.x), q2 = bflo(xh.y), q3 = bfhi(xh.y), q4 = bflo(xh.z), q5 = bfhi(xh.z), q6 = bflo(xh.w), q7 = bfhi(xh.w); \
              ss += q0 * q0 + q1 * q1 + q2 * q2 + q3 * q3 + q4 * q4 + q5 * q5 + q6 * q6 + q7 * q7; } \
            const bf16x8 ah = __builtin_bit_cast(bf16x8, xh); \
            _Pragma("unroll") for (int n = 0; n < 3; ++n) { const LAS unsigned char* wp = lds + (buf) * RT_BUF + n * 16 * 512 + ((ks & 1) ? rbO : rbE) + 64 * ks; \
                const bf16x8 bh = *(const LAS bf16x8*)wp, bl = *(const LAS bf16x8*)(wp + 48 * 512); \
                acc[n] = __builtin_amdgcn_mfma_f32_16x16x32_bf16(bh, ah, acc[n], 0, 0, 0); \
                acc[n] = __builtin_amdgcn_mfma_f32_16x16x32_bf16(bl, ah, acc[n], 0, 0, 0); } __builtin_amdgcn_sched_barrier(0); } } while (0)
        const GAS bf16* xpc = (const GAS bf16*)xp; const char* wpc = (const char*)WTs + voffW;
        __syncthreads();
        RT_DMAW(0, 0); RT_LOADX(xa, 0, 0); RT_LOADX(xb, 0, 1);
        for (int c = 0; c < 8; c += 2) {
            asm volatile("s_waitcnt vmcnt(4)" ::: "memory"); __syncthreads();
            RT_DMAW(1, 1);
            RT_COMPUTE(xa, 0, 0, 0); RT_LOADX(xa, 1, 0);
            RT_COMPUTE(xb, 0, 1, 0); RT_LOADX(xb, 1, 1);
            asm volatile("s_waitcnt vmcnt(4)" ::: "memory"); __syncthreads();
            if (c + 2 < 8) RT_DMAW(2, 0);
            RT_COMPUTE(xa, 1, 0, 1); if (c + 2 < 8) RT_LOADX(xa, 2, 0);
            RT_COMPUTE(xb, 1, 1, 1); if (c + 2 < 8) RT_LOADX(xb, 2, 1);
            xpc += 512; wpc += 1024;
            asm volatile("" : "+v"(xpc));
        }
#undef RT_LOADX
#undef RT_DMAW
#undef RT_COMPUTE
        ss += __shfl_xor(ss, 16); ss += __shfl_xor(ss, 32);
        const float rstd = 1.0f / sqrtf(ss * (1.0f / DM) + EPS);
#pragma unroll
        for (int n = 0; n < 3; ++n)
#pragma unroll
            for (int j = 0; j < 4; ++j) lscr[i16 * 48 + n * 16 + kq * 4 + j] = acc[n][j] * rstd;
        asm volatile("s_waitcnt lgkmcnt(0)" ::: "memory");
        unsigned e1 = 0, e2 = 0, l1 = 0, l2 = 0, bk = 0, lB = 0, h1 = 0; float g1 = 0.f, g2 = 0.f;
        if (lane < 16) { const LAS float* lg = lscr + lane * 48;
            int gs = 0; float gl_[8]; gl_[0] = lg[0] + bg[0]; float gm = gl_[0];
            for (int j = 1; j < 8; ++j) { gl_[j] = lg[j] + bg[j]; if (gl_[j] > gm) { gm = gl_[j]; gs = j; } }
            float den = 0.f; for (int j = 0; j < 8; ++j) den += expf(gl_[j] - gm);
            const float gp = 1.0f / den;
            float el[4]; for (int i = 0; i < 4; ++i) el[i] = lg[8 + gs * 4 + i] + be[gs * 4 + i];
            int i1 = 0; for (int i = 1; i < 4; ++i) if (el[i] > el[i1]) i1 = i;
            int i2 = (i1 == 0) ? 1 : 0; for (int i = 0; i < 4; ++i) if (i != i1 && el[i] > el[i2]) i2 = i;
            const float ex = expf(el[i2] - el[i1]); const float p1 = 1.0f / (1.0f + ex), p2 = ex / (1.0f + ex);
            e1 = gs * 4 + i1; e2 = gs * 4 + i2; g1 = gp * p1; g2 = gp * p2;
            const int lo = i1 < i2 ? i1 : i2, hi = i1 < i2 ? i2 : i1, pidx = lo == 0 ? hi - 1 : (lo == 1 ? hi + 1 : 5);
            bk = gs * 6 + pidx; h1 = (i1 == hi) ? 1u : 0u;
            l1 = __hip_atomic_fetch_add(lcnt + e1, 1u, __ATOMIC_RELAXED, __HIP_MEMORY_SCOPE_WORKGROUP);
            l2 = __hip_atomic_fetch_add(lcnt + e2, 1u, __ATOMIC_RELAXED, __HIP_MEMORY_SCOPE_WORKGROUP);
            lB = __hip_atomic_fetch_add(lcntB + bk, 1u, __ATOMIC_RELAXED, __HIP_MEMORY_SCOPE_WORKGROUP); }
        __syncthreads();
        if (tid < 32) { const unsigned c = lcnt[tid]; lbase[tid] = c ? __hip_atomic_fetch_add(cnt + tid * 64, c, __ATOMIC_RELAXED, __HIP_MEMORY_SCOPE_AGENT) : 0u; }
        else if (tid >= 64 && tid < 112) { const unsigned b = tid - 64, c = lcntB[b]; lbaseB[b] = c ? __hip_atomic_fetch_add(cntB + b * 64, c, __ATOMIC_RELAXED, __HIP_MEMORY_SCOPE_AGENT) : 0u; }
        __syncthreads();
        if (lane < 16) { const unsigned r = (unsigned)row; const size_t o1 = (size_t)e1 * NTOK + lbase[e1] + l1, o2 = (size_t)e2 * NTOK + lbase[e2] + l2;
            const unsigned slot = lbaseB[bk] + lB, c1 = (bk << 20) | (h1 << 19) | slot, c2 = (bk << 20) | ((1u - h1) << 19) | slot;
            list[o1] = r; list[o2] = r; const unsigned rb = __float_as_uint(rstd);
            rec[o1] = (u32x4){rb, __float_as_uint(g1), c1, r}; rec[o2] = (u32x4){rb, __float_as_uint(g2), c2, r}; }
        __syncthreads();
        if (tid < 32) lcnt[tid] = 0u;
        if (tid < 48) lcntB[tid] = 0u;
        asm volatile("s_waitcnt vmcnt(0) lgkmcnt(0)" ::: "memory");
    }
}


namespace pg8 {
constexpr int BM = 256, BK = 64, HALF = 128, HTB = HALF * BK * 2, STAGE_BYTES = 8 * HTB, NXCD = 8, WGM = 8;
__host__ __device__ __forceinline__ int lds_byte(int r, int c) { const int st = (r >> 4) * 2 + (c >> 5), rr = r & 15, cc = c & 31, ob = rr * 64 + cc * 2; return st * 1024 + (ob ^ (((ob >> 9) & 1) << 5)); }
__host__ __device__ __forceinline__ void stage_rc(int b, int& R, int& C) { const int st = b / 1024, sb = b % 1024, swz = sb ^ (((sb >> 9) & 1) << 5); R = (st >> 1) * 16 + swz / 64; C = (st & 1) * 32 + (swz % 64) / 2; }
__host__ __device__ __forceinline__ int perm32(int rho) { const int n = rho >> 4, i = rho & 15; return 8 * (i >> 2) + 4 * n + (i & 3); }
struct Unit { int pm, pn, e, r0, rows; };
__device__ __forceinline__ unsigned cvt_pk_bf16(float lo, float hi) { unsigned r; asm volatile("v_cvt_pk_bf16_f32 %0, %1, %2" : "=v"(r) : "v"(lo), "v"(hi)); return r; }

__device__ __forceinline__ void tile_of(int wgid, int nM, int nN, int& pm, int& pn) {
    const int nwg = nM * nN; { const int q = nwg / NXCD, r = nwg % NXCD, xcd = wgid % NXCD, off = wgid / NXCD; wgid = (xcd < r ? xcd * (q + 1) : r * (q + 1) + (xcd - r) * q) + off; }
    const int nig = WGM * nN, gid = wgid / nig, fm = gid * WGM, gsz = (nM - fm) < WGM ? (nM - fm) : WGM;
    pm = fm + ((wgid % nig) % gsz); pn = (wgid % nig) / gsz;
}
struct DenseOrder { static constexpr bool GATHER = false, SPLITB = false;
    const bf16* A; const bf16* Bt; int K, nM, nN, G, c;
    __device__ __forceinline__ void init(const bf16* A_, const bf16* Bt_, int M, int N, int K_) { A = A_; Bt = Bt_; K = K_; nM = M / BM; nN = N / BM; G = gridDim.x; c = blockIdx.x; }
    __device__ __forceinline__ bool next(int i, Unit& u) const { const long L = (long)i * G + c; if (L >= (long)nM * nN) return false; tile_of((int)L, nM, nN, u.pm, u.pn); u.e = 0; u.r0 = 0; u.rows = BM; return true; }
    __device__ __forceinline__ const char* abase(const Unit& u) const { return (const char*)A + (size_t)u.pm * BM * K * 2; }
    __device__ __forceinline__ const char* bbase(const Unit& u) const { return (const char*)Bt + (size_t)u.pn * BM * K * 2; }
    __device__ __forceinline__ int kb() const { return K; }
    __device__ __forceinline__ const char* bbase2(const Unit& u) const { return bbase(u) + K; }
    __device__ __forceinline__ void a_offs(const Unit&, unsigned (&vo)[2][2], const int (&R)[2], const int (&C)[2]) const {
#pragma unroll
        for (int h = 0; h < 2; ++h)
#pragma unroll
            for (int i = 0; i < 2; ++i) vo[h][i] = (unsigned)((R[i] + HALF * h) * K + C[i]) * 2u; }
};
struct MoeOrder { static constexpr bool GATHER = false, SPLITB = false;
    const bf16* A; const bf16* Bt; int K, N, nN, G, c; const LAS int* tstart; const LAS int* cnts;
    __device__ __forceinline__ void init(const bf16* A_, const bf16* Bt_, int N_, int K_, const LAS int* ts, const LAS int* cn) { A = A_; Bt = Bt_; K = K_; N = N_; nN = N_ / BM; G = gridDim.x; c = blockIdx.x; tstart = ts; cnts = cn; }
    __device__ __forceinline__ bool next(int i, Unit& u) const { const int nM = tstart[32]; const long L = (long)i * G + c; if (L >= (long)nM * nN) return false; tile_of((int)L, nM, nN, u.pm, u.pn);
        const int e = tstart[128 + u.pm]; u.e = e; u.r0 = (u.pm - tstart[e]) * BM; const int left = cnts[e] - u.r0; u.rows = left < BM ? left : BM; return true; }
    __device__ __forceinline__ const char* abase(const Unit& u) const { return (const char*)A + (size_t)u.pm * BM * K * 2; }
    __device__ __forceinline__ const char* bbase(const Unit& u) const { return (const char*)Bt + ((size_t)u.e * N + (size_t)u.pn * BM) * K * 2; }
    __device__ __forceinline__ int kb() const { return K; }
    __device__ __forceinline__ const char* bbase2(const Unit& u) const { return bbase(u) + K; }
    __device__ __forceinline__ void a_offs(const Unit&, unsigned (&vo)[2][2], const int (&R)[2], const int (&C)[2]) const {
#pragma unroll
        for (int h = 0; h < 2; ++h)
#pragma unroll
            for (int i = 0; i < 2; ++i) vo[h][i] = (unsigned)((R[i] + HALF * h) * K + C[i]) * 2u; }
};
struct MoeGatherOrder : MoeOrder { static constexpr bool GATHER = true;
    const unsigned* list;
    __device__ __forceinline__ const char* abase(const Unit&) const { return (const char*)A; }
    __device__ __forceinline__ void a_offs(const Unit& u, unsigned (&vo)[2][2], const int (&R)[2], const int (&C)[2]) const {
#pragma unroll
        for (int h = 0; h < 2; ++h)
#pragma unroll
            for (int i = 0; i < 2; ++i) { const int rl = R[i] + HALF * h, rc = rl < u.rows ? rl : u.rows - 1; const unsigned tok = list[(size_t)u.e * NTOK + u.r0 + rc]; vo[h][i] = (tok * (unsigned)K + (unsigned)C[i]) * 2u; } }
};
struct MoeBucketOrder { static constexpr bool GATHER = false, SPLITB = true;
    const bf16* A; const bf16* Bt; int nN, G, c; const LAS int* tab;
    __device__ __forceinline__ void init(const bf16* A_, const bf16* Bt_, const LAS int* t) { A = A_; Bt = Bt_; nN = DM / BM; G = gridDim.x; c = blockIdx.x; tab = t; }
    __device__ __forceinline__ bool next(int i, Unit& u) const { const int nM = tab[448 + 48]; const long L = (long)i * G + c; if (L >= (long)nM * nN) return false; tile_of((int)L, nM, nN, u.pm, u.pn);
        const int bk = tab[576 + u.pm], g = bk / 6, px = bk % 6, lo = px < 3 ? 0 : (px < 5 ? 1 : 2), hi = px < 3 ? px + 1 : (px < 5 ? px - 1 : 3);
        u.e = (g * 4 + lo) | ((g * 4 + hi) << 8); u.r0 = (u.pm - tab[448 + bk]) * BM; const int left = tab[512 + bk] - u.r0; u.rows = left < BM ? left : BM; return true; }
    __device__ __forceinline__ const char* abase(const Unit& u) const { return (const char*)A + (size_t)u.pm * BM * (2 * DFF) * 2; }
    __device__ __forceinline__ const char* bbase(const Unit& u) const { return (const char*)Bt + ((size_t)(u.e & 255) * DM + (size_t)u.pn * BM) * DFF * 2; }
    __device__ __forceinline__ const char* bbase2(const Unit& u) const { return (const char*)Bt + ((size_t)(u.e >> 8) * DM + (size_t)u.pn * BM) * DFF * 2; }
    __device__ __forceinline__ int kb() const { return DFF; }
    __device__ __forceinline__ void a_offs(const Unit&, unsigned (&vo)[2][2], const int (&R)[2], const int (&C)[2]) const {
#pragma unroll
        for (int h = 0; h < 2; ++h)
#pragma unroll
            for (int i = 0; i < 2; ++i) vo[h][i] = (unsigned)((R[i] + HALF * h) * (2 * DFF) + C[i]) * 2u; }
};
struct EpiBf16 { static constexpr bool PERM = true; bf16* O; int ldc;
    __device__ __forceinline__ void operator()(const f32x4 (&acc)[2][2][4][2], const Unit& u, int wr, int wc, int fr, int fq) const {
        const int row0 = u.pm * BM + wr * 64 + fr, col0 = u.pn * BM + wc * 32 + 8 * fq;
#pragma unroll
        for (int ai = 0; ai < 2; ++ai)
#pragma unroll
            for (int m = 0; m < 4; ++m) { bf16* rowp = O + (size_t)(row0 + ai * HALF + m * 16) * ldc + col0;
#pragma unroll
                for (int bj = 0; bj < 2; ++bj) { const f32x4 v0 = acc[ai][bj][m][0], v1 = acc[ai][bj][m][1];
                    u32x4 w; w.x = cvt_pk_bf16(v0[0], v0[1]); w.y = cvt_pk_bf16(v0[2], v0[3]); w.z = cvt_pk_bf16(v1[0], v1[1]); w.w = cvt_pk_bf16(v1[2], v1[3]);
                    *(u32x4*)(rowp + bj * HALF) = w; } }
    } };
struct EpiF32 { static constexpr bool PERM = false; float* C; int ldc;
    __device__ __forceinline__ void operator()(const f32x4 (&acc)[2][2][4][2], const Unit& u, int wr, int wc, int fr, int fq) const {
        const int row0 = u.pm * BM + wr * 64 + fr, col0 = u.pn * BM + wc * 32 + 4 * fq;
#pragma unroll
        for (int ai = 0; ai < 2; ++ai)
#pragma unroll
            for (int m = 0; m < 4; ++m) { float* rowp = C + (size_t)(row0 + ai * HALF + m * 16) * ldc + col0;
#pragma unroll
                for (int bj = 0; bj < 2; ++bj)
#pragma unroll
                    for (int n = 0; n < 2; ++n) *(f32x4*)(rowp + bj * HALF + n * 16) = acc[ai][bj][m][n]; }
    } };
struct EpiRes { static constexpr bool PERM = true; const bf16* res; bf16* out;
    __device__ __forceinline__ void operator()(const f32x4 (&acc)[2][2][4][2], const Unit& u, int wr, int wc, int fr, int fq) const {
        const int row0 = u.pm * BM + wr * 64 + fr, col0 = u.pn * BM + wc * 32 + 8 * fq;
#pragma unroll
        for (int ai = 0; ai < 2; ++ai) { u32x4 b[4][2];
#pragma unroll
            for (int m = 0; m < 4; ++m) { const size_t off = (size_t)(row0 + ai * HALF + m * 16) * DM + col0;
#pragma unroll
                for (int bj = 0; bj < 2; ++bj) b[m][bj] = *(const u32x4*)(res + off + bj * HALF); }
            asm volatile("" ::: "memory");
#pragma unroll
            for (int m = 0; m < 4; ++m) { const size_t off = (size_t)(row0 + ai * HALF + m * 16) * DM + col0;
#pragma unroll
                for (int bj = 0; bj < 2; ++bj) { const u32x4 r = b[m][bj]; const f32x4 a0 = acc[ai][bj][m][0], a1 = acc[ai][bj][m][1];
                    u32x4 w; w.x = cvt_pk_bf16(bflo(r.x) + a0[0], bfhi(r.x) + a0[1]); w.y = cvt_pk_bf16(bflo(r.y) + a0[2], bfhi(r.y) + a0[3]);
                    w.z = cvt_pk_bf16(bflo(r.z) + a1[0], bfhi(r.z) + a1[1]); w.w = cvt_pk_bf16(bflo(r.w) + a1[2], bfhi(r.w) + a1[3]);
                    *(u32x4*)(out + off + bj * HALF) = w; } }
            asm volatile("" ::: "memory"); }
    } };
struct EpiSC { static constexpr bool PERM = true; bf16* Bg; bf16* P;
    __device__ __forceinline__ void operator()(const f32x4 (&acc)[2][2][4][2], const Unit& u, int wr, int wc, int fr, int fq) const {
        const int row0 = u.pm * BM + wr * 64 + fr;
        if (u.pn < 8) { const int col0 = u.pn * BM + wc * 32 + 8 * fq;
#pragma unroll
            for (int ai = 0; ai < 2; ++ai)
#pragma unroll
                for (int m = 0; m < 4; ++m) { bf16* rowp = Bg + (size_t)(row0 + ai * HALF + m * 16) * DM + col0;
#pragma unroll
                    for (int bj = 0; bj < 2; ++bj) { const f32x4 v0 = acc[ai][bj][m][0], v1 = acc[ai][bj][m][1];
                        u32x4 w; w.x = cvt_pk_bf16(v0[0], v0[1]); w.y = cvt_pk_bf16(v0[2], v0[3]); w.z = cvt_pk_bf16(v1[0], v1[1]); w.w = cvt_pk_bf16(v1[2], v1[3]);
                        *(u32x4*)(rowp + bj * HALF) = w; } }
        } else { const int col0 = (u.pn - 8) * HALF + wc * 32 + 8 * fq;
#pragma unroll
            for (int ai = 0; ai < 2; ++ai)
#pragma unroll
                for (int m = 0; m < 4; ++m) { const f32x4 v0 = acc[ai][0][m][0] * acc[ai][1][m][0], v1 = acc[ai][0][m][1] * acc[ai][1][m][1];
                    u32x4 w; w.x = cvt_pk_bf16(v0[0], v0[1]); w.y = cvt_pk_bf16(v0[2], v0[3]); w.z = cvt_pk_bf16(v1[0], v1[1]); w.w = cvt_pk_bf16(v1[2], v1[3]);
                    *(u32x4*)(P + (size_t)(row0 + ai * HALF + m * 16) * DM + col0) = w; }
        }
    } };
struct EpiSwiglu { static constexpr bool PERM = true; bf16* ACT2; const u32x4* REC; const LAS int* tab;
    __device__ __forceinline__ void operator()(const f32x4 (&acc)[2][2][4][2], const Unit& u, int wr, int wc, int fr, int fq) const {
        const int col0 = u.pn * HALF + wc * 32 + 8 * fq; const u32x4* rp = REC + (size_t)u.e * NTOK + u.r0 + wr * 64 + fr;
#pragma unroll
        for (int ai = 0; ai < 2; ++ai) {
            u32x4 rc[4];
#pragma unroll
            for (int m = 0; m < 4; ++m) rc[m] = rp[ai * HALF + m * 16];
#pragma unroll
            for (int m = 0; m < 4; ++m) { const int rl = ai * HALF + wr * 64 + m * 16 + fr;
                if (rl < u.rows) { float o[8]; const float rs = __uint_as_float(rc[m].x), gt = __uint_as_float(rc[m].y); const unsigned cd = rc[m].z;
                    const unsigned doff = (((unsigned)tab[448 + (cd >> 20)] * (unsigned)BM + (cd & 0x7FFFFu)) * (unsigned)(2 * DFF) + ((cd >> 19) & 1u) * (unsigned)DFF + (unsigned)col0) * 2u;
#pragma unroll
                    for (int n = 0; n < 2; ++n)
#pragma unroll
                        for (int j = 0; j < 4; ++j) { const float g = acc[ai][0][m][n][j] * rs, up = acc[ai][1][m][n][j] * rs;
                            o[n * 4 + j] = g * __builtin_amdgcn_rcpf(1.0f + __builtin_amdgcn_exp2f(-1.4426950408889634f * g)) * up * gt; }
                    u32x4 w; w.x = cvt_pk_bf16(o[0], o[1]); w.y = cvt_pk_bf16(o[2], o[3]); w.z = cvt_pk_bf16(o[4], o[5]); w.w = cvt_pk_bf16(o[6], o[7]);
                    *(u32x4*)((char*)ACT2 + doff) = w;
                } }
            asm volatile("" ::: "memory"); }
    } };
template <bool NEXT>
struct EpiDown { static constexpr bool PERM = true; const unsigned* TOKOF; bf16* XS; float* OUT; float* PART;
    __device__ __forceinline__ void operator()(const f32x4 (&acc)[2][2][4][2], const Unit& u, int wr, int wc, int fr, int fq) const {
        const int col0 = u.pn * BM + wc * 32 + 8 * fq;
        unsigned tk[2][4];
#pragma unroll
        for (int ai = 0; ai < 2; ++ai)
#pragma unroll
            for (int m = 0; m < 4; ++m) { const int rl = ai * HALF + wr * 64 + m * 16 + fr; tk[ai][m] = TOKOF[(size_t)u.pm * BM + rl]; }
#pragma unroll
        for (int ai = 0; ai < 2; ++ai) { u32x4 b[4][2];
#pragma unroll
            for (int m = 0; m < 4; ++m) { const int rl = ai * HALF + wr * 64 + m * 16 + fr; const unsigned t = rl < u.rows ? tk[ai][m] : 0u;
                const bf16* rowp = XS + (size_t)t * DM + col0;
#pragma unroll
                for (int bj = 0; bj < 2; ++bj) b[m][bj] = *(const u32x4*)(rowp + bj * HALF); }
            asm volatile("" ::: "memory");
#pragma unroll
            for (int m = 0; m < 4; ++m) { const int rl = ai * HALF + wr * 64 + m * 16 + fr; const bool ok = rl < u.rows; const size_t ro = (size_t)tk[ai][m] * DM + col0;
                float ss = 0.f;
#pragma unroll
                for (int bj = 0; bj < 2; ++bj) { const u32x4 r = b[m][bj];
                    const f32x4 x0 = (f32x4){bflo(r.x), bfhi(r.x), bflo(r.y), bfhi(r.y)} + acc[ai][bj][m][0], x1 = (f32x4){bflo(r.z), bfhi(r.z), bflo(r.w), bfhi(r.w)} + acc[ai][bj][m][1];
                    if constexpr (NEXT) {
                        ss += x0[0] * x0[0] + x0[1] * x0[1] + x0[2] * x0[2] + x0[3] * x0[3] + x1[0] * x1[0] + x1[1] * x1[1] + x1[2] * x1[2] + x1[3] * x1[3];
                        u32x4 w; w.x = cvt_pk_bf16(x0[0], x0[1]); w.y = cvt_pk_bf16(x0[2], x0[3]); w.z = cvt_pk_bf16(x1[0], x1[1]); w.w = cvt_pk_bf16(x1[2], x1[3]);
                        if (ok) *(u32x4*)(XS + ro + bj * HALF) = w;
                    } else { if (ok) { *(f32x4*)(OUT + ro + bj * HALF) = x0; *(f32x4*)(OUT + ro + bj * HALF + 4) = x1; } } }
                if constexpr (NEXT) { ss += __shfl_xor(ss, 16); ss += __shfl_xor(ss, 32);
                    if (ok && fq == 0) PART[(size_t)tk[ai][m] * 32 + u.pn * 4 + wc] = ss; } }
            asm volatile("" ::: "memory"); }
    } };

template <class Epi, class Sched, bool ALIGN_EPI = true>
__device__ __forceinline__ void gemm_phase(const int wv_, LAS unsigned char* lds, const int K, const Sched& S, const Epi& E) {
    const int tid = TIDX, wid = wv_, lane = tid & 63, wr = wid >> 2, wc = wid & 3, fr = lane & 15, fq = lane >> 4;
    const int nt = K / BK;
    unsigned voffB[2]; int Ra[2], Ca[2];
#pragma unroll
    for (int i = 0; i < 2; ++i) { int R, C; stage_rc(tid * 16 + i * 8192, R, C); const int Rb = Epi::PERM ? ((R & ~31) + perm32(R & 31)) : R;
        Ra[i] = R; Ca[i] = C; voffB[i] = (unsigned)(Rb * S.kb() + C) * 2u; }
    unsigned vAc[2][2], vAn[2][2];
    const size_t kstep = (size_t)(BK * 2);
    const size_t hstep = (size_t)HALF * S.kb() * 2;
    const int nth = nt / 2;
    const unsigned ldsw = (unsigned)wid * 1024u;
    const int aoff = lds_byte(wr * 64 + fr, fq * 8), boff = lds_byte(wc * 32 + fr, fq * 8);
#define PG8_SA(b, h) (((b) * 2 + (h)) * HTB)
#define PG8_SB(b, h) ((4 + (b) * 2 + (h)) * HTB)
#define PG8_STAGE(bufoff, gbase, voff) do { _Pragma("unroll") for (int _i = 0; _i < 2; ++_i) \
        __builtin_amdgcn_global_load_lds((const unsigned*)((const char*)(gbase) + (voff)[_i]), (LAS unsigned*)(lds + (bufoff) + ldsw + _i * 8192), 16, 0, 0); } while (0)
#define PG8_LDA(dst, b, h) do { _Pragma("unroll") for (int m = 0; m < 4; ++m) _Pragma("unroll") for (int k = 0; k < 2; ++k) dst[m][k] = *(const LAS bf16x8*)(lds + PG8_SA(b, h) + aoff + m * 2048 + k * 1024); } while (0)
#define PG8_LDB(dst, b, h) do { _Pragma("unroll") for (int n = 0; n < 2; ++n) _Pragma("unroll") for (int k = 0; k < 2; ++k) dst[n][k] = *(const LAS bf16x8*)(lds + PG8_SB(b, h) + boff + n * 2048 + k * 1024); } while (0)
#define PG8_MMA(ai, bj, At, Bt) do { __builtin_amdgcn_s_setprio(1); _Pragma("unroll") for (int m = 0; m < 4; ++m) _Pragma("unroll") for (int n = 0; n < 2; ++n) _Pragma("unroll") for (int k = 0; k < 2; ++k) \
        acc[ai][bj][m][n] = __builtin_amdgcn_mfma_f32_16x16x32_bf16(Bt[n][k], At[m][k], acc[ai][bj][m][n], 0, 0, 0); __builtin_amdgcn_s_setprio(0); } while (0)
#define PG8_WAIT_V(n) asm volatile("s_waitcnt vmcnt(" #n ")" ::: "memory")
#define PG8_WAIT_L(n) asm volatile("s_waitcnt lgkmcnt(" #n ")" ::: "memory")
#define PG8_BAR __builtin_amdgcn_s_barrier()
#define PG8_SCHED __builtin_amdgcn_sched_barrier(0)
    Unit cur, nxt; int ui = 0;
    if (!S.next(0, cur)) return;
    f32x4 acc[2][2][4][2];
#pragma unroll
    for (int a = 0; a < 2; ++a)
#pragma unroll
        for (int b = 0; b < 2; ++b)
#pragma unroll
            for (int m = 0; m < 4; ++m)
#pragma unroll
                for (int n = 0; n < 2; ++n) acc[a][b][m][n] = (f32x4){0.f, 0.f, 0.f, 0.f};
    bf16x8 At[4][2], B0[2][2], B1[2][2];
    const char* cA = S.abase(cur); const char* cB = S.bbase(cur); long dB2 = 0;
    if constexpr (Sched::SPLITB) dB2 = (S.bbase2(cur) - cB) - (long)nth * (long)kstep;
    S.a_offs(cur, vAc, Ra, Ca);
    PG8_STAGE(PG8_SB(0, 0), cB, voffB); PG8_STAGE(PG8_SB(0, 1), cB + hstep, voffB); PG8_STAGE(PG8_SA(0, 0), cA, vAc[0]); PG8_STAGE(PG8_SA(0, 1), cA, vAc[1]);
    if (wr == 1) PG8_BAR;
    PG8_WAIT_V(2); PG8_BAR;
    PG8_STAGE(PG8_SB(1, 0), cB + kstep, voffB); PG8_STAGE(PG8_SA(1, 0), cA + kstep, vAc[0]); PG8_STAGE(PG8_SB(1, 1), cB + hstep + kstep, voffB);
    PG8_WAIT_V(6); PG8_BAR;
    for (;;) {
        const bool has_next = S.next(ui + 1, nxt);
        const char* nA = has_next ? S.abase(nxt) : cA; const char* nB = has_next ? S.bbase(nxt) : cB;
        if constexpr (Sched::GATHER) {
            if (has_next) S.a_offs(nxt, vAn, Ra, Ca);
            else {
#pragma unroll
                for (int h = 0; h < 2; ++h)
#pragma unroll
                    for (int i = 0; i < 2; ++i) vAn[h][i] = vAc[h][i]; } }
        for (int t = 0; t < nt; t += 2) {
            const bool last = (t == nt - 2);
            const char* a1 = cA + (size_t)(t + 1) * kstep;
            const char* a2 = last ? nA : cA + (size_t)(t + 2) * kstep; const char* b2 = last ? nB : cB + (size_t)(t + 2) * kstep;
            if constexpr (Sched::SPLITB) { if (!last && t + 2 >= nth) b2 += dB2; }
            const char* a3 = a2 + kstep; const char* b3 = b2 + kstep;
            unsigned v0[2], v1[2];
#pragma unroll
            for (int i = 0; i < 2; ++i) { v0[i] = (Sched::GATHER && last) ? vAn[0][i] : vAc[0][i]; v1[i] = (Sched::GATHER && last) ? vAn[1][i] : vAc[1][i]; }
            PG8_LDB(B0, 0, 0); PG8_LDB(B1, 0, 1); PG8_SCHED; PG8_LDA(At, 0, 0); PG8_STAGE(PG8_SA(1, 1), a1, vAc[1]);
            PG8_WAIT_V(8); PG8_WAIT_L(0); PG8_BAR; PG8_MMA(0, 0, At, B0); PG8_MMA(0, 1, At, B1); PG8_BAR; PG8_SCHED;
            PG8_LDA(At, 0, 1); PG8_STAGE(PG8_SB(0, 0), b2, voffB); PG8_STAGE(PG8_SB(0, 1), b2 + hstep, voffB); PG8_STAGE(PG8_SA(0, 0), a2, v0);
            PG8_WAIT_V(8); PG8_WAIT_L(0); PG8_BAR; PG8_MMA(1, 0, At, B0); PG8_MMA(1, 1, At, B1); PG8_BAR; PG8_SCHED;
            PG8_LDB(B0, 1, 0); PG8_LDB(B1, 1, 1); PG8_SCHED; PG8_LDA(At, 1, 0); PG8_STAGE(PG8_SA(0, 1), a2, v1);
            PG8_WAIT_V(8); PG8_WAIT_L(0); PG8_BAR; PG8_MMA(0, 0, At, B0); PG8_MMA(0, 1, At, B1); PG8_BAR; PG8_SCHED;
            PG8_LDA(At, 1, 1); PG8_STAGE(PG8_SB(1, 0), b3, voffB); PG8_STAGE(PG8_SB(1, 1), b3 + hstep, voffB); PG8_STAGE(PG8_SA(1, 0), a3, v0);
            PG8_WAIT_V(8); PG8_WAIT_L(0); PG8_BAR; PG8_MMA(1, 0, At, B0); PG8_MMA(1, 1, At, B1); PG8_BAR; PG8_SCHED;
        }
        if constexpr (ALIGN_EPI) { if (wr == 0) PG8_BAR; }
        E(acc, cur, wr, wc, fr, fq);
        if (!has_next) break;
#pragma unroll
        for (int a = 0; a < 2; ++a)
#pragma unroll
            for (int b = 0; b < 2; ++b)
#pragma unroll
                for (int m = 0; m < 4; ++m)
#pragma unroll
                    for (int n = 0; n < 2; ++n) acc[a][b][m][n] = (f32x4){0.f, 0.f, 0.f, 0.f};
        cur = nxt; cA = nA; cB = nB; ++ui;
        if constexpr (Sched::SPLITB) dB2 = (S.bbase2(cur) - cB) - (long)nth * (long)kstep;
        if constexpr (Sched::GATHER) {
#pragma unroll
            for (int h = 0; h < 2; ++h)
#pragma unroll
                for (int i = 0; i < 2; ++i) vAc[h][i] = vAn[h][i]; }
        if constexpr (ALIGN_EPI) { if (wr == 1) PG8_BAR; }
    }
    PG8_WAIT_V(0);
    if constexpr (!ALIGN_EPI) { if (wr == 0) PG8_BAR; }
    PG8_BAR;
#undef PG8_SA
#undef PG8_SB
#undef PG8_STAGE
#undef PG8_LDA
#undef PG8_LDB
#undef PG8_MMA
#undef PG8_WAIT_V
#undef PG8_WAIT_L
#undef PG8_BAR
#undef PG8_SCHED
}
}


constexpr int MOE_TAB_OFF = SCR_BYTES + 1024;
__device__ __forceinline__ void moe_tables256(const int wv_, LAS unsigned char* lds, unsigned* cnt, unsigned* cntB) {
    LAS int* tstart = (LAS int*)(lds + MOE_TAB_OFF); LAS int* cnts = tstart + 64;
    __syncthreads();
    if (TIDX < 32) cnts[TIDX] = (int)__hip_atomic_load(cnt + TIDX * 64, __ATOMIC_RELAXED, __HIP_MEMORY_SCOPE_AGENT);
    else if (TIDX >= 64 && TIDX < 112) tstart[512 + TIDX - 64] = (int)__hip_atomic_load(cntB + (TIDX - 64) * 64, __ATOMIC_RELAXED, __HIP_MEMORY_SCOPE_AGENT);
    __syncthreads();
    if (TIDX == 0) { int t = 0; for (int e = 0; e < 32; ++e) { tstart[e] = t; t += (cnts[e] + 255) / 256; } tstart[32] = t; }
    else if (TIDX == 64) { int t = 0; for (int b = 0; b < 48; ++b) { tstart[448 + b] = t; t += (tstart[512 + b] + 255) / 256; } tstart[448 + 48] = t; }
    __syncthreads();
    for (int t = TIDX; t < tstart[32]; t += NTHREADS) { int e = 0; for (int k = 1; k < 32; ++k) e += (tstart[k] <= t) ? 1 : 0; tstart[128 + t] = e; }
    for (int t = TIDX; t < tstart[448 + 48]; t += NTHREADS) { int b = 0; for (int k = 1; k < 48; ++k) b += (tstart[448 + k] <= t) ? 1 : 0; tstart[576 + t] = b; }
    __syncthreads();
}
__device__ __forceinline__ void moe_up_phase256(const int wv_, LAS unsigned char* lds, const bf16* Hu, const u32x4* REC, const bf16* WupT, unsigned* cnt, unsigned* cntB, const unsigned* list, bf16* ACT2, unsigned* TOKOF,
                                                const float* cw_up, const float* cw_dn, bf16* cw_upT, bf16* cw_dnT, const float* cw_gain) {
    LAS int* tstart = (LAS int*)(lds + MOE_TAB_OFF); LAS int* cnts = tstart + 64;
    moe_tables256(wv_, lds, cnt, cntB);
    pg8::MoeGatherOrder S; S.init(Hu, WupT, 2 * DFF, DM, tstart, cnts); S.list = list;
    for (int o = blockIdx.x * NTHREADS + TIDX; o < NEXP * NTOK; o += gridDim.x * NTHREADS) { const int e = o >> 15, r = o & (NTOK - 1);
        if (r < cnts[e]) { const u32x4 rc = REC[o]; TOKOF[(size_t)tstart[448 + (rc.z >> 20)] * 256 + (rc.z & 0x7FFFFu)] = rc.w; } }
    pg8::EpiSwiglu E{ACT2, REC, tstart};
    pg8::gemm_phase<pg8::EpiSwiglu, pg8::MoeGatherOrder, false>(wv_, lds, DM, S, E);
    if (cw_up) {
        const int G = gridDim.x, units = tstart[32] * 4, rem = units % G; int first_idle = rem;
        if (rem == 0 || G - rem < G / 4) first_idle = 0;
        const int c = blockIdx.x;
        if (c >= first_idle) { const int wid = wv_, lane = TIDX & 63; LAS float* scr = (LAS float*)(lds + wid * 16384);
            const int gw = (c - first_idle) * NWAVES + wid, NGW = (G - first_idle) * NWAVES;
            cvt_mats<2, true>(cw_up, NEXP, DM, 2 * DFF, 2 * DFF, cw_upT, scr, gw, NGW, lane, cw_gain, 0);
            cvt_mats<0>(cw_dn, NEXP, DFF, DM, DM, cw_dnT, scr, gw, NGW, lane); }
    }
}
template <bool NEXT>
__device__ __forceinline__ void moe_down_phase256(const int wv_, LAS unsigned char* lds, const bf16* ACT2, const bf16* WdnT, unsigned* cnt, unsigned* cntB, const unsigned* TOKOF, bf16* XS, float* OUT, float* PART) {
    LAS int* tstart = (LAS int*)(lds + MOE_TAB_OFF);
    moe_tables256(wv_, lds, cnt, cntB);
    pg8::MoeBucketOrder S; S.init(ACT2, WdnT, tstart);
    pg8::EpiDown<NEXT> E{TOKOF, XS, OUT, PART};
    pg8::gemm_phase<pg8::EpiDown<NEXT>, pg8::MoeBucketOrder, false>(wv_, lds, 2 * DFF, S, E);
}
template <class Epi, bool ALIGN_EPI = true>
__device__ __forceinline__ void gemm_dense256(const int wv_, LAS unsigned char* lds, const bf16* A, const bf16* Bt, int M, int N, int K, const Epi& E) {
    pg8::DenseOrder S; S.init(A, Bt, M, N, K);
    pg8::gemm_phase<Epi, pg8::DenseOrder, ALIGN_EPI>(wv_, lds, K, S, E);
}

__device__ __forceinline__ void rstd_prepass(const int wv_, const float* PART, float* RSTD) {
    const int tid = TIDX;
    for (int row = blockIdx.x * (NTHREADS / 4) + (tid >> 2); row < NTOK; row += gridDim.x * (NTHREADS / 4)) {
        const f32x4 a = *(const f32x4*)(PART + (size_t)row * 32 + (tid & 3) * 8), b = *(const f32x4*)(PART + (size_t)row * 32 + (tid & 3) * 8 + 4);
        float s = ((a[0] + a[1]) + (a[2] + a[3])) + ((b[0] + b[1]) + (b[2] + b[3]));
        s += __shfl_xor(s, 1); s += __shfl_xor(s, 2);
        if ((tid & 3) == 0) RSTD[row] = 1.0f / sqrtf(s * (1.0f / DM) + EPS);
    }
}
template <bool RS>
__device__ __forceinline__ void sc_thin_phase(const int wv_, const bf16* Bg, const bf16* P, const float* cw  , bf16* Y, const float* RSTD) {
    const size_t total = (size_t)NTOK * (DM / 8), stride = (size_t)gridDim.x * NTHREADS;
    constexpr int NU = 4;
    for (size_t i0 = (size_t)blockIdx.x * NTHREADS + TIDX; i0 < total; i0 += NU * stride) {
        u32x4 p[NU][3], bb[NU]; float rr[NU][3];
#pragma unroll
        for (int k = 0; k < NU; ++k) { const size_t i = i0 + k * stride; const bool ok = i < total; const int n = ok ? (int)(i / (DM / 8)) : 0, d0 = ok ? (int)(i % (DM / 8)) * 8 : 0, t = n & (SEQ - 1);
#pragma unroll
            for (int j = 0; j < 3; ++j) { const int tt = t + j - 1; p[k][j] = (tt >= 0 && tt < SEQ) ? *(const u32x4*)(P + (size_t)(n + j - 1) * DM + d0) : (u32x4){0u, 0u, 0u, 0u};
                if constexpr (RS) rr[k][j] = (tt >= 0 && tt < SEQ) ? RSTD[n + j - 1] : 0.f; }
            bb[k] = *(const u32x4*)(Bg + (size_t)n * DM + d0); }
#pragma unroll
        for (int k = 0; k < NU; ++k) { const size_t i = i0 + k * stride; if (i >= total) continue; const int n = (int)(i / (DM / 8)), d0 = (int)(i % (DM / 8)) * 8;
            float acc[8];
#pragma unroll
            for (int q = 0; q < 8; ++q) acc[q] = 0.f;
#pragma unroll
            for (int j = 0; j < 3; ++j) { const u32x4 pp = p[k][j];
                f32x4 w0 = *(const f32x4*)(cw + j * DM + d0), w1 = *(const f32x4*)(cw + j * DM + d0 + 4);
                if constexpr (RS) { const float s2 = rr[k][j] * rr[k][j]; w0 *= s2; w1 *= s2; }
                acc[0] += bflo(pp.x) * w0[0]; acc[1] += bfhi(pp.x) * w0[1]; acc[2] += bflo(pp.y) * w0[2]; acc[3] += bfhi(pp.y) * w0[3];
                acc[4] += bflo(pp.z) * w1[0]; acc[5] += bfhi(pp.z) * w1[1]; acc[6] += bflo(pp.w) * w1[2]; acc[7] += bfhi(pp.w) * w1[3]; }
            const u32x4 b_ = bb[k];
            if constexpr (RS) {
#pragma unroll
                for (int q = 0; q < 8; ++q) acc[q] *= rr[k][1]; }
            u32x4 o; o.x = pk2(bflo(b_.x) * acc[0], bfhi(b_.x) * acc[1]); o.y = pk2(bflo(b_.y) * acc[2], bfhi(b_.y) * acc[3]);
            o.z = pk2(bflo(b_.z) * acc[4], bfhi(b_.z) * acc[5]); o.w = pk2(bflo(b_.w) * acc[6], bfhi(b_.w) * acc[7]);
            *(u32x4*)(Y + (size_t)n * DM + d0) = o; }
    }
}

__device__ __forceinline__ s16x4 tr_rd(unsigned addr) { s16x4 r; asm volatile("ds_read_b64_tr_b16 %0, %1" : "=v"(r) : "v"(addr) : "memory"); return r; }
__device__ __forceinline__ void hy_thin1_phase(const int wv_, const bf16* Z, const float* cw  , const float* cb  , bf16* X0, bf16* VT, LAS unsigned char* lds, const float* RSTD) {
    const int tid = TIDX, tl = tid >> 3, dc = tid & 7, lane = tid & 63, wv = wv_, grp = lane >> 4, li = lane & 15;
    const int items = (NTOK / 64) * (DM / 64);
    u32x4 z[3][3]; float zr[3];
#define T1_LOAD(it_) do { const int nt_ = (it_) / (DM / 64), db_ = (it_) % (DM / 64), n_ = nt_ * 64 + tl, t_ = n_ & (SEQ - 1), d0_ = db_ * 64 + dc * 8; \
        _Pragma("unroll") for (int j = 0; j < 3; ++j) { const int tt = t_ + j - 1; zr[j] = (tt >= 0 && tt < SEQ) ? RSTD[n_ + j - 1] : 0.f; } \
        _Pragma("unroll") for (int gI = 1; gI < 3; ++gI) _Pragma("unroll") for (int j = 0; j < 3; ++j) { const int tt = t_ + j - 1; \
            z[gI][j] = (tt >= 0 && tt < SEQ) ? *(const u32x4*)(Z + (size_t)(n_ + j - 1) * (3 * DM) + gI * DM + d0_) : (u32x4){0u, 0u, 0u, 0u}; } } while (0)
    if ((int)blockIdx.x < items) T1_LOAD(blockIdx.x);
    for (int it = blockIdx.x; it < items; it += gridDim.x) {
        const int nt = it / (DM / 64), db = it % (DM / 64), n = nt * 64 + tl, d0 = db * 64 + dc * 8;
        float u[3][8];
#pragma unroll
        for (int gI = 1; gI < 3; ++gI) { const int c0 = gI * DM + d0;
            const f32x4 b0 = *(const f32x4*)(cb + c0), b1 = *(const f32x4*)(cb + c0 + 4);
#pragma unroll
            for (int k = 0; k < 4; ++k) { u[gI][k] = b0[k]; u[gI][4 + k] = b1[k]; }
#pragma unroll
            for (int j = 0; j < 3; ++j) { const u32x4 zz = z[gI][j];
                const f32x4 w0 = *(const f32x4*)(cw + j * 3 * DM + c0) * zr[j], w1 = *(const f32x4*)(cw + j * 3 * DM + c0 + 4) * zr[j];
                u[gI][0] += bflo(zz.x) * w0[0]; u[gI][1] += bfhi(zz.x) * w0[1]; u[gI][2] += bflo(zz.y) * w0[2]; u[gI][3] += bfhi(zz.y) * w0[3];
                u[gI][4] += bflo(zz.z) * w1[0]; u[gI][5] += bfhi(zz.z) * w1[1]; u[gI][6] += bflo(zz.w) * w1[2]; u[gI][7] += bfhi(zz.w) * w1[3]; } }
        u32x4 vx; vx.x = pk2(u[2][0] * u[1][0], u[2][1] * u[1][1]); vx.y = pk2(u[2][2] * u[1][2], u[2][3] * u[1][3]); vx.z = pk2(u[2][4] * u[1][4], u[2][5] * u[1][5]); vx.w = pk2(u[2][6] * u[1][6], u[2][7] * u[1][7]);
        __syncthreads();
        *(LAS u32x4*)(lds + tl * 144 + dc * 16) = vx;
        if (it + (int)gridDim.x < items) T1_LOAD(it + gridDim.x);
        __syncthreads();
        { const unsigned a0 = (unsigned)(size_t)(lds + (32 * (wv >> 2) + 8 * grp + (li >> 2)) * 144 + (16 * (wv & 3) + 4 * (li & 3)) * 2);
            s16x4 lo = tr_rd(a0), hi = tr_rd(a0 + 4 * 144);
            asm volatile("s_waitcnt lgkmcnt(0)" : "+v"(lo), "+v"(hi) :: "memory");
            const int bidx = (nt * 64) / SEQ, t0 = (nt * 64) & (SEQ - 1);
            const bf16x8 ov = (bf16x8){lo[0], lo[1], lo[2], lo[3], hi[0], hi[1], hi[2], hi[3]};
            *(bf16x8*)(VT + ((size_t)bidx * DM + db * 64 + 16 * (wv & 3) + li) * SEQ + t0 + 32 * (wv >> 2) + 8 * grp) = ov; }
    }
#undef T1_LOAD
}

constexpr int LC_KR0 = 0, LC_KR1 = 16384 + 64, LC_V = 33024, LC_VROW = 2176;
__device__ __forceinline__ int lc_vrow_byte(int b) { return (b * LC_VROW + 4 * (b & 3)) * 4; }
__device__ __forceinline__ bf16x8 lc_ld_a(const LAS unsigned char* p) {
    const unsigned w0 = *(const LAS unsigned*)(p), w1 = *(const LAS unsigned*)(p + 4), w2 = *(const LAS unsigned*)(p + 8), w3 = *(const LAS unsigned*)(p + 12);
    u32x4 w = {w0, w1, w2, w3}; return __builtin_bit_cast(bf16x8, w);
}
__device__ __forceinline__ void longconv_phase(const int wv_, const bf16* KRB, const bf16* VT, const float* skip, bf16* YST, LAS unsigned char* lds) {
    const int tid = TIDX, lane = tid & 63, wid = wv_, r32 = lane & 31, hi = lane >> 5;
    for (int i = tid; i < 8 * 192; i += NTHREADS) { const int b = i / 192, j = i % 192, sp = j < 96 ? j : 4096 + j;
        *(LAS bf16*)(lds + LC_V + lc_vrow_byte(b) + 2 * sp) = 0; }
    const int T0 = 512 * wid, P = 4095 - T0 - r32 + 8 * hi, cpy = P & 1;
    const int Al = (cpy ? LC_KR1 : LC_KR0) + 2 * (P - cpy) - 960;
    const int q = r32 >> 3, bb = r32 & 7, Vl = LC_V + lc_vrow_byte(bb) + 64 * q + 16 * hi;
    u32x4 pk0, pk1, pk2_, pk3, vr[8];
#define LC_LOAD(dd) do { const u32x4* k0 = (const u32x4*)(KRB + (size_t)(dd) * 8192), * k1 = (const u32x4*)(KRB + (size_t)DM * 8192 + (size_t)(dd) * 8192); \
        pk0 = k0[tid]; pk1 = k0[tid + 512]; pk2_ = k1[tid]; pk3 = k1[tid + 512]; \
        _Pragma("unroll") for (int i = 0; i < 8; ++i) vr[i] = *((const u32x4*)(VT + ((size_t)i * DM + (dd)) * SEQ) + tid); } while (0)
    if ((int)blockIdx.x < DM) LC_LOAD(blockIdx.x);
    for (int d = blockIdx.x; d < DM; d += gridDim.x) {
        __syncthreads();
        *(LAS u32x4*)(lds + LC_KR0 + tid * 16) = pk0; *(LAS u32x4*)(lds + LC_KR0 + (tid + 512) * 16) = pk1;
        *(LAS u32x4*)(lds + LC_KR1 + tid * 16) = pk2_; *(LAS u32x4*)(lds + LC_KR1 + (tid + 512) * 16) = pk3;
#pragma unroll
        for (int i = 0; i < 8; ++i) *(LAS u32x4*)(lds + LC_V + lc_vrow_byte(i) + 192 + tid * 16) = vr[i];
        __syncthreads();
        if (d + (int)gridDim.x < DM) LC_LOAD(d + gridDim.x);
        f32x16 acc[4];
#pragma unroll
        for (int g = 0; g < 4; ++g)
#pragma unroll
            for (int r = 0; r < 16; ++r) acc[g][r] = 0.f;
        for (int a = 0; a < 8; ++a) {
            const LAS unsigned char* ab = lds + Al + 1024 * a; const LAS unsigned char* vb = lds + Vl + 1024 * a;
#pragma unroll
            for (int u = 0; u < 8; ++u) {
                bf16x8 At[7], Bt[4];
#pragma unroll
                for (int jp = 0; jp < 7; ++jp) At[jp] = lc_ld_a(ab + 768 + 32 * u - 256 * (jp - 3));
#pragma unroll
                for (int h = 0; h < 4; ++h) Bt[h] = *(const LAS bf16x8*)(vb + 32 * u + 256 * h);
#pragma unroll
                for (int h = 0; h < 4; ++h)
#pragma unroll
                    for (int g = 0; g < 4; ++g) acc[g] = __builtin_amdgcn_mfma_f32_32x32x16_bf16(At[g - h + 3], Bt[h], acc[g], 0, 0, 0);
            }
        }
        { const LAS unsigned char* ab = lds + Al + 8192; const LAS unsigned char* vb = lds + Vl + 8192;
#pragma unroll
            for (int u = 0; u < 6; ++u) {
                const bf16x8 B0 = *(const LAS bf16x8*)(vb + 32 * u);
#pragma unroll
                for (int g = 0; g < 4; ++g) { const bf16x8 A0 = lc_ld_a(ab + 768 + 32 * u - 256 * g); acc[g] = __builtin_amdgcn_mfma_f32_32x32x16_bf16(A0, B0, acc[g], 0, 0, 0); }
            } }
        const float sk = skip[d];
#pragma unroll
        for (int g = 0; g < 4; ++g)
#pragma unroll
            for (int rr = 0; rr < 4; ++rr) { const int t = T0 + 128 * g + 32 * q + 8 * rr + 4 * hi;
                const u32x2 vv = *(const LAS u32x2*)(lds + LC_V + lc_vrow_byte(bb) + (96 + t) * 2);
                u32x2 o; o.x = pk2(acc[g][4 * rr + 0] + bflo(vv.x) * sk, acc[g][4 * rr + 1] + bfhi(vv.x) * sk); o.y = pk2(acc[g][4 * rr + 2] + bflo(vv.y) * sk, acc[g][4 * rr + 3] + bfhi(vv.y) * sk);
                *(u32x2*)(YST + ((size_t)bb * DM + d) * SEQ + t) = o; }
    }
#undef LC_LOAD
}

__device__ __forceinline__ void hy_thin2_phase(const int wv_, const bf16* YST, const bf16* Z, const float* cw  , const float* cb  , const float* RSTD, bf16* G, LAS unsigned char* lds) {
    const int tid = TIDX, dl = tid >> 3, tc = tid & 7, lane = tid & 63, wv = wv_, grp = lane >> 4, li = lane & 15;
    constexpr int items = (NTOK / 64) * (DM / 64), NI = 4, TILE = 64 * 144;
    u32x4 yv[NI];
#define T2_LOAD(g_) do { _Pragma("unroll") for (int k = 0; k < NI; ++k) { const int it_ = (g_) * NI + k; if (it_ < items) { const int nt_ = it_ / (DM / 64), db_ = it_ % (DM / 64), bi_ = (nt_ * 64) / SEQ, t0_ = (nt_ * 64) & (SEQ - 1); \
        yv[k] = *(const u32x4*)(YST + ((size_t)bi_ * DM + db_ * 64 + dl) * SEQ + t0_ + tc * 8); } } } while (0)
    if ((int)blockIdx.x * NI < items) T2_LOAD(blockIdx.x);
    for (int gi = blockIdx.x; gi * NI < items; gi += gridDim.x) {
        u32x4 zq[NI][3]; float zs[NI][3]; size_t goff[NI]; int dq[NI];
#pragma unroll
        for (int k = 0; k < NI; ++k) { const int it = gi * NI + k < items ? gi * NI + k : items - 1; const int nt = it / (DM / 64), db = it % (DM / 64);
            const int n = nt * 64 + 16 * (wv & 3) + li, t = n & (SEQ - 1); dq[k] = db * 64 + 32 * (wv >> 2) + 8 * grp; goff[k] = (size_t)n * DM + dq[k];
#pragma unroll
            for (int j = 0; j < 3; ++j) { const int tt = t + j - 1; const bool ok = tt >= 0 && tt < SEQ;
                zq[k][j] = ok ? *(const u32x4*)(Z + (size_t)(n + j - 1) * (3 * DM) + dq[k]) : (u32x4){0u, 0u, 0u, 0u}; zs[k][j] = ok ? RSTD[n + j - 1] : 0.f; } }
        __syncthreads();
#pragma unroll
        for (int k = 0; k < NI; ++k) *(LAS u32x4*)(lds + k * TILE + dl * 144 + tc * 16) = yv[k];
        if ((gi + (int)gridDim.x) * NI < items) T2_LOAD(gi + gridDim.x);
        __syncthreads();
        const unsigned a0 = (unsigned)(size_t)(lds + (32 * (wv >> 2) + 8 * grp + (li >> 2)) * 144 + (16 * (wv & 3) + 4 * (li & 3)) * 2);
#pragma unroll
        for (int k = 0; k < NI; ++k) {
            s16x4 lo = tr_rd(a0 + k * TILE), hi = tr_rd(a0 + k * TILE + 4 * 144);
            asm volatile("s_waitcnt lgkmcnt(0)" : "+v"(lo), "+v"(hi) :: "memory");
            const u32x2 l2 = __builtin_bit_cast(u32x2, lo), h2 = __builtin_bit_cast(u32x2, hi);
            float x[8]; { const f32x4 b0 = *(const f32x4*)(cb + dq[k]), b1 = *(const f32x4*)(cb + dq[k] + 4);
#pragma unroll
                for (int e = 0; e < 4; ++e) { x[e] = b0[e]; x[4 + e] = b1[e]; } }
#pragma unroll
            for (int j = 0; j < 3; ++j) { const u32x4 zz = zq[k][j]; const f32x4 w0 = *(const f32x4*)(cw + j * 3 * DM + dq[k]) * zs[k][j], w1 = *(const f32x4*)(cw + j * 3 * DM + dq[k] + 4) * zs[k][j];
                x[0] += bflo(zz.x) * w0[0]; x[1] += bfhi(zz.x) * w0[1]; x[2] += bflo(zz.y) * w0[2]; x[3] += bfhi(zz.y) * w0[3];
                x[4] += bflo(zz.z) * w1[0]; x[5] += bfhi(zz.z) * w1[1]; x[6] += bflo(zz.w) * w1[2]; x[7] += bfhi(zz.w) * w1[3]; }
            u32x4 o; o.x = pk2(bflo(l2.x) * x[0], bfhi(l2.x) * x[1]); o.y = pk2(bflo(l2.y) * x[2], bfhi(l2.y) * x[3]);
            o.z = pk2(bflo(h2.x) * x[4], bfhi(h2.x) * x[5]); o.w = pk2(bflo(h2.y) * x[6], bfhi(h2.y) * x[7]);
            if (gi * NI + k < items) *(u32x4*)(G + goff[k]) = o; }
    }
#undef T2_LOAD
}

__device__ __forceinline__ void mla_thin1_phase(const int wv_, const bf16* DOWN, const float* qn, const float* kvn, bf16* CQ, bf16* CKV, const float* RSTD) {
    const int lane = TIDX & 63, wid = wv_;
    constexpr int NR = 4;
    for (int rg = blockIdx.x * NWAVES + wid; rg < NTOK / NR; rg += gridDim.x * NWAVES) {
        u32x2 va[NR][2], vb[NR][2];
#pragma unroll
        for (int r = 0; r < NR; ++r)
#pragma unroll
            for (int part = 0; part < 2; ++part) { const bf16* dp = DOWN + (size_t)(rg * NR + r) * NDOWNP + part * 512; va[r][part] = *(const u32x2*)(dp + lane * 4); vb[r][part] = *(const u32x2*)(dp + 256 + lane * 4); }
#pragma unroll
        for (int r = 0; r < NR; ++r)
#pragma unroll
            for (int part = 0; part < 2; ++part) { const int row = rg * NR + r; const float rsx = RSTD[row]; const u32x2 ua = va[r][part], ub = vb[r][part];
                const f32x4 a = (f32x4){bflo(ua.x), bfhi(ua.x), bflo(ua.y), bfhi(ua.y)} * rsx, b = (f32x4){bflo(ub.x), bfhi(ub.x), bflo(ub.y), bfhi(ub.y)} * rsx;
                float ss = a[0] * a[0] + a[1] * a[1] + a[2] * a[2] + a[3] * a[3] + b[0] * b[0] + b[1] * b[1] + b[2] * b[2] + b[3] * b[3];
                ss = wave_sum(ss); const float rs = 1.0f / sqrtf(ss * (1.0f / 512.0f) + EPS);
                const float* gn = part ? kvn : qn; const f32x4 ga = *(const f32x4*)(gn + lane * 4), gb = *(const f32x4*)(gn + 256 + lane * 4);
                bf16* o = (part ? CKV : CQ) + (size_t)row * 512;
                u32x2 oa, ob; oa.x = pk2(a[0] * rs * ga[0], a[1] * rs * ga[1]); oa.y = pk2(a[2] * rs * ga[2], a[3] * rs * ga[3]);
                ob.x = pk2(b[0] * rs * gb[0], b[1] * rs * gb[1]); ob.y = pk2(b[2] * rs * gb[2], b[3] * rs * gb[3]);
                *(u32x2*)(o + lane * 4) = oa; *(u32x2*)(o + 256 + lane * 4) = ob; }
    }
}
__device__ __forceinline__ void mla_thin2_phase(const int wv_, const bf16* QRAW, const bf16* KVRAW, const bf16* DOWN, const float* qg, const float* kg, const f32x2* ROPE, bf16* Q, bf16* K, const float* RSTD) {
    const int lane = TIDX & 63, wid = wv_, grp = lane >> 5, j = lane & 31, jc = j < 24 ? j : 23;
    const bool act = j < 24, isrope = j >= 16 && j < 24, isx2 = j >= 20;
    float qgv[8], kgv[8];
#pragma unroll
    for (int k = 0; k < 8; ++k) { qgv[k] = qg[8 * jc + k]; kgv[k] = kg[8 * jc + k]; }
    for (int row = blockIdx.x * NWAVES + wid; row < NTOK; row += gridDim.x * NWAVES) {
        const int t = row & (SEQ - 1);
        float cs[8], sn[8], kr[8];
#pragma unroll
        for (int k = 0; k < 8; ++k) { cs[k] = 1.f; sn[k] = 0.f; kr[k] = 0.f; }
        if (isrope) { const f32x4* rp = (const f32x4*)(ROPE + (size_t)t * 32 + 8 * ((j - 16) & 3));
            const f32x4 r0 = rp[0], r1 = rp[1], r2 = rp[2], r3 = rp[3];
            cs[0] = r0[0]; sn[0] = r0[1]; cs[1] = r0[2]; sn[1] = r0[3]; cs[2] = r1[0]; sn[2] = r1[1]; cs[3] = r1[2]; sn[3] = r1[3];
            cs[4] = r2[0]; sn[4] = r2[1]; cs[5] = r2[2]; sn[5] = r2[3]; cs[6] = r3[0]; sn[6] = r3[1]; cs[7] = r3[2]; sn[7] = r3[3];
            const u32x4 k0 = *(const u32x4*)(DOWN + (size_t)row * NDOWNP + 1024 + 8 * (j - 16));
            kr[0] = bflo(k0.x); kr[1] = bfhi(k0.x); kr[2] = bflo(k0.y); kr[3] = bfhi(k0.y); kr[4] = bflo(k0.z); kr[5] = bfhi(k0.z); kr[6] = bflo(k0.w); kr[7] = bfhi(k0.w);
            { const float rsx = RSTD[row];
#pragma unroll
                for (int k = 0; k < 8; ++k) kr[k] *= rsx; }
            if (!isx2) {
#pragma unroll
                for (int k = 0; k < 8; ++k) sn[k] = -sn[k]; } }
        u32x4 kx[NH / 2];
#pragma unroll
        for (int hp = 0; hp < NH / 2; ++hp) { const int h = 2 * hp + grp;
            kx[hp] = *(const u32x4*)(KVRAW + (size_t)row * 4096 + h * 256 + 8 * (j < 16 ? j : 0)); }
#pragma unroll
        for (int hp = 0; hp < NH / 2; ++hp) {
            const int h = 2 * hp + grp;
#pragma unroll
            for (int qk = 1; qk < 2; ++qk) {
                float v[8]; const u32x4 x = kx[hp];
                v[0] = bflo(x.x); v[1] = bfhi(x.x); v[2] = bflo(x.y); v[3] = bfhi(x.y); v[4] = bflo(x.z); v[5] = bfhi(x.z); v[6] = bflo(x.w); v[7] = bfhi(x.w);
                if (qk == 1 && j >= 16) {
#pragma unroll
                    for (int k = 0; k < 8; ++k) v[k] = kr[k]; }
                float ss = 0.f;
#pragma unroll
                for (int k = 0; k < 8; ++k) ss += v[k] * v[k];
                ss = act ? ss : 0.f;
                ss += __shfl_xor(ss, 1); ss += __shfl_xor(ss, 2); ss += __shfl_xor(ss, 4); ss += __shfl_xor(ss, 8); ss += __shfl_xor(ss, 16);
                const float rs = 1.0f / sqrtf(ss * (1.0f / 192.0f) + EPS);
                float o[8];
#pragma unroll
                for (int k = 0; k < 8; ++k) { const float n = v[k] * rs * (qk == 0 ? qgv[k] : kgv[k]); const float pr = __shfl_xor(n, 4); o[k] = n * cs[k] + pr * sn[k]; }
                if (act) { u32x4 w; w.x = pk2(o[0], o[1]); w.y = pk2(o[2], o[3]); w.z = pk2(o[4], o[5]); w.w = pk2(o[6], o[7]);
                    *(u32x4*)((qk == 0 ? Q : K) + (size_t)row * 3072 + h * DQK + 8 * j) = w; }
            }
        }
    }
}

namespace attn {
constexpr int KVBLK = 64, QBLK = 32;
constexpr float SCALE = 0.07216878364870322f;
constexpr float THR = 8.f;
constexpr int LDQ = 3072, LDK = 3072, LDV = 4096, LDO = 2048;
constexpr int SHM_V = KVBLK * DV * 2, SHM_K = KVBLK * DQK * 2;
#define KSWZ(row, colB) ((row) * 384 + ((colB) ^ ((((row) >> 1) & 7) << 4)))
#define SBAR() __builtin_amdgcn_sched_barrier(0)
__device__ __forceinline__ unsigned cvtpk(float lo, float hi) { unsigned r; asm volatile("v_cvt_pk_bf16_f32 %0, %1, %2" : "=v"(r) : "v"(lo), "v"(hi)); return r; }
__device__ __forceinline__ void partialSM(f32x16& p0, f32x16& p1, float& m_reg, float& mn, float& alpha) {
    constexpr float C = SCALE * 1.4426950408889634f;
    float pmax = p0[0];
#pragma unroll
    for (int r = 1; r < 16; ++r) pmax = fmaxf(pmax, p0[r]);
#pragma unroll
    for (int r = 0; r < 16; ++r) pmax = fmaxf(pmax, p1[r]);
    { auto rr = __builtin_amdgcn_permlane32_swap(__float_as_uint(pmax), __float_as_uint(pmax), false, false);
      pmax = fmaxf(__uint_as_float(rr[0]), __uint_as_float(rr[1])); }
    if (__builtin_expect(__all(pmax - m_reg <= THR / SCALE), 1)) { mn = m_reg; alpha = 1.f; }
    else { mn = fmaxf(m_reg, pmax); alpha = __builtin_amdgcn_exp2f((m_reg - mn) * C); m_reg = mn; }
    const float mnC = -mn * C;
#pragma unroll
    for (int r = 0; r < 16; ++r) p0[r] = fmaf(p0[r], C, mnC);
#pragma unroll
    for (int r = 0; r < 16; ++r) p1[r] = fmaf(p1[r], C, mnC);
#pragma unroll
    for (int r = 0; r < 16; ++r) p0[r] = __builtin_amdgcn_exp2f(p0[r]);
}
__device__ __forceinline__ void finishSM(f32x16& p0, f32x16& p1, float alpha, float& l_reg, bf16x8& pa0, bf16x8& pa1, bf16x8& pa2, bf16x8& pa3) {
#pragma unroll
    for (int r = 0; r < 16; ++r) p1[r] = __builtin_amdgcn_exp2f(p1[r]);
    float ps = 0;
#pragma unroll
    for (int r = 0; r < 16; ++r) ps += p0[r];
#pragma unroll
    for (int r = 0; r < 16; ++r) ps += p1[r];
    { auto rr = __builtin_amdgcn_permlane32_swap(__float_as_uint(ps), __float_as_uint(ps), false, false);
      ps = __uint_as_float(rr[0]) + __uint_as_float(rr[1]); }
    l_reg = l_reg * alpha + ps;
#define PK4(P, BASE, OUT) do { unsigned a0 = cvtpk(P[BASE + 0], P[BASE + 1]), a1 = cvtpk(P[BASE + 2], P[BASE + 3]);   \
    unsigned b0 = cvtpk(P[BASE + 4], P[BASE + 5]), b1 = cvtpk(P[BASE + 6], P[BASE + 7]);                              \
    auto r0 = __builtin_amdgcn_permlane32_swap(a0, b0, false, false); auto r1 = __builtin_amdgcn_permlane32_swap(a1, b1, false, false); \
    u32x4 w = {r0[0], r1[0], r0[1], r1[1]}; OUT = __builtin_bit_cast(bf16x8, w); } while (0)
    PK4(p0, 0, pa0); PK4(p0, 8, pa1); PK4(p1, 0, pa2); PK4(p1, 8, pa3);
#undef PK4
}
__device__ __forceinline__ void qkt(f32x16& p0, f32x16& p1, const LAS unsigned char* Ks, const bf16x8* qr, int r32, int hi) {
#pragma unroll
    for (int i = 0; i < 16; ++i) { p0[i] = 0.f; p1[i] = 0.f; }
#pragma unroll
    for (int d0 = 0; d0 < 12; ++d0) { const int cb = (d0 * 16 + hi * 8) * 2;
        const bf16x8 b0 = *(const LAS bf16x8*)(Ks + KSWZ(r32, cb));
        const bf16x8 b1 = *(const LAS bf16x8*)(Ks + KSWZ(32 + r32, cb));
        p0 = __builtin_amdgcn_mfma_f32_32x32x16_bf16(b0, qr[d0], p0, 0, 0, 0);
        p1 = __builtin_amdgcn_mfma_f32_32x32x16_bf16(b1, qr[d0], p1, 0, 0, 0); }
}
__device__ __forceinline__ int v_st(int k, int c) { const int kk = (k & ~0xC) | ((k & 4) << 1) | ((k & 8) >> 1); return ((kk >> 3) * 4 + (c >> 5)) * 512 + ((kk & 7) * 32 + (c & 31)) * 2; }
__device__ __forceinline__ int v_rd_base(int lane) { return ((lane & 3) << 3) | (((lane >> 2) & 3) << 6) | (((lane >> 4) & 1) << 5) | (((lane >> 5) & 1) << 8); }
constexpr int v_rd_off(int d0, int ks, int half) { return d0 * 512 + ks * 4096 + half * 2048; }
template <int OFF> __device__ __forceinline__ s16x4 tr_read(int vb) {
    s16x4 r; asm volatile("ds_read_b64_tr_b16 %0, %1 offset:%2" : "=&v"(r) : "v"(vb), "i"(OFF) : "memory"); return r;
}
template <int D0> __device__ __forceinline__ void pv_one(f32x16& od, int vb, bf16x8 pa0, bf16x8 pa1, bf16x8 pa2, bf16x8 pa3) {
    const s16x4 l0 = tr_read<v_rd_off(D0, 0, 0)>(vb), h0 = tr_read<v_rd_off(D0, 0, 1)>(vb), l1 = tr_read<v_rd_off(D0, 1, 0)>(vb), h1 = tr_read<v_rd_off(D0, 1, 1)>(vb);
    const s16x4 l2 = tr_read<v_rd_off(D0, 2, 0)>(vb), h2 = tr_read<v_rd_off(D0, 2, 1)>(vb), l3 = tr_read<v_rd_off(D0, 3, 0)>(vb), h3 = tr_read<v_rd_off(D0, 3, 1)>(vb);
    asm volatile("s_waitcnt lgkmcnt(0)" ::: "memory"); SBAR();
#define PKV(L, H) (bf16x8){L[0], L[1], L[2], L[3], H[0], H[1], H[2], H[3]}
    od = __builtin_amdgcn_mfma_f32_32x32x16_bf16(pa0, PKV(l0, h0), od, 0, 0, 0);
    od = __builtin_amdgcn_mfma_f32_32x32x16_bf16(pa1, PKV(l1, h1), od, 0, 0, 0);
    od = __builtin_amdgcn_mfma_f32_32x32x16_bf16(pa2, PKV(l2, h2), od, 0, 0, 0);
    od = __builtin_amdgcn_mfma_f32_32x32x16_bf16(pa3, PKV(l3, h3), od, 0, 0, 0);
#undef PKV
}
__device__ __forceinline__ void pv_d0(f32x16* o, int vb, bf16x8 pa0, bf16x8 pa1, bf16x8 pa2, bf16x8 pa3) {
    pv_one<0>(o[0], vb, pa0, pa1, pa2, pa3); pv_one<1>(o[1], vb, pa0, pa1, pa2, pa3); pv_one<2>(o[2], vb, pa0, pa1, pa2, pa3); pv_one<3>(o[3], vb, pa0, pa1, pa2, pa3);
}
__device__ __forceinline__ void unit(const int wv_, const bf16* __restrict__ Qb, const bf16* __restrict__ Kh, const bf16* __restrict__ Vh, bf16* __restrict__ Ob, int seq, LAS unsigned char* lds,
                                     const float* __restrict__ qg, const f32x2* __restrict__ ROPE, int t0) {
    const int tid = TIDX, wid = wv_, lane = tid & 63, r32 = lane & 31, hi = lane >> 5;
    LAS unsigned char* V_lds = lds; LAS unsigned char* K_lds = lds + 3 * SHM_V;
    LAS float* ws = (LAS float*)(lds + 3 * SHM_V + 3 * SHM_K) + wid * 64; LAS float* li_l = ws; LAS float* al_l = ws + 32;
    float m_reg = -1e30f, l_reg = 0; f32x16 o[4]; bf16x8 qr[12];
#pragma unroll
    for (int d = 0; d < 4; ++d)
#pragma unroll
        for (int r = 0; r < 16; ++r) o[d][r] = 0.f;
    const bf16* Qw = Qb + (long)(wid * QBLK + r32) * LDQ + hi * 8;
#pragma unroll
    for (int d0 = 0; d0 < 12; ++d0) qr[d0] = *(const bf16x8*)(Qw + d0 * 16);
    const int wu = wv_;
    int koff[3], voff[2];
#pragma unroll
    for (int i = 0; i < 3; ++i) { const int p = (i * 8 + wid) * 64 + lane, row = p / 24, cidx = p % 24; koff[i] = row * LDK + ((cidx ^ ((row >> 1) & 7)) * 8); }
#pragma unroll
    for (int i = 0; i < 2; ++i) { const int p = (i * 8 + wid) * 64 + lane, sub = p >> 5, q5 = p & 31, kk = (sub >> 2) * 8 + (q5 >> 2), k = (kk & ~0xC) | ((kk & 4) << 1) | ((kk & 8) >> 1), c = (sub & 3) * 32 + (q5 & 3) * 8;
        voff[i] = k * LDV + c; }
    const int vb0 = (int)(uintptr_t)V_lds + v_rd_base(lane);
#define DMA_TILE(b, k0) do { const bf16* Kt_ = Kh + (long)(k0) * LDK; const bf16* Vt_ = Vh + (long)(k0) * LDV; \
    _Pragma("unroll") for (int i = 0; i < 3; ++i) __builtin_amdgcn_global_load_lds((const GAS unsigned*)(Kt_ + koff[i]), (LAS unsigned*)(K_lds + (b) * SHM_K + (i * 8 + wu) * 1024), 16, 0, 0); \
    _Pragma("unroll") for (int i = 0; i < 2; ++i) __builtin_amdgcn_global_load_lds((const GAS unsigned*)(Vt_ + voff[i]), (LAS unsigned*)(V_lds + (b) * SHM_V + (i * 8 + wu) * 1024), 16, 0, 0); } while (0)
#define RESC(a) do { if (__any((a) < 1.f)) { if (hi == 0) al_l[r32] = (a); asm volatile("s_waitcnt lgkmcnt(0)" ::: "memory"); \
    _Pragma("unroll") for (int d = 0; d < 4; ++d) _Pragma("unroll") for (int r = 0; r < 16; ++r) o[d][r] *= al_l[crow(r, hi)]; } } while (0)
    f32x16 pA0, pA1, pB0, pB1; float mnA, mnB, alA, alB; bf16x8 pa0, pa1, pa2, pa3; const int NT = seq / KVBLK;
#define VMWAIT() asm volatile("s_waitcnt vmcnt(0)" ::: "memory")
    __syncthreads();
    DMA_TILE(0, 0);
    {
        float ss = 0.f;
#pragma unroll
        for (int d0 = 0; d0 < 12; ++d0) { const u32x4 w = __builtin_bit_cast(u32x4, qr[d0]);
            const float a0 = bflo(w.x), a1 = bfhi(w.x), a2 = bflo(w.y), a3 = bfhi(w.y), a4 = bflo(w.z), a5 = bfhi(w.z), a6 = bflo(w.w), a7 = bfhi(w.w);
            ss += a0 * a0 + a1 * a1 + a2 * a2 + a3 * a3 + a4 * a4 + a5 * a5 + a6 * a6 + a7 * a7; }
        ss += __shfl_xor(ss, 32);
        const float rs = 1.0f / sqrtf(ss * (1.0f / 192.0f) + EPS);
#pragma unroll
        for (int d0 = 0; d0 < 8; ++d0) { const u32x4 w = __builtin_bit_cast(u32x4, qr[d0]); const f32x4 g0 = *(const f32x4*)(qg + d0 * 16 + hi * 8) * rs, g1 = *(const f32x4*)(qg + d0 * 16 + hi * 8 + 4) * rs;
            u32x4 o_; o_.x = cvtpk(bflo(w.x) * g0[0], bfhi(w.x) * g0[1]); o_.y = cvtpk(bflo(w.y) * g0[2], bfhi(w.y) * g0[3]); o_.z = cvtpk(bflo(w.z) * g1[0], bfhi(w.z) * g1[1]); o_.w = cvtpk(bflo(w.w) * g1[2], bfhi(w.w) * g1[3]);
            qr[d0] = __builtin_bit_cast(bf16x8, o_); }
        const f32x2* rp = ROPE + (size_t)(t0 + wid * QBLK + r32) * 32 + hi * 8;
#pragma unroll
        for (int d0 = 8; d0 < 10; ++d0) { const u32x4 wa = __builtin_bit_cast(u32x4, qr[d0]), wb = __builtin_bit_cast(u32x4, qr[d0 + 2]);
            float a[8], b[8], oa[8], ob[8];
            a[0] = bflo(wa.x); a[1] = bfhi(wa.x); a[2] = bflo(wa.y); a[3] = bfhi(wa.y); a[4] = bflo(wa.z); a[5] = bfhi(wa.z); a[6] = bflo(wa.w); a[7] = bfhi(wa.w);
            b[0] = bflo(wb.x); b[1] = bfhi(wb.x); b[2] = bflo(wb.y); b[3] = bfhi(wb.y); b[4] = bflo(wb.z); b[5] = bfhi(wb.z); b[6] = bflo(wb.w); b[7] = bfhi(wb.w);
#pragma unroll
            for (int j4 = 0; j4 < 2; ++j4) { const f32x4 ga = *(const f32x4*)(qg + d0 * 16 + hi * 8 + 4 * j4) * rs, gb = *(const f32x4*)(qg + (d0 + 2) * 16 + hi * 8 + 4 * j4) * rs;
                const f32x4 c01 = *(const f32x4*)(rp + (d0 - 8) * 16 + 4 * j4), c23 = *(const f32x4*)(rp + (d0 - 8) * 16 + 4 * j4 + 2);
#pragma unroll
                for (int jj = 0; jj < 4; ++jj) { const int j = 4 * j4 + jj; const float cs = jj < 2 ? c01[2 * jj] : c23[2 * (jj - 2)], sn = jj < 2 ? c01[2 * jj + 1] : c23[2 * (jj - 2) + 1];
                    const float na = a[j] * ga[jj], nb = b[j] * gb[jj]; oa[j] = na * cs - nb * sn; ob[j] = nb * cs + na * sn; } }
            u32x4 pa_, pb_; pa_.x = cvtpk(oa[0], oa[1]); pa_.y = cvtpk(oa[2], oa[3]); pa_.z = cvtpk(oa[4], oa[5]); pa_.w = cvtpk(oa[6], oa[7]);
            pb_.x = cvtpk(ob[0], ob[1]); pb_.y = cvtpk(ob[2], ob[3]); pb_.z = cvtpk(ob[4], ob[5]); pb_.w = cvtpk(ob[6], ob[7]);
            qr[d0] = __builtin_bit_cast(bf16x8, pa_); qr[d0 + 2] = __builtin_bit_cast(bf16x8, pb_); }
    }
    VMWAIT(); __syncthreads();
    DMA_TILE(1, KVBLK);
    qkt(pA0, pA1, K_lds, qr, r32, hi); partialSM(pA0, pA1, m_reg, mnA, alA);
    VMWAIT(); __syncthreads();
    int bj = 1;
    for (int j = 1; j + 1 < NT; j += 2) {
        const int bp = bj == 0 ? 2 : bj - 1, bn = bj == 2 ? 0 : bj + 1, bnn = bn == 2 ? 0 : bn + 1;
        DMA_TILE(bn, (j + 1) * KVBLK);
        SBAR(); qkt(pB0, pB1, K_lds + bj * SHM_K, qr, r32, hi);
        finishSM(pA0, pA1, alA, l_reg, pa0, pa1, pa2, pa3); SBAR();
        pv_d0(o, vb0 + bp * SHM_V, pa0, pa1, pa2, pa3); partialSM(pB0, pB1, m_reg, mnB, alB);
        RESC(alB); VMWAIT(); __syncthreads();
        if (j + 2 < NT) DMA_TILE(bnn, (j + 2) * KVBLK);
        SBAR(); qkt(pA0, pA1, K_lds + bn * SHM_K, qr, r32, hi);
        finishSM(pB0, pB1, alB, l_reg, pa0, pa1, pa2, pa3); SBAR();
        pv_d0(o, vb0 + bj * SHM_V, pa0, pa1, pa2, pa3); partialSM(pA0, pA1, m_reg, mnA, alA);
        RESC(alA); VMWAIT(); __syncthreads();
        bj = bnn;
    }
    {
        const int bp = bj == 0 ? 2 : bj - 1;
        SBAR(); qkt(pB0, pB1, K_lds + bj * SHM_K, qr, r32, hi);
        finishSM(pA0, pA1, alA, l_reg, pa0, pa1, pa2, pa3); SBAR();
        pv_d0(o, vb0 + bp * SHM_V, pa0, pa1, pa2, pa3); partialSM(pB0, pB1, m_reg, mnB, alB);
        RESC(alB);
        finishSM(pB0, pB1, alB, l_reg, pa0, pa1, pa2, pa3); SBAR();
        pv_d0(o, vb0 + bj * SHM_V, pa0, pa1, pa2, pa3);
    }
#undef VMWAIT
    if (hi == 0) li_l[r32] = l_reg; asm volatile("s_waitcnt lgkmcnt(0)" ::: "memory");
    float rli[16];
#pragma unroll
    for (int r = 0; r < 16; ++r) rli[r] = __builtin_amdgcn_rcpf(li_l[crow(r, hi)]);
    bf16* Ow = Ob + (long)(wid * QBLK) * LDO;
#pragma unroll
    for (int r = 0; r < 16; ++r) { const int orow = crow(r, hi);
#pragma unroll
        for (int d0 = 0; d0 < 4; ++d0) Ow[(long)orow * LDO + d0 * 32 + r32] = (bf16)f2bf(o[d0][r] * rli[r]); }
#undef DMA_TILE
#undef RESC
}
}
__device__ __forceinline__ void attn_phase(const int wv_, const bf16* Q, const bf16* K, const bf16* KVRAW, bf16* O, LAS unsigned char* lds, const float* qg, const f32x2* ROPE) {
    const int G = gridDim.x, bx = blockIdx.x; const int vcu = (G % 8 == 0) ? (bx % 8) * (G / 8) + bx / 8 : bx;
    const int units = NBATCH * NH * (SEQ / 256);
    for (int u = vcu; u < units; u += G) {
        const int qb = u % 16, h = (u / 16) % NH, b = u / (16 * NH);
        const size_t row0 = (size_t)b * SEQ;
        attn::unit(wv_, Q + (row0 + qb * 256) * 3072 + h * DQK, K + row0 * 3072 + h * DQK, KVRAW + row0 * 4096 + h * 256 + 128, O + (row0 + qb * 256) * DM + h * DV, SEQ, lds, qg, ROPE, qb * 256);
    }
}

__device__ __forceinline__ void final_phase(const int wv_, float* X, const bf16* ym) {
    const size_t total = (size_t)NTOK * (DM / 4), stride = (size_t)gridDim.x * NTHREADS;
    for (size_t i0 = (size_t)blockIdx.x * NTHREADS + TIDX; i0 < total; i0 += 4 * stride) {
        f32x4 x[4]; u32x2 a[4];
#pragma unroll
        for (int k = 0; k < 4; ++k) { const size_t i = i0 + k * stride; if (i < total) { const size_t row = i / (DM / 4); const int col = (int)(i % (DM / 4)) * 4;
            x[k] = *(const f32x4*)(X + row * DM + col); a[k] = *(const u32x2*)(ym + row * DM + col); } }
#pragma unroll
        for (int k = 0; k < 4; ++k) { const size_t i = i0 + k * stride; if (i < total) { const size_t row = i / (DM / 4); const int col = (int)(i % (DM / 4)) * 4; f32x4 v = x[k];
            v[0] += bflo(a[k].x); v[1] += bfhi(a[k].x); v[2] += bflo(a[k].y); v[3] += bfhi(a[k].y);
            *(f32x4*)(X + row * DM + col) = v; } }
    }
}

struct Args { const float* in[31]; float* out; unsigned char* ws; int ph_lo, ph_hi; };
enum Phase { P_PRO = 0,
    P0_G1, P0_TH, P0_G2, P0_NR, P0_UP, P0_DN,
    P1_G1, P1_T1, P1_LC, P1_T2, P1_G2, P1_NR, P1_UP, P1_DN,
    P2_GD, P2_T1, P2_GU, P2_T2, P2_AT, P2_GO, P2_NR, P2_UP, P2_DN,
    P3_G1, P3_TH, P3_G2, P3_NR, P3_UP, P3_DN,
    N_PHASES };

__device__ __forceinline__ const float* kernarg_ptr(int i) {
    const unsigned long long v = ((volatile const __attribute__((address_space(4))) unsigned long long*)__builtin_amdgcn_kernarg_segment_ptr())[i];
    return (const float*)(const GAS float*)v;
}
#define INP(i) kernarg_ptr(i)
__global__ void __launch_bounds__(NTHREADS, 2) fwd(Args a) {
    extern __shared__ __attribute__((aligned(16))) unsigned char lds_raw[];
    LAS unsigned char* lds = (LAS unsigned char*)lds_raw;
    const int wv_ = __builtin_amdgcn_readfirstlane((int)threadIdx.x >> 6);
    volatile LAS unsigned* MISC = (volatile LAS unsigned*)(lds + MISC_OFF);
    const int tid = TIDX, lane = tid & 63, wid = wv_;
    unsigned char* ws = (unsigned char*)INP(32);
    unsigned* ctl = (unsigned*)(ws + WS_CTL);
    for (int u = tid; u < (LDS_BYTES - SCR_BYTES) / 4; u += NTHREADS) ((LAS unsigned*)(lds + SCR_BYTES))[u] = 0u;
    __syncthreads();
    XcdBarrier bar = xcd_barrier_post(wv_, ctl + CW_BAR, MISC + 8);
    const int lo = a.ph_lo, hi = a.ph_hi;
#ifndef ONLY_PHASE
#define ONLY_PHASE -1
#endif
#define IN(k) ((ONLY_PHASE < 0 || ONLY_PHASE == (k)) && lo <= (k) && (k) < hi)
#define SEAM(k) do { if (IN(k) && IN((k) + 1)) xcd_barrier(wv_, bar); } while (0)
#define x_in INP(0)
#define X ((float*)INP(31))
#define SCIN ((bf16*)(ws + WS_SCIN))
#define SCOUT ((bf16*)(ws + WS_SCOUT))
#define HYIN ((bf16*)(ws + WS_HYIN))
#define HYOUT ((bf16*)(ws + WS_HYOUT))
#define MDOWN ((bf16*)(ws + WS_MDOWN))
#define MUQ ((bf16*)(ws + WS_MUQ))
#define MUKV ((bf16*)(ws + WS_MUKV))
#define MWO ((bf16*)(ws + WS_MWO))
#define MOEUP ((bf16*)(ws + WS_MOEUP))
#define MOEDN ((bf16*)(ws + WS_MOEDN))
#define KERN ((bf16*)(ws + WS_KERN))
#define H ((bf16*)(ws + WS_H))
#define BIG ((bf16*)(ws + WS_BIG))
#define KVRAW ((bf16*)(ws + WS_KVRAW))
#define YB ((bf16*)(ws + WS_YB))
#define X0 ((bf16*)(ws + WS_X0))
#define VT ((bf16*)(ws + WS_VT))
#define YST ((bf16*)(ws + WS_YST))
#define DOWN ((bf16*)(ws + WS_DOWN))
#define CQ ((bf16*)(ws + WS_CQ))
#define CKV ((bf16*)(ws + WS_CKV))
#define QBUF ((bf16*)(ws + WS_Q))
#define KBUF ((bf16*)(ws + WS_K))
#define LIST ((unsigned*)(ws + WS_LIST))
#define GATE ((float*)(ws + WS_GATE))
#define ACT ((bf16*)(ws + WS_ACT))
#define YM ((bf16*)(ws + WS_YM))
#define RSTDB ((float*)(ws + WS_RSTD))
#define WRS ((bf16*)(ws + WS_WRS))
#define ROPEB ((f32x2*)(ws + WS_ROPE))
#define RECB ((u32x4*)(ws + WS_REC))
#define XS H
#define PARTB ((float*)(ws + WS_YM))
#define ACT2 BIG
#define TOKOF ((unsigned*)(ws + WS_ACT))

    if (IN(P_PRO)) {
        LAS float* scr = (LAS float*)(lds + wid * 16384);
        const int gw = blockIdx.x * NWAVES + wid, NGW = gridDim.x * NWAVES;
        cvt_mats<3, true>(INP(3), 2, DM, 3 * DM, 3 * DM, SCIN, scr, gw, NGW, lane, INP(1), 3 * DM);
        cvt_mats<0>(INP(5), 2, DM, DM, DM, SCOUT, scr, gw, NGW, lane);
        cvt_mats<0, true>(INP(6), 1, DM, 3 * DM, 3 * DM, HYIN, scr, gw, NGW, lane, INP(1) + 1 * DM, 0);
        cvt_mats<0>(INP(16), 1, DM, DM, DM, HYOUT, scr, gw, NGW, lane);
        cvt_mats<0, true>(INP(17), 1, DM, NDOWN, NDOWNP, MDOWN, scr, gw, NGW, lane, INP(1) + 2 * DM, 0);
        cvt_mats<0>(INP(20), 1, QRANK, NH * DQK, NH * DQK, MUQ, scr, gw, NGW, lane);
        cvt_mats<0>(INP(21), 1, KVRANK, NH * 256, NH * 256, MUKV, scr, gw, NGW, lane);
        cvt_mats<0>(INP(24), 1, DM, DM, DM, MWO, scr, gw, NGW, lane);
        cvt_mats<2, true>(INP(29), NEXP, DM, 2 * DFF, 2 * DFF, MOEUP, scr, gw, NGW, lane, INP(2), 0);
        cvt_mats<0>(INP(30), NEXP, DFF, DM, DM, MOEDN, scr, gw, NGW, lane);
        for (int i = blockIdx.x * NTHREADS + tid; i < 4 * 48 * DM; i += gridDim.x * NTHREADS) {
            const int d = i % DM, e = (i / DM) % 48, l = i / (DM * 48);
            float w = e < 8 ? INP(25)[((size_t)l * DM + d) * 8 + e] : (e < 40 ? INP(27)[((size_t)l * DM + d) * 32 + (e - 8)] : 0.f);
            w *= INP(2)[l * DM + d];
            const unsigned wh = f2bf(w); const float wr = w - __builtin_bit_cast(float, wh << 16);
            WRS[((size_t)(l * 2 + 0) * 48 + e) * DM + d] = (bf16)wh; WRS[((size_t)(l * 2 + 1) * 48 + e) * DM + d] = (bf16)f2bf(wr);
        }
        for (int i = blockIdx.x * NTHREADS + tid; i < SEQ * 32; i += gridDim.x * NTHREADS) { const int t = i >> 5, ii = i & 31;
            const float inv = exp2f(-(float)(2 * ii) * (13.287712379549449f / 64.0f)); float sn_, cs_; sincosf((float)t * inv, &sn_, &cs_); ROPEB[i] = (f32x2){cs_, sn_}; }
        __syncthreads();
        filter_phase(wv_, INP(9), INP(10), INP(11), INP(12), INP(13), INP(14), KERN, lds);
        __syncthreads();
        x0_phase(wv_, x_in, XS, RSTDB);
    }
    SEAM(P_PRO);

#define MOE_BLOCK(P, L) \
    if (IN(P)) router_phase(wv_, XS, WRS + (size_t)(L) * 2 * 48 * DM, INP(26) + (L) * 8, INP(28) + (L) * 32, ctl + CW_CNT + (L) * 2048, ctl + CW_CNTB + (L) * 4096, LIST, RECB, lds); \
    SEAM(P); \
    if (IN((P) + 1)) moe_up_phase256(wv_, lds, XS, RECB, MOEUP + (size_t)(L) * NEXP * 1024 * DM, ctl + CW_CNT + (L) * 2048, ctl + CW_CNTB + (L) * 4096, LIST, ACT2, TOKOF, \
        (L) < 3 ? INP(29) + (size_t)((L) + 1) * NEXP * DM * 2 * DFF : nullptr, (L) < 3 ? INP(30) + (size_t)((L) + 1) * NEXP * DFF * DM : nullptr, \
        MOEUP + (size_t)((L) + 1) * NEXP * 1024 * DM, MOEDN + (size_t)((L) + 1) * NEXP * DM * DFF, INP(2) + ((L) + 1) * DM); \
    SEAM((P) + 1); \
    if (IN((P) + 2)) moe_down_phase256<((L) < 3)>(wv_, lds, ACT2, MOEDN + (size_t)(L) * NEXP * DM * DFF, ctl + CW_CNT + (L) * 2048, ctl + CW_CNTB + (L) * 4096, TOKOF, XS, X, PARTB); \
    SEAM((P) + 2);

    if (IN(P0_G1)) gemm_dense256<pg8::EpiSC, false>(wv_, lds, XS, SCIN, NTOK, 3 * DM, DM, pg8::EpiSC{BIG, BIG + (size_t)NTOK * DM});
    SEAM(P0_G1);
    if (IN(P0_TH)) sc_thin_phase<true>(wv_, BIG, BIG + (size_t)NTOK * DM, INP(4), YB, RSTDB);
    SEAM(P0_TH);
    if (IN(P0_G2)) gemm_dense256<pg8::EpiRes, false>(wv_, lds, YB, SCOUT, NTOK, DM, DM, pg8::EpiRes{XS, XS});
    SEAM(P0_G2);
    MOE_BLOCK(P0_NR, 0)
    if (IN(P1_G1)) { rstd_prepass(wv_, PARTB, RSTDB); gemm_dense256<pg8::EpiBf16, false>(wv_, lds, XS, HYIN, NTOK, 3 * DM, DM, pg8::EpiBf16{BIG, 3 * DM}); }
    SEAM(P1_G1);
    if (IN(P1_T1)) hy_thin1_phase(wv_, BIG, INP(7), INP(8), X0, VT, lds, RSTDB);
    SEAM(P1_T1);
    if (IN(P1_LC)) longconv_phase(wv_, KERN, VT, INP(15), YST, lds);
    SEAM(P1_LC);
    if (IN(P1_T2)) hy_thin2_phase(wv_, YST, BIG, INP(7), INP(8), RSTDB, YB, lds);
    SEAM(P1_T2);
    if (IN(P1_G2)) gemm_dense256<pg8::EpiRes, false>(wv_, lds, YB, HYOUT, NTOK, DM, DM, pg8::EpiRes{XS, XS});
    SEAM(P1_G2);
    MOE_BLOCK(P1_NR, 1)
    if (IN(P2_GD)) { rstd_prepass(wv_, PARTB, RSTDB); gemm_dense256<pg8::EpiBf16, false>(wv_, lds, XS, MDOWN, NTOK, NDOWNP, DM, pg8::EpiBf16{DOWN, NDOWNP}); }
    SEAM(P2_GD);
    if (IN(P2_T1)) mla_thin1_phase(wv_, DOWN, INP(18), INP(19), CQ, CKV, RSTDB);
    SEAM(P2_T1);
    if (IN(P2_GU)) { gemm_dense256<pg8::EpiBf16, false>(wv_, lds, CQ, MUQ, NTOK, NH * DQK, QRANK, pg8::EpiBf16{BIG, NH * DQK}); gemm_dense256<pg8::EpiBf16, false>(wv_, lds, CKV, MUKV, NTOK, NH * 256, KVRANK, pg8::EpiBf16{KVRAW, NH * 256}); }
    SEAM(P2_GU);
    if (IN(P2_T2)) mla_thin2_phase(wv_, BIG, KVRAW, DOWN, INP(22), INP(23), ROPEB, QBUF, KBUF, RSTDB);
    SEAM(P2_T2);
    if (IN(P2_AT)) attn_phase(wv_, BIG, KBUF, KVRAW, YB, lds, INP(22), ROPEB);
    SEAM(P2_AT);
    if (IN(P2_GO)) gemm_dense256<pg8::EpiRes, false>(wv_, lds, YB, MWO, NTOK, DM, DM, pg8::EpiRes{XS, XS});
    SEAM(P2_GO);
    MOE_BLOCK(P2_NR, 2)
    if (IN(P3_G1)) { rstd_prepass(wv_, PARTB, RSTDB); gemm_dense256<pg8::EpiSC, false>(wv_, lds, XS, SCIN + (size_t)3 * DM * DM, NTOK, 3 * DM, DM, pg8::EpiSC{BIG, BIG + (size_t)NTOK * DM}); }
    SEAM(P3_G1);
    if (IN(P3_TH)) sc_thin_phase<true>(wv_, BIG, BIG + (size_t)NTOK * DM, INP(4) + 3 * DM, YB, RSTDB);
    SEAM(P3_TH);
    if (IN(P3_G2)) gemm_dense256<pg8::EpiRes, false>(wv_, lds, YB, SCOUT + (size_t)DM * DM, NTOK, DM, DM, pg8::EpiRes{XS, XS});
    SEAM(P3_G2);
    MOE_BLOCK(P3_NR, 3)
}

#ifndef N_LAUNCHES
#define N_LAUNCHES 1
#endif
extern "C" void kernel_launch(void* const* d_in, const int* in_sizes, int n_in, void* d_out, int out_size, void* d_ws, size_t ws_size, hipStream_t stream) {
    static int grid = 0;
    if (grid == 0) {
        if (n_in != 31 || out_size != NTOK * DM || ws_size < WS_END) { fprintf(stderr, "kernel_launch: bad shapes n_in %d out %d ws %zu (need %zu)\n", n_in, out_size, ws_size, (size_t)WS_END); grid = -1; return; }
        int dev = 0, cus = 0, per_cu = 0;
        if (hipGetDevice(&dev) != hipSuccess || hipDeviceGetAttribute(&cus, hipDeviceAttributeMultiprocessorCount, dev) != hipSuccess) { grid = -1; return; }
        if (hipFuncSetAttribute((const void*)fwd, hipFuncAttributeMaxDynamicSharedMemorySize, LDS_BYTES) != hipSuccess) { fprintf(stderr, "kernel_launch: hipFuncSetAttribute failed\n"); grid = -1; return; }
        if (hipOccupancyMaxActiveBlocksPerMultiprocessor(&per_cu, (const void*)fwd, NTHREADS, LDS_BYTES) != hipSuccess || per_cu < 1) fprintf(stderr, "kernel_launch: occupancy query says %d\n", per_cu);
        (void)hipGetLastError();
        grid = cus;
    }
    if (grid < 0) return;
    if (hipMemsetAsync((char*)d_ws + WS_CTL, 0, CTL_ZERO_BYTES, stream) != hipSuccess) return;
    Args a{};
    for (int i = 0; i < 31; ++i) a.in[i] = (const float*)d_in[i];
    a.out = (float*)d_out; a.ws = (unsigned char*)d_ws;
#if N_LAUNCHES == 1
    a.ph_lo = 0; a.ph_hi = N_PHASES;
    hipLaunchKernelGGL(fwd, dim3(grid), dim3(NTHREADS), LDS_BYTES, stream, a);
#else
    for (int p = 0; p < N_PHASES; ++p) { a.ph_lo = p; a.ph_hi = p + 1; hipLaunchKernelGGL(fwd, dim3(grid), dim3(NTHREADS), LDS_BYTES, stream, a); }
#endif
#ifdef PROBE_LO
    hipMemsetAsync((char*)d_ws + WS_CTL + CW_BAR * 4, 0, XCD_BAR_WORDS * 4, stream);
    a.ph_lo = PROBE_LO; a.ph_hi = PROBE_HI;
    hipLaunchKernelGGL(fwd, dim3(grid), dim3(NTHREADS), LDS_BYTES, stream, a);
#endif
    const hipError_t le = hipPeekAtLastError();
    if (le != hipSuccess) fprintf(stderr, "kernel_launch: launch failed: %s\n", hipGetErrorName(le));
}
```

```cpp
#include <hip/hip_runtime.h>
#include <cstdio>
#include <cstdint>

#define LAS __attribute__((address_space(3)))
#define GAS __attribute__((address_space(1)))
typedef unsigned short bf16;
typedef short bf16x8 __attribute__((ext_vector_type(8)));
typedef short s16x4 __attribute__((ext_vector_type(4)));
typedef float f32x4 __attribute__((ext_vector_type(4)));
typedef float f32x2 __attribute__((ext_vector_type(2)));
typedef float f32x16 __attribute__((ext_vector_type(16)));
typedef unsigned u32x4 __attribute__((ext_vector_type(4)));
typedef unsigned u32x2 __attribute__((ext_vector_type(2)));

constexpr int NTOK = 32768, DM = 2048, SEQ = 4096, NBATCH = 8;
constexpr int NH = 16, DQK = 192, DNOPE = 128, DROPE = 64, DV = 128, QRANK = 512, KVRANK = 512, NDOWN = 1088, NDOWNP = 1280;
constexpr int NEXP = 32, NGRP = 8, EPG = 4, DFF = 512;
constexpr int NTHREADS = 512, NWAVES = 8;
constexpr float EPS = 1e-6f;

constexpr size_t MiB = 1u << 20;
constexpr size_t WS_CTL = 0, CTL_ZERO_BYTES = 1 * MiB;
constexpr size_t WS_SCIN = 4 * MiB;
constexpr size_t WS_SCOUT = 52 * MiB;
constexpr size_t WS_HYIN = 68 * MiB;
constexpr size_t WS_HYOUT = 92 * MiB;
constexpr size_t WS_MDOWN = 100 * MiB;
constexpr size_t WS_MUQ = 106 * MiB;
constexpr size_t WS_MUKV = 109 * MiB;
constexpr size_t WS_MWO = 113 * MiB;
constexpr size_t WS_MOEUP = 128 * MiB;
constexpr size_t WS_MOEDN = 640 * MiB;
constexpr size_t WS_KERN = 896 * MiB;
constexpr size_t WS_H = 960 * MiB;
constexpr size_t WS_BIG = 1088 * MiB;
constexpr size_t WS_KVRAW = WS_BIG + 192 * MiB;
constexpr size_t WS_YB = 1600 * MiB;
constexpr size_t WS_X0 = 1728 * MiB;
constexpr size_t WS_VT = 1856 * MiB;
constexpr size_t WS_YST = 1984 * MiB;
constexpr size_t WS_DOWN = 2112 * MiB;
constexpr size_t WS_CQ = 2272 * MiB;
constexpr size_t WS_CKV = 2304 * MiB;
constexpr size_t WS_Q = 2336 * MiB;
constexpr size_t WS_K = 2528 * MiB;
constexpr size_t WS_LIST = 2720 * MiB;
constexpr size_t WS_GATE = 3064 * MiB;
constexpr size_t WS_ACT = 2726 * MiB;
constexpr size_t WS_YM = 2800 * MiB;
constexpr size_t WS_RSTD = 3068 * MiB;
constexpr size_t WS_WRS = 3058 * MiB;
constexpr size_t WS_ROPE = 3062 * MiB;
constexpr size_t WS_REC = 3072 * MiB;
constexpr size_t WS_END = 3092 * MiB;
constexpr int CW_CNT = 8192;
constexpr int CW_CNTB = 16384;
constexpr int CW_BAR = 4096;

constexpr int SCR_BYTES = 131072;
constexpr int MISC_OFF = SCR_BYTES + 320;
constexpr int LDS_BYTES = 147456;

__device__ __forceinline__ unsigned f2bf(float f) { unsigned u = __builtin_bit_cast(unsigned, f); return (u + 0x7fffu + ((u >> 16) & 1u)) >> 16; }
__device__ __forceinline__ unsigned pk2(float lo, float hi) { unsigned r; asm("v_cvt_pk_bf16_f32 %0, %1, %2" : "=v"(r) : "v"(lo), "v"(hi)); return r; }
__device__ __forceinline__ float bf2f(unsigned short b) { return __builtin_bit_cast(float, ((unsigned)b) << 16); }
__device__ __forceinline__ float bflo(unsigned w) { return __builtin_bit_cast(float, w << 16); }
__device__ __forceinline__ float bfhi(unsigned w) { return __builtin_bit_cast(float, w & 0xffff0000u); }
__device__ __forceinline__ int opaque_i(int x) { asm volatile("" : "+v"(x)); return x; }
__device__ __forceinline__ int lane_mb() { int l; asm volatile("v_mbcnt_lo_u32_b32 %0, -1, 0\n\tv_mbcnt_hi_u32_b32 %0, -1, %0" : "=v"(l)); return l; }
#define TIDX opaque_i((wv_ << 6) | lane_mb())
__device__ __forceinline__ float wave_sum(float v) {
#pragma unroll
    for (int o = 1; o < 64; o <<= 1) v += __shfl_xor(v, o);
    return v;
}
__device__ __forceinline__ int crow(int r, int hi) { return (r & 3) + 8 * (r >> 2) + 4 * hi; }

#define XB_TMO      128
#define XB_XCNT(j)  (256  + 64 * (j))
#define XB_XSUB(j)  (1280 + 64 * (j))
#define XB_XGEN(j)  (2304 + 64 * (j))
#define XB_TOP      3328
#define XB_TOPGEN   3392
#define XCD_BAR_WORDS 3456
#define XB_SPIN_CAP (1u << 22)
__device__ __forceinline__ unsigned xb_ld(unsigned* p)              { return __hip_atomic_load(p, __ATOMIC_RELAXED, __HIP_MEMORY_SCOPE_AGENT); }
__device__ __forceinline__ unsigned xb_add(unsigned* p, unsigned v) { return __hip_atomic_fetch_add(p, v, __ATOMIC_RELAXED, __HIP_MEMORY_SCOPE_AGENT); }
__device__ __forceinline__ unsigned xb_xcc_id() { return (unsigned)__builtin_amdgcn_s_getreg((3 << 11) | 20) & 0xFu; }
#define XB_SPIN(cond, bar) do { unsigned _sp = 0; while (cond) { __builtin_amdgcn_s_sleep(1); \
    if ((++_sp & 255u) == 0u) { if (xb_ld(&(bar)[XB_TMO])) break; if (_sp > XB_SPIN_CAP) { atomicAdd(&(bar)[XB_TMO], 1u); break; } } } } while (0)
struct XcdBarrier { unsigned* bar; unsigned x; volatile LAS unsigned* st; };
__device__ __forceinline__ XcdBarrier xcd_barrier_post(const int wv_, unsigned* bar, volatile LAS unsigned* st) {
    XcdBarrier b; b.bar = bar; b.x = xb_xcc_id(); b.st = st;
    if (TIDX == 0) (void)xb_add(&bar[XB_XCNT(b.x)], 1u);
    return b;
}
__device__ __forceinline__ void xcd_barrier_complete(unsigned* bar, unsigned x, unsigned& nloc, unsigned& nx) {
    const unsigned G = gridDim.x * gridDim.y * gridDim.z;
    unsigned sum, cnt, mine, sp = 0u;
    for (;;) {
        sum = 0u; cnt = 0u; mine = 0u;
#pragma unroll
        for (unsigned j = 0; j < 16; ++j) { const unsigned c = xb_ld(&bar[XB_XCNT(j)]); sum += c; cnt += (c > 0u) ? 1u : 0u; mine = (j == x) ? c : mine; }
        if (sum == G) break;
        __builtin_amdgcn_s_sleep(1);
        if ((++sp & 255u) == 0u) { if (xb_ld(&bar[XB_TMO])) break; if (sp > XB_SPIN_CAP) { atomicAdd(&bar[XB_TMO], 1u); break; } }
    }
    nloc = mine > 0u ? mine : 1u; nx = cnt > 0u ? cnt : 1u;
}
__device__ __forceinline__ void xcd_barrier(const int wv_, const XcdBarrier& b) {
    asm volatile("s_waitcnt vmcnt(0)" ::: "memory");
    __syncthreads();
    if (TIDX == 0) {
        unsigned* bar = b.bar;
        __builtin_amdgcn_s_waitcnt(0);
        unsigned nloc = b.st[0], nx = b.st[1];
        if (nloc == 0u) { xcd_barrier_complete(bar, b.x, nloc, nx); b.st[0] = nloc; b.st[1] = nx; }
        const unsigned old = xb_add(&bar[XB_XSUB(b.x)], 1u);
        const unsigned gen = old / nloc;
        if (old + 1u == (gen + 1u) * nloc) {
            __builtin_amdgcn_fence(__ATOMIC_RELEASE, "agent");
            asm volatile("s_waitcnt vmcnt(0)" ::: "memory");
            const unsigned og = xb_add(&bar[XB_TOP], 1u);
            const unsigned tg = og / nx;
            if (og + 1u == (tg + 1u) * nx) xb_add(&bar[XB_TOPGEN], 1u);
            else XB_SPIN(xb_ld(&bar[XB_TOPGEN]) == tg, bar);
            __builtin_amdgcn_fence(__ATOMIC_ACQUIRE, "agent");
            xb_add(&bar[XB_XGEN(b.x)], 1u);
            asm volatile("s_waitcnt vmcnt(0)" ::: "memory");
        } else {
            XB_SPIN(xb_ld(&bar[XB_XGEN(b.x)]) == gen, bar);
            __builtin_amdgcn_fence(__ATOMIC_ACQUIRE, "agent");
            asm volatile("s_waitcnt vmcnt(0)" ::: "memory");
        }
    }
    __syncthreads();
}

template <int MODE, bool GAIN = false>
__device__ __forceinline__ void cvt_mats(const float* W, int nmat, int K, int N, int NP, bf16* WT, LAS float* scr, int gw, int NGW, int lane, const float* gain = nullptr, int gms = 0) {
    const int nkb = K / 64, nnb = NP / 32, per = nkb * nnb; const long total = (long)nmat * per;
    f32x4 va[8], vb[8], vc[8]; size_t da = 0, db = 0, dc = 0; float ga[8], gb[8], gc[8];
#define CV_ISSUE(v_, d_, g_, it_) do { const long itx = (it_); if (itx < total) { \
        const int m = (int)(itx / per), r = (int)(itx % per), kb = r / nnb, nb = r % nnb, n0d = nb * 32; int n0s; \
        if (MODE == 2) { const int pn = n0d / 256, bj = (n0d / 128) & 1, i = n0d % 128; n0s = bj * 512 + 128 * pn + i; } \
        else if (MODE == 3) { if (n0d < DM) n0s = n0d; else { const int q = (n0d - DM) / 256, bj = ((n0d - DM) / 128) & 1, i = n0d % 128; n0s = DM + bj * DM + 128 * q + i; } } \
        else n0s = n0d < N ? n0d : -1; \
        d_ = (size_t)m * NP * K + (size_t)n0d * K + kb * 64; \
        if constexpr (GAIN) { _Pragma("unroll") for (int i = 0; i < 8; ++i) g_[i] = gain[m * gms + kb * 64 + (lane >> 3) + 8 * i]; } \
        if (n0s >= 0) { const float* src = W + (size_t)m * K * N + (size_t)(kb * 64 + (lane >> 3)) * N + n0s + (lane & 7) * 4; \
            _Pragma("unroll") for (int i = 0; i < 8; ++i) v_[i] = *(const f32x4*)(src + (size_t)(8 * i) * N); } \
        else { _Pragma("unroll") for (int i = 0; i < 8; ++i) v_[i] = (f32x4){0.f, 0.f, 0.f, 0.f}; } } } while (0)
#define CV_PROC(v_, d_, g_) do { \
        _Pragma("unroll") for (int i = 0; i < 8; ++i) { LAS float* d = scr + ((lane >> 3) + 8 * i) * 33 + (lane & 7) * 4; const f32x4 vv = GAIN ? v_[i] * g_[i] : v_[i]; d[0] = vv[0]; d[1] = vv[1]; d[2] = vv[2]; d[3] = vv[3]; } \
        asm volatile("s_waitcnt lgkmcnt(0)" ::: "memory"); \
        const int c = lane & 7; \
        _Pragma("unroll") for (int j = 0; j < 4; ++j) { const int n = (lane >> 3) + 8 * j; const LAS float* sp = scr + (8 * c) * 33 + n; \
            u32x4 o; o.x = pk2(sp[0 * 33], sp[1 * 33]); o.y = pk2(sp[2 * 33], sp[3 * 33]); o.z = pk2(sp[4 * 33], sp[5 * 33]); o.w = pk2(sp[6 * 33], sp[7 * 33]); \
            *(u32x4*)(WT + (d_) + (size_t)n * K + 8 * c) = o; } \
        asm volatile("s_waitcnt lgkmcnt(0)" ::: "memory"); } while (0)
    long it = gw;
    CV_ISSUE(va, da, ga, it); CV_ISSUE(vb, db, gb, it + NGW); CV_ISSUE(vc, dc, gc, it + 2L * NGW);
    while (it < total) {
        CV_PROC(va, da, ga); CV_ISSUE(va, da, ga, it + 3L * NGW);
        if (it + NGW < total) { CV_PROC(vb, db, gb); CV_ISSUE(vb, db, gb, it + 4L * NGW); }
        if (it + 2L * NGW < total) { CV_PROC(vc, dc, gc); CV_ISSUE(vc, dc, gc, it + 5L * NGW); }
        it += 3L * NGW;
    }
#undef CV_ISSUE
#undef CV_PROC
}

__device__ __forceinline__ void filter_phase(const int wv_, const float* w1, const float* b1, const float* whid, const float* bhid, const float* freq, const float* wout, bf16* KRB, LAS unsigned char* lds) {
    LAS float* z = (LAS float*)lds;
    LAS float* ha = z + 16 * 33;
    LAS float* hb = ha + 16 * 64;
    LAS float* hc = hb + 16 * 64;
    const int tid = TIDX;
    for (int pb = blockIdx.x; pb < SEQ / 16; pb += gridDim.x) {
        const int l0 = pb * 16;
        __syncthreads();
        for (int i = tid; i < 16 * 33; i += NTHREADS) {
            const int p = i / 33, f = i % 33, l = l0 + p; float v;
            if (f == 0) v = (float)l / (float)(SEQ - 1);
            else { const int j = (f - 1) & 15; const float band = 1e-4f + (float)j * ((15.0f - 1e-4f) / 15.0f); const float w = 6.283185307179586f * (float)l / (float)SEQ; const float a = band * w;
                v = (f <= 16) ? cosf(a) : -sinf(a); }
            z[i] = v;
        }
        __syncthreads();
        for (int i = tid; i < 16 * 64; i += NTHREADS) { const int p = i >> 6, j = i & 63; float s = b1[j];
            for (int k = 0; k < 33; ++k) s += z[p * 33 + k] * w1[k * 64 + j];
            ha[i] = sinf(freq[j] * s); }
        __syncthreads();
        for (int i = tid; i < 16 * 64; i += NTHREADS) { const int p = i >> 6, j = i & 63; float s = bhid[j];
            for (int k = 0; k < 64; ++k) s += ha[p * 64 + k] * whid[k * 64 + j];
            hb[i] = sinf(freq[64 + j] * s); }
        __syncthreads();
        for (int i = tid; i < 16 * 64; i += NTHREADS) { const int p = i >> 6, j = i & 63; float s = bhid[64 + j];
            for (int k = 0; k < 64; ++k) s += hb[p * 64 + k] * whid[4096 + k * 64 + j];
            hc[j * 16 + p] = sinf(freq[128 + j] * s); }
        __syncthreads();
#pragma unroll 1
        for (int qh = 0; qh < 2; ++qh) {
        float acc[4][16];
#pragma unroll
        for (int q = 0; q < 4; ++q)
#pragma unroll
            for (int p = 0; p < 16; ++p) acc[q][p] = 0.f;
#pragma unroll 1
        for (int k0 = 0; k0 < 64; k0 += 2) { float w[2][4];
#pragma unroll
            for (int kk = 0; kk < 2; ++kk)
#pragma unroll
                for (int q = 0; q < 4; ++q) w[kk][q] = wout[(size_t)(k0 + kk) * 4096 + tid + NTHREADS * (qh * 4 + q)];
#pragma unroll
            for (int kk = 0; kk < 2; ++kk) { const LAS f32x4* hp = (const LAS f32x4*)(hc + (k0 + kk) * 16); const f32x4 h0 = hp[0], h1 = hp[1], h2 = hp[2], h3 = hp[3];
#pragma unroll
                for (int q = 0; q < 4; ++q) { const float wv = w[kk][q];
#pragma unroll
                    for (int p = 0; p < 4; ++p) { acc[q][p] += h0[p] * wv; acc[q][4 + p] += h1[p] * wv; acc[q][8 + p] += h2[p] * wv; acc[q][12 + p] += h3[p] * wv; } } } }
        LAS bf16* T = (LAS bf16*)(lds + 16384);
        __syncthreads();
#pragma unroll
        for (int q = 0; q < 4; ++q) {
            const int c = tid + NTHREADS * (qh * 4 + q), d = c & (DM - 1);
            const float mind = -3.0701134573253946f, maxd = -15.350567286626973f;
            const float delta = fabsf(mind + (float)d * ((maxd - mind) / (float)(DM - 1)));
            unsigned pk[8];
#pragma unroll
            for (int p = 0; p < 16; p += 2) { const float t0 = (float)(l0 + p) / (float)(SEQ - 1), t1 = (float)(l0 + p + 1) / (float)(SEQ - 1);
                pk[p >> 1] = f2bf(acc[q][p] * expf(-t0 * delta)) | (f2bf(acc[q][p + 1] * expf(-t1 * delta)) << 16); }
            *(LAS u32x4*)(T + (size_t)d * 16) = (u32x4){pk[0], pk[1], pk[2], pk[3]}; *(LAS u32x4*)(T + (size_t)d * 16 + 8) = (u32x4){pk[4], pk[5], pk[6], pk[7]};
        }
        __syncthreads();
        { const bool bwd = qh == 1;
            for (int e = tid; e < DM * 16; e += NTHREADS) { const int d = e >> 4, p = e & 15, l = l0 + p; const bf16 hv = T[e];
                const int m = bwd ? 4095 + l : 4095 - l;
                if (!bwd || l > 0) { KRB[(size_t)d * 8192 + m] = hv; if (m >= 1) KRB[(size_t)DM * 8192 + (size_t)d * 8192 + m - 1] = hv; } } }
        }
    }
}

template <bool COMBINE>
__device__ __forceinline__ void norm_phase(const int wv_, const float* xin, float* xout, const bf16* ym, const float* g, bf16* H) {
    const int tid = TIDX, lane = tid & 63, wid = wv_;
    constexpr int NR = 4;
    for (int rg = blockIdx.x * NWAVES + wid; rg < NTOK / NR; rg += gridDim.x * NWAVES) {
        f32x4 v[NR][8]; float rstd[NR];
#pragma unroll
        for (int r = 0; r < NR; ++r) { const size_t row = (size_t)rg * NR + r; float ss = 0.f;
#pragma unroll
            for (int j = 0; j < 8; ++j) { const int col = j * 256 + lane * 4; f32x4 x = *(const f32x4*)(xin + row * DM + col);
                if (COMBINE) { const u32x2 a = *(const u32x2*)(ym + row * DM + col);
                    x[0] += bflo(a.x); x[1] += bfhi(a.x); x[2] += bflo(a.y); x[3] += bfhi(a.y);
                    *(f32x4*)(xout + row * DM + col) = x; }
                v[r][j] = x; ss += x[0] * x[0] + x[1] * x[1] + x[2] * x[2] + x[3] * x[3]; }
            ss = wave_sum(ss); rstd[r] = 1.0f / sqrtf(ss * (1.0f / DM) + EPS); }
#pragma unroll
        for (int j = 0; j < 8; ++j) { const int col = j * 256 + lane * 4; const f32x4 gv = *(const f32x4*)(g + col);
#pragma unroll
            for (int r = 0; r < NR; ++r) { const size_t row = (size_t)rg * NR + r; const f32x4 x = v[r][j] * rstd[r] * gv;
                u32x2 o; o.x = pk2(x[0], x[1]); o.y = pk2(x[2], x[3]); *(u32x2*)(H + row * DM + col) = o; } }
    }
}

__device__ __forceinline__ void x0_phase(const int wv_, const float* xin, bf16* XBo, float* RSTD) {
    const int tid = TIDX, lane = tid & 63, wid = wv_;
    constexpr int NR = 4;
    for (int rg = blockIdx.x * NWAVES + wid; rg < NTOK / NR; rg += gridDim.x * NWAVES) {
        f32x4 v[NR][8];
#pragma unroll
        for (int r = 0; r < NR; ++r) { const size_t row = (size_t)rg * NR + r;
#pragma unroll
            for (int j = 0; j < 8; ++j) v[r][j] = *(const f32x4*)(xin + row * DM + j * 256 + lane * 4); }
#pragma unroll
        for (int r = 0; r < NR; ++r) { const size_t row = (size_t)rg * NR + r; float ss = 0.f;
#pragma unroll
            for (int j = 0; j < 8; ++j) { const f32x4 x = v[r][j]; ss += x[0] * x[0] + x[1] * x[1] + x[2] * x[2] + x[3] * x[3];
                u32x2 o; o.x = pk2(x[0], x[1]); o.y = pk2(x[2], x[3]); *(u32x2*)(XBo + row * DM + j * 256 + lane * 4) = o; }
            ss = wave_sum(ss); if (lane == 0) RSTD[row] = 1.0f / sqrtf(ss * (1.0f / DM) + EPS); }
    }
}

constexpr int RT_BUF = 96 * 512, RT_LSCR = 2 * RT_BUF;
__device__ __forceinline__ unsigned cvtpk_(float lo, float hi) { unsigned r; asm volatile("v_cvt_pk_bf16_f32 %0, %1, %2" : "=v"(r) : "v"(lo), "v"(hi)); return r; }
__device__ __forceinline__ void router_phase(const int wv_, const bf16* X, const bf16* WTs, const float* bg, const float* be,
                                             unsigned* cnt, unsigned* cntB, unsigned* list, u32x4* rec, LAS unsigned char* lds) {
    const int tid = TIDX, lane = tid & 63, wid = wv_, i16 = lane & 15, kq = lane >> 4;
    LAS float* lscr = (LAS float*)lds + wid * (16 * 48);
    LAS unsigned* lcnt = (LAS unsigned*)(lds + RT_LSCR + 8192); LAS unsigned* lbase = lcnt + 32; LAS unsigned* lcntB = lcnt + 64; LAS unsigned* lbaseB = lcnt + 128;
    if (tid < 32) lcnt[tid] = 0u;
    if (tid < 48) lcntB[tid] = 0u;
    const unsigned voffW = (unsigned)(((2 * wid + (lane >> 5)) * DM + (((lane & 31) ^ ((2 * wid + (lane >> 5)) & 7)) * 8)) * 2);
    const int s7 = i16 & 7, d64 = (s7 & 4) ? 64 : 0, rb0 = i16 * 512 + 16 * (kq ^ (s7 & 3)), rbE = rb0 + d64, rbO = rb0 - d64;
    for (int it = blockIdx.x; it < NTOK / 128; it += gridDim.x) {
        const size_t row = (size_t)it * 128 + wid * 16 + i16;
        const bf16* xp = X + row * DM + 8 * kq;
        f32x4 acc[3]; float ss = 0.f;
#pragma unroll
        for (int n = 0; n < 3; ++n) acc[n] = (f32x4){0.f, 0.f, 0.f, 0.f};
        u32x4 xa[4], xb[4];
#define RT_LOADX(dst, c, h) do { _Pragma("unroll") for (int ks = 0; ks < 4; ++ks) dst[ks] = *(const GAS u32x4*)(xpc + (c) * 256 + ((h) * 4 + ks) * 32); } while (0)
#define RT_DMAW(c, buf) do { _Pragma("unroll") for (int i = 0; i < 6; ++i) \
        __builtin_amdgcn_global_load_lds((const unsigned*)(wpc + (size_t)(c) * 512 + (size_t)i * 16 * DM * 2), (LAS unsigned*)(lds + (buf) * RT_BUF + (i * 8 + wid) * 1024), 16, 0, 0); asm volatile("" ::: "memory"); } while (0)
#define RT_COMPUTE(xr, c, h, buf) do { _Pragma("unroll") for (int ks4 = 0; ks4 < 4; ++ks4) { const int ks = (h) * 4 + ks4; const u32x4 xh = xr[ks4]; \
            { const float q0 = bflo(xh.x), q1 = bfhi(xh.x), q2 = bflo(xh.y), q3 = bfhi(xh.y), q4 = bflo(xh.z), q5 = bfhi(xh.z), q6 = bflo(xh.w), q7 = bfhi(xh.w); \
              ss += q0 * q0 + q1 * q1 + q2 * q2 + q3 * q3 + q4 * q4 + q5 * q5 + q6 * q6 + q7 * q7; } \
            const bf16x8 ah = __builtin_bit_cast(bf16x8, xh); \
            _Pragma("unroll") for (int n = 0; n < 3; ++n) { const LAS unsigned char* wp = lds + (buf) * RT_BUF + n * 16 * 512 + ((ks & 1) ? rbO : rbE) + 64 * ks; \
                const bf16x8 bh = *(const LAS bf16x8*)wp, bl = *(const LAS bf16x8*)(wp + 48 * 512); \
                acc[n] = __builtin_amdgcn_mfma_f32_16x16x32_bf16(bh, ah, acc[n], 0, 0, 0); \
                acc[n] = __builtin_amdgcn_mfma_f32_16x16x32_bf16(bl, ah, acc[n], 0, 0, 0); } __builtin_amdgcn_sched_barrier(0); } } while (0)
        const GAS bf16* xpc = (const GAS bf16*)xp; const char* wpc = (const char*)WTs + voffW;
        __syncthreads();
        RT_DMAW(0, 0); RT_LOADX(xa, 0, 0); RT_LOADX(xb, 0, 1);
        for (int c = 0; c < 8; c += 2) {
            asm volatile("s_waitcnt vmcnt(4)" ::: "memory"); __syncthreads();
            RT_DMAW(1, 1);
            RT_COMPUTE(xa, 0, 0, 0); RT_LOADX(xa, 1, 0);
            RT_COMPUTE(xb, 0, 1, 0); RT_LOADX(xb, 1, 1);
            asm volatile("s_waitcnt vmcnt(4)" ::: "memory"); __syncthreads();
            if (c + 2 < 8) RT_DMAW(2, 0);
            RT_COMPUTE(xa, 1, 0, 1); if (c + 2 < 8) RT_LOADX(xa, 2, 0);
            RT_COMPUTE(xb, 1, 1, 1); if (c + 2 < 8) RT_LOADX(xb, 2, 1);
            xpc += 512; wpc += 1024;
            asm volatile("" : "+v"(xpc));
        }
#undef RT_LOADX
#undef RT_DMAW
#undef RT_COMPUTE
        ss += __shfl_xor(ss, 16); ss += __shfl_xor(ss, 32);
        const float rstd = 1.0f / sqrtf(ss * (1.0f / DM) + EPS);
#pragma unroll
        for (int n = 0; n < 3; ++n)
#pragma unroll
            for (int j = 0; j < 4; ++j) lscr[i16 * 48 + n * 16 + kq * 4 + j] = acc[n][j] * rstd;
        asm volatile("s_waitcnt lgkmcnt(0)" ::: "memory");
        unsigned e1 = 0, e2 = 0, l1 = 0, l2 = 0, bk = 0, lB = 0, h1 = 0; float g1 = 0.f, g2 = 0.f;
        if (lane < 16) { const LAS float* lg = lscr + lane * 48;
            int gs = 0; float gl_[8]; gl_[0] = lg[0] + bg[0]; float gm = gl_[0];
            for (int j = 1; j < 8; ++j) { gl_[j] = lg[j] + bg[j]; if (gl_[j] > gm) { gm = gl_[j]; gs = j; } }
            float den = 0.f; for (int j = 0; j < 8; ++j) den += expf(gl_[j] - gm);
            const float gp = 1.0f / den;
            float el[4]; for (int i = 0; i < 4; ++i) el[i] = lg[8 + gs * 4 + i] + be[gs * 4 + i];
            int i1 = 0; for (int i = 1; i < 4; ++i) if (el[i] > el[i1]) i1 = i;
            int i2 = (i1 == 0) ? 1 : 0; for (int i = 0; i < 4; ++i) if (i != i1 && el[i] > el[i2]) i2 = i;
            const float ex = expf(el[i2] - el[i1]); const float p1 = 1.0f / (1.0f + ex), p2 = ex / (1.0f + ex);
            e1 = gs * 4 + i1; e2 = gs * 4 + i2; g1 = gp * p1; g2 = gp * p2;
            const int lo = i1 < i2 ? i1 : i2, hi = i1 < i2 ? i2 : i1, pidx = lo == 0 ? hi - 1 : (lo == 1 ? hi + 1 : 5);
            bk = gs * 6 + pidx; h1 = (i1 == hi) ? 1u : 0u;
            l1 = __hip_atomic_fetch_add(lcnt + e1, 1u, __ATOMIC_RELAXED, __HIP_MEMORY_SCOPE_WORKGROUP);
            l2 = __hip_atomic_fetch_add(lcnt + e2, 1u, __ATOMIC_RELAXED, __HIP_MEMORY_SCOPE_WORKGROUP);
            lB = __hip_atomic_fetch_add(lcntB + bk, 1u, __ATOMIC_RELAXED, __HIP_MEMORY_SCOPE_WORKGROUP); }
        __syncthreads();
        if (tid < 32) { const unsigned c = lcnt[tid]; lbase[tid] = c ? __hip_atomic_fetch_add(cnt + tid * 64, c, __ATOMIC_RELAXED, __HIP_MEMORY_SCOPE_AGENT) : 0u; }
        else if (tid >= 64 && tid < 112) { const unsigned b = tid - 64, c = lcntB[b]; lbaseB[b] = c ? __hip_atomic_fetch_add(cntB + b * 64, c, __ATOMIC_RELAXED, __HIP_MEMORY_SCOPE_AGENT) : 0u; }
        __syncthreads();
        if (lane < 16) { const unsigned r = (unsigned)row; const size_t o1 = (size_t)e1 * NTOK + lbase[e1] + l1, o2 = (size_t)e2 * NTOK + lbase[e2] + l2;
            const unsigned slot = lbaseB[bk] + lB, c1 = (bk << 20) | (h1 << 19) | slot, c2 = (bk << 20) | ((1u - h1) << 19) | slot;
            list[o1] = r; list[o2] = r; const unsigned rb = __float_as_uint(rstd);
            rec[o1] = (u32x4){rb, __float_as_uint(g1), c1, r}; rec[o2] = (u32x4){rb, __float_as_uint(g2), c2, r}; }
        __syncthreads();
        if (tid < 32) lcnt[tid] = 0u;
        if (tid < 48) lcntB[tid] = 0u;
        asm volatile("s_waitcnt vmcnt(0) lgkmcnt(0)" ::: "memory");
    }
}


namespace pg8 {
constexpr int BM = 256, BK = 64, HALF = 128, HTB = HALF * BK * 2, STAGE_BYTES = 8 * HTB, NXCD = 8, WGM = 8;
__host__ __device__ __forceinline__ int lds_byte(int r, int c) { const int st = (r >> 4) * 2 + (c >> 5), rr = r & 15, cc = c & 31, ob = rr * 64 + cc * 2; return st * 1024 + (ob ^ (((ob >> 9) & 1) << 5)); }
__host__ __device__ __forceinline__ void stage_rc(int b, int& R, int& C) { const int st = b / 1024, sb = b % 1024, swz = sb ^ (((sb >> 9) & 1) << 5); R = (st >> 1) * 16 + swz / 64; C = (st & 1) * 32 + (swz % 64) / 2; }
__host__ __device__ __forceinline__ int perm32(int rho) { const int n = rho >> 4, i = rho & 15; return 8 * (i >> 2) + 4 * n + (i & 3); }
struct Unit { int pm, pn, e, r0, rows; };
__device__ __forceinline__ unsigned cvt_pk_bf16(float lo, float hi) { unsigned r; asm volatile("v_cvt_pk_bf16_f32 %0, %1, %2" : "=v"(r) : "v"(lo), "v"(hi)); return r; }

__device__ __forceinline__ void tile_of(int wgid, int nM, int nN, int& pm, int& pn) {
    const int nwg = nM * nN; { const int q = nwg / NXCD, r = nwg % NXCD, xcd = wgid % NXCD, off = wgid / NXCD; wgid = (xcd < r ? xcd * (q + 1) : r * (q + 1) + (xcd - r) * q) + off; }
    const int nig = WGM * nN, gid = wgid / nig, fm = gid * WGM, gsz = (nM - fm) < WGM ? (nM - fm) : WGM;
    pm = fm + ((wgid % nig) % gsz); pn = (wgid % nig) / gsz;
}
struct DenseOrder { static constexpr bool GATHER = false, SPLITB = false;
    const bf16* A; const bf16* Bt; int K, nM, nN, G, c;
    __device__ __forceinline__ void init(const bf16* A_, const bf16* Bt_, int M, int N, int K_) { A = A_; Bt = Bt_; K = K_; nM = M / BM; nN = N / BM; G = gridDim.x; c = blockIdx.x; }
    __device__ __forceinline__ bool next(int i, Unit& u) const { const long L = (long)i * G + c; if (L >= (long)nM * nN) return false; tile_of((int)L, nM, nN, u.pm, u.pn); u.e = 0; u.r0 = 0; u.rows = BM; return true; }
    __device__ __forceinline__ const char* abase(const Unit& u) const { return (const char*)A + (size_t)u.pm * BM * K * 2; }
    __device__ __forceinline__ const char* bbase(const Unit& u) const { return (const char*)Bt + (size_t)u.pn * BM * K * 2; }
    __device__ __forceinline__ int kb() const { return K; }
    __device__ __forceinline__ const char* bbase2(const Unit& u) const { return bbase(u) + K; }
    __device__ __forceinline__ void a_offs(const Unit&, unsigned (&vo)[2][2], const int (&R)[2], const int (&C)[2]) const {
#pragma unroll
        for (int h = 0; h < 2; ++h)
#pragma unroll
            for (int i = 0; i < 2; ++i) vo[h][i] = (unsigned)((R[i] + HALF * h) * K + C[i]) * 2u; }
};
struct MoeOrder { static constexpr bool GATHER = false, SPLITB = false;
    const bf16* A; const bf16* Bt; int K, N, nN, G, c; const LAS int* tstart; const LAS int* cnts;
    __device__ __forceinline__ void init(const bf16* A_, const bf16* Bt_, int N_, int K_, const LAS int* ts, const LAS int* cn) { A = A_; Bt = Bt_; K = K_; N = N_; nN = N_ / BM; G = gridDim.x; c = blockIdx.x; tstart = ts; cnts = cn; }
    __device__ __forceinline__ bool next(int i, Unit& u) const { const int nM = tstart[32]; const long L = (long)i * G + c; if (L >= (long)nM * nN) return false; tile_of((int)L, nM, nN, u.pm, u.pn);
        const int e = tstart[128 + u.pm]; u.e = e; u.r0 = (u.pm - tstart[e]) * BM; const int left = cnts[e] - u.r0; u.rows = left < BM ? left : BM; return true; }
    __device__ __forceinline__ const char* abase(const Unit& u) const { return (const char*)A + (size_t)u.pm * BM * K * 2; }
    __device__ __forceinline__ const char* bbase(const Unit& u) const { return (const char*)Bt + ((size_t)u.e * N + (size_t)u.pn * BM) * K * 2; }
    __device__ __forceinline__ int kb() const { return K; }
    __device__ __forceinline__ const char* bbase2(const Unit& u) const { return bbase(u) + K; }
    __device__ __forceinline__ void a_offs(const Unit&, unsigned (&vo)[2][2], const int (&R)[2], const int (&C)[2]) const {
#pragma unroll
        for (int h = 0; h < 2; ++h)
#pragma unroll
            for (int i = 0; i < 2; ++i) vo[h][i] = (unsigned)((R[i] + HALF * h) * K + C[i]) * 2u; }
};
struct MoeGatherOrder : MoeOrder { static constexpr bool GATHER = true;
    const unsigned* list;
    __device__ __forceinline__ const char* abase(const Unit&) const { return (const char*)A; }
    __device__ __forceinline__ void a_offs(const Unit& u, unsigned (&vo)[2][2], const int (&R)[2], const int (&C)[2]) const {
#pragma unroll
        for (int h = 0; h < 2; ++h)
#pragma unroll
            for (int i = 0; i < 2; ++i) { const int rl = R[i] + HALF * h, rc = rl < u.rows ? rl : u.rows - 1; const unsigned tok = list[(size_t)u.e * NTOK + u.r0 + rc]; vo[h][i] = (tok * (unsigned)K + (unsigned)C[i]) * 2u; } }
};
struct MoeBucketOrder { static constexpr bool GATHER = false, SPLITB = true;
    const bf16* A; const bf16* Bt; int nN, G, c; const LAS int* tab;
    __device__ __forceinline__ void init(const bf16* A_, const bf16* Bt_, const LAS int* t) { A = A_; Bt = Bt_; nN = DM / BM; G = gridDim.x; c = blockIdx.x; tab = t; }
    __device__ __forceinline__ bool next(int i, Unit& u) const { const int nM = tab[448 + 48]; const long L = (long)i * G + c; if (L >= (long)nM * nN) return false; tile_of((int)L, nM, nN, u.pm, u.pn);
        const int bk = tab[576 + u.pm], g = bk / 6, px = bk % 6, lo = px < 3 ? 0 : (px < 5 ? 1 : 2), hi = px < 3 ? px + 1 : (px < 5 ? px - 1 : 3);
        u.e = (g * 4 + lo) | ((g * 4 + hi) << 8); u.r0 = (u.pm - tab[448 + bk]) * BM; const int left = tab[512 + bk] - u.r0; u.rows = left < BM ? left : BM; return true; }
    __device__ __forceinline__ const char* abase(const Unit& u) const { return (const char*)A + (size_t)u.pm * BM * (2 * DFF) * 2; }
    __device__ __forceinline__ const char* bbase(const Unit& u) const { return (const char*)Bt + ((size_t)(u.e & 255) * DM + (size_t)u.pn * BM) * DFF * 2; }
    __device__ __forceinline__ const char* bbase2(const Unit& u) const { return (const char*)Bt + ((size_t)(u.e >> 8) * DM + (size_t)u.pn * BM) * DFF * 2; }
    __device__ __forceinline__ int kb() const { return DFF; }
    __device__ __forceinline__ void a_offs(const Unit&, unsigned (&vo)[2][2], const int (&R)[2], const int (&C)[2]) const {
#pragma unroll
        for (int h = 0; h < 2; ++h)
#pragma unroll
            for (int i = 0; i < 2; ++i) vo[h][i] = (unsigned)((R[i] + HALF * h) * (2 * DFF) + C[i]) * 2u; }
};
struct EpiBf16 { static constexpr bool PERM = true; bf16* O; int ldc;
    __device__ __forceinline__ void operator()(const f32x4 (&acc)[2][2][4][2], const Unit& u, int wr, int wc, int fr, int fq) const {
        const int row0 = u.pm * BM + wr * 64 + fr, col0 = u.pn * BM + wc * 32 + 8 * fq;
#pragma unroll
        for (int ai = 0; ai < 2; ++ai)
#pragma unroll
            for (int m = 0; m < 4; ++m) { bf16* rowp = O + (size_t)(row0 + ai * HALF + m * 16) * ldc + col0;
#pragma unroll
                for (int bj = 0; bj < 2; ++bj) { const f32x4 v0 = acc[ai][bj][m][0], v1 = acc[ai][bj][m][1];
                    u32x4 w; w.x = cvt_pk_bf16(v0[0], v0[1]); w.y = cvt_pk_bf16(v0[2], v0[3]); w.z = cvt_pk_bf16(v1[0], v1[1]); w.w = cvt_pk_bf16(v1[2], v1[3]);
                    *(u32x4*)(rowp + bj * HALF) = w; } }
    } };
struct EpiF32 { static constexpr bool PERM = false; float* C; int ldc;
    __device__ __forceinline__ void operator()(const f32x4 (&acc)[2][2][4][2], const Unit& u, int wr, int wc, int fr, int fq) const {
        const int row0 = u.pm * BM + wr * 64 + fr, col0 = u.pn * BM + wc * 32 + 4 * fq;
#pragma unroll
        for (int ai = 0; ai < 2; ++ai)
#pragma unroll
            for (int m = 0; m < 4; ++m) { float* rowp = C + (size_t)(row0 + ai * HALF + m * 16) * ldc + col0;
#pragma unroll
                for (int bj = 0; bj < 2; ++bj)
#pragma unroll
                    for (int n = 0; n < 2; ++n) *(f32x4*)(rowp + bj * HALF + n * 16) = acc[ai][bj][m][n]; }
    } };
struct EpiRes { static constexpr bool PERM = true; const bf16* res; bf16* out;
    __device__ __forceinline__ void operator()(const f32x4 (&acc)[2][2][4][2], const Unit& u, int wr, int wc, int fr, int fq) const {
        const int row0 = u.pm * BM + wr * 64 + fr, col0 = u.pn * BM + wc * 32 + 8 * fq;
#pragma unroll
        for (int ai = 0; ai < 2; ++ai) { u32x4 b[4][2];
#pragma unroll
            for (int m = 0; m < 4; ++m) { const size_t off = (size_t)(row0 + ai * HALF + m * 16) * DM + col0;
#pragma unroll
                for (int bj = 0; bj < 2; ++bj) b[m][bj] = *(const u32x4*)(res + off + bj * HALF); }
            asm volatile("" ::: "memory");
#pragma unroll
            for (int m = 0; m < 4; ++m) { const size_t off = (size_t)(row0 + ai * HALF + m * 16) * DM + col0;
#pragma unroll
                for (int bj = 0; bj < 2; ++bj) { const u32x4 r = b[m][bj]; const f32x4 a0 = acc[ai][bj][m][0], a1 = acc[ai][bj][m][1];
                    u32x4 w; w.x = cvt_pk_bf16(bflo(r.x) + a0[0], bfhi(r.x) + a0[1]); w.y = cvt_pk_bf16(bflo(r.y) + a0[2], bfhi(r.y) + a0[3]);
                    w.z = cvt_pk_bf16(bflo(r.z) + a1[0], bfhi(r.z) + a1[1]); w.w = cvt_pk_bf16(bflo(r.w) + a1[2], bfhi(r.w) + a1[3]);
                    *(u32x4*)(out + off + bj * HALF) = w; } }
            asm volatile("" ::: "memory"); }
    } };
struct EpiSC { static constexpr bool PERM = true; bf16* Bg; bf16* P;
    __device__ __forceinline__ void operator()(const f32x4 (&acc)[2][2][4][2], const Unit& u, int wr, int wc, int fr, int fq) const {
        const int row0 = u.pm * BM + wr * 64 + fr;
        if (u.pn < 8) { const int col0 = u.pn * BM + wc * 32 + 8 * fq;
#pragma unroll
            for (int ai = 0; ai < 2; ++ai)
#pragma unroll
                for (int m = 0; m < 4; ++m) { bf16* rowp = Bg + (size_t)(row0 + ai * HALF + m * 16) * DM + col0;
#pragma unroll
                    for (int bj = 0; bj < 2; ++bj) { const f32x4 v0 = acc[ai][bj][m][0], v1 = acc[ai][bj][m][1];
                        u32x4 w; w.x = cvt_pk_bf16(v0[0], v0[1]); w.y = cvt_pk_bf16(v0[2], v0[3]); w.z = cvt_pk_bf16(v1[0], v1[1]); w.w = cvt_pk_bf16(v1[2], v1[3]);
                        *(u32x4*)(rowp + bj * HALF) = w; } }
        } else { const int col0 = (u.pn - 8) * HALF + wc * 32 + 8 * fq;
#pragma unroll
            for (int ai = 0; ai < 2; ++ai)
#pragma unroll
                for (int m = 0; m < 4; ++m) { const f32x4 v0 = acc[ai][0][m][0] * acc[ai][1][m][0], v1 = acc[ai][0][m][1] * acc[ai][1][m][1];
                    u32x4 w; w.x = cvt_pk_bf16(v0[0], v0[1]); w.y = cvt_pk_bf16(v0[2], v0[3]); w.z = cvt_pk_bf16(v1[0], v1[1]); w.w = cvt_pk_bf16(v1[2], v1[3]);
                    *(u32x4*)(P + (size_t)(row0 + ai * HALF + m * 16) * DM + col0) = w; }
        }
    } };
struct EpiSwiglu { static constexpr bool PERM = true; bf16* ACT2; const u32x4* REC; const LAS int* tab;
    __device__ __forceinline__ void operator()(const f32x4 (&acc)[2][2][4][2], const Unit& u, int wr, int wc, int fr, int fq) const {
        const int col0 = u.pn * HALF + wc * 32 + 8 * fq; const u32x4* rp = REC + (size_t)u.e * NTOK + u.r0 + wr * 64 + fr;
#pragma unroll
        for (int ai = 0; ai < 2; ++ai) {
            u32x4 rc[4];
#pragma unroll
            for (int m = 0; m < 4; ++m) rc[m] = rp[ai * HALF + m * 16];
#pragma unroll
            for (int m = 0; m < 4; ++m) { const int rl = ai * HALF + wr * 64 + m * 16 + fr;
                if (rl < u.rows) { float o[8]; const float rs = __uint_as_float(rc[m].x), gt = __uint_as_float(rc[m].y); const unsigned cd = rc[m].z;
                    const unsigned doff = (((unsigned)tab[448 + (cd >> 20)] * (unsigned)BM + (cd & 0x7FFFFu)) * (unsigned)(2 * DFF) + ((cd >> 19) & 1u) * (unsigned)DFF + (unsigned)col0) * 2u;
#pragma unroll
                    for (int n = 0; n < 2; ++n)
#pragma unroll
                        for (int j = 0; j < 4; ++j) { const float g = acc[ai][0][m][n][j] * rs, up = acc[ai][1][m][n][j] * rs;
                            o[n * 4 + j] = g * __builtin_amdgcn_rcpf(1.0f + __builtin_amdgcn_exp2f(-1.4426950408889634f * g)) * up * gt; }
                    u32x4 w; w.x = cvt_pk_bf16(o[0], o[1]); w.y = cvt_pk_bf16(o[2], o[3]); w.z = cvt_pk_bf16(o[4], o[5]); w.w = cvt_pk_bf16(o[6], o[7]);
                    *(u32x4*)((char*)ACT2 + doff) = w;
                } }
            asm volatile("" ::: "memory"); }
    } };
template <bool NEXT>
struct EpiDown { static constexpr bool PERM = true; const unsigned* TOKOF; bf16* XS; float* OUT; float* PART;
    __device__ __forceinline__ void operator()(const f32x4 (&acc)[2][2][4][2], const Unit& u, int wr, int wc, int fr, int fq) const {
        const int col0 = u.pn * BM + wc * 32 + 8 * fq;
        unsigned tk[2][4];
#pragma unroll
        for (int ai = 0; ai < 2; ++ai)
#pragma unroll
            for (int m = 0; m < 4; ++m) { const int rl = ai * HALF + wr * 64 + m * 16 + fr; tk[ai][m] = TOKOF[(size_t)u.pm * BM + rl]; }
#pragma unroll
        for (int ai = 0; ai < 2; ++ai) { u32x4 b[4][2];
#pragma unroll
            for (int m = 0; m < 4; ++m) { const int rl = ai * HALF + wr * 64 + m * 16 + fr; const unsigned t = rl < u.rows ? tk[ai][m] : 0u;
                const bf16* rowp = XS + (size_t)t * DM + col0;
#pragma unroll
                for (int bj = 0; bj < 2; ++bj) b[m][bj] = *(const u32x4*)(rowp + bj * HALF); }
            asm volatile("" ::: "memory");
#pragma unroll
            for (int m = 0; m < 4; ++m) { const int rl = ai * HALF + wr * 64 + m * 16 + fr; const bool ok = rl < u.rows; const size_t ro = (size_t)tk[ai][m] * DM + col0;
                float ss = 0.f;
#pragma unroll
                for (int bj = 0; bj < 2; ++bj) { const u32x4 r = b[m][bj];
                    const f32x4 x0 = (f32x4){bflo(r.x), bfhi(r.x), bflo(r.y), bfhi(r.y)} + acc[ai][bj][m][0], x1 = (f32x4){bflo(r.z), bfhi(r.z), bflo(r.w), bfhi(r.w)} + acc[ai][bj][m][1];
                    if constexpr (NEXT) {
                        ss += x0[0] * x0[0] + x0[1] * x0[1] + x0[2] * x0[2] + x0[3] * x0[3] + x1[0] * x1[0] + x1[1] * x1[1] + x1[2] * x1[2] + x1[3] * x1[3];
                        u32x4 w; w.x = cvt_pk_bf16(x0[0], x0[1]); w.y = cvt_pk_bf16(x0[2], x0[3]); w.z = cvt_pk_bf16(x1[0], x1[1]); w.w = cvt_pk_bf16(x1[2], x1[3]);
                        if (ok) *(u32x4*)(XS + ro + bj * HALF) = w;
                    } else { if (ok) { *(f32x4*)(OUT + ro + bj * HALF) = x0; *(f32x4*)(OUT + ro + bj * HALF + 4) = x1; } } }
                if constexpr (NEXT) { ss += __shfl_xor(ss, 16); ss += __shfl_xor(ss, 32);
                    if (ok && fq == 0) PART[(size_t)tk[ai][m] * 32 + u.pn * 4 + wc] = ss; } }
            asm volatile("" ::: "memory"); }
    } };

template <class Epi, class Sched, bool ALIGN_EPI = true>
__device__ __forceinline__ void gemm_phase(const int wv_, LAS unsigned char* lds, const int K, const Sched& S, const Epi& E) {
    const int tid = TIDX, wid = wv_, lane = tid & 63, wr = wid >> 2, wc = wid & 3, fr = lane & 15, fq = lane >> 4;
    const int nt = K / BK;
    unsigned voffB[2]; int Ra[2], Ca[2];
#pragma unroll
    for (int i = 0; i < 2; ++i) { int R, C; stage_rc(tid * 16 + i * 8192, R, C); const int Rb = Epi::PERM ? ((R & ~31) + perm32(R & 31)) : R;
        Ra[i] = R; Ca[i] = C; voffB[i] = (unsigned)(Rb * S.kb() + C) * 2u; }
    unsigned vAc[2][2], vAn[2][2];
    const size_t kstep = (size_t)(BK * 2);
    const size_t hstep = (size_t)HALF * S.kb() * 2;
    const int nth = nt / 2;
    const unsigned ldsw = (unsigned)wid * 1024u;
    const int aoff = lds_byte(wr * 64 + fr, fq * 8), boff = lds_byte(wc * 32 + fr, fq * 8);
#define PG8_SA(b, h) (((b) * 2 + (h)) * HTB)
#define PG8_SB(b, h) ((4 + (b) * 2 + (h)) * HTB)
#define PG8_STAGE(bufoff, gbase, voff) do { _Pragma("unroll") for (int _i = 0; _i < 2; ++_i) \
        __builtin_amdgcn_global_load_lds((const unsigned*)((const char*)(gbase) + (voff)[_i]), (LAS unsigned*)(lds + (bufoff) + ldsw + _i * 8192), 16, 0, 0); } while (0)
#define PG8_LDA(dst, b, h) do { _Pragma("unroll") for (int m = 0; m < 4; ++m) _Pragma("unroll") for (int k = 0; k < 2; ++k) dst[m][k] = *(const LAS bf16x8*)(lds + PG8_SA(b, h) + aoff + m * 2048 + k * 1024); } while (0)
#define PG8_LDB(dst, b, h) do { _Pragma("unroll") for (int n = 0; n < 2; ++n) _Pragma("unroll") for (int k = 0; k < 2; ++k) dst[n][k] = *(const LAS bf16x8*)(lds + PG8_SB(b, h) + boff + n * 2048 + k * 1024); } while (0)
#define PG8_MMA(ai, bj, At, Bt) do { __builtin_amdgcn_s_setprio(1); _Pragma("unroll") for (int m = 0; m < 4; ++m) _Pragma("unroll") for (int n = 0; n < 2; ++n) _Pragma("unroll") for (int k = 0; k < 2; ++k) \
        acc[ai][bj][m][n] = __builtin_amdgcn_mfma_f32_16x16x32_bf16(Bt[n][k], At[m][k], acc[ai][bj][m][n], 0, 0, 0); __builtin_amdgcn_s_setprio(0); } while (0)
#define PG8_WAIT_V(n) asm volatile("s_waitcnt vmcnt(" #n ")" ::: "memory")
#define PG8_WAIT_L(n) asm volatile("s_waitcnt lgkmcnt(" #n ")" ::: "memory")
#define PG8_BAR __builtin_amdgcn_s_barrier()
#define PG8_SCHED __builtin_amdgcn_sched_barrier(0)
    Unit cur, nxt; int ui = 0;
    if (!S.next(0, cur)) return;
    f32x4 acc[2][2][4][2];
#pragma unroll
    for (int a = 0; a < 2; ++a)
#pragma unroll
        for (int b = 0; b < 2; ++b)
#pragma unroll
            for (int m = 0; m < 4; ++m)
#pragma unroll
                for (int n = 0; n < 2; ++n) acc[a][b][m][n] = (f32x4){0.f, 0.f, 0.f, 0.f};
    bf16x8 At[4][2], B0[2][2], B1[2][2];
    const char* cA = S.abase(cur); const char* cB = S.bbase(cur); long dB2 = 0;
    if constexpr (Sched::SPLITB) dB2 = (S.bbase2(cur) - cB) - (long)nth * (long)kstep;
    S.a_offs(cur, vAc, Ra, Ca);
    PG8_STAGE(PG8_SB(0, 0), cB, voffB); PG8_STAGE(PG8_SB(0, 1), cB + hstep, voffB); PG8_STAGE(PG8_SA(0, 0), cA, vAc[0]); PG8_STAGE(PG8_SA(0, 1), cA, vAc[1]);
    if (wr == 1) PG8_BAR;
    PG8_WAIT_V(2); PG8_BAR;
    PG8_STAGE(PG8_SB(1, 0), cB + kstep, voffB); PG8_STAGE(PG8_SA(1, 0), cA + kstep, vAc[0]); PG8_STAGE(PG8_SB(1, 1), cB + hstep + kstep, voffB);
    PG8_WAIT_V(6); PG8_BAR;
    for (;;) {
        const bool has_next = S.next(ui + 1, nxt);
        const char* nA = has_next ? S.abase(nxt) : cA; const char* nB = has_next ? S.bbase(nxt) : cB;
        if constexpr (Sched::GATHER) {
            if (has_next) S.a_offs(nxt, vAn, Ra, Ca);
            else {
#pragma unroll
                for (int h = 0; h < 2; ++h)
#pragma unroll
                    for (int i = 0; i < 2; ++i) vAn[h][i] = vAc[h][i]; } }
        for (int t = 0; t < nt; t += 2) {
            const bool last = (t == nt - 2);
            const char* a1 = cA + (size_t)(t + 1) * kstep;
            const char* a2 = last ? nA : cA + (size_t)(t + 2) * kstep; const char* b2 = last ? nB : cB + (size_t)(t + 2) * kstep;
            if constexpr (Sched::SPLITB) { if (!last && t + 2 >= nth) b2 += dB2; }
            const char* a3 = a2 + kstep; const char* b3 = b2 + kstep;
            unsigned v0[2], v1[2];
#pragma unroll
            for (int i = 0; i < 2; ++i) { v0[i] = (Sched::GATHER && last) ? vAn[0][i] : vAc[0][i]; v1[i] = (Sched::GATHER && last) ? vAn[1][i] : vAc[1][i]; }
            PG8_LDB(B0, 0, 0); PG8_LDB(B1, 0, 1); PG8_SCHED; PG8_LDA(At, 0, 0); PG8_STAGE(PG8_SA(1, 1), a1, vAc[1]);
            PG8_WAIT_V(8); PG8_WAIT_L(0); PG8_BAR; PG8_MMA(0, 0, At, B0); PG8_MMA(0, 1, At, B1); PG8_BAR; PG8_SCHED;
            PG8_LDA(At, 0, 1); PG8_STAGE(PG8_SB(0, 0), b2, voffB); PG8_STAGE(PG8_SB(0, 1), b2 + hstep, voffB); PG8_STAGE(PG8_SA(0, 0), a2, v0);
            PG8_WAIT_V(8); PG8_WAIT_L(0); PG8_BAR; PG8_MMA(1, 0, At, B0); PG8_MMA(1, 1, At, B1); PG8_BAR; PG8_SCHED;
            PG8_LDB(B0, 1, 0); PG8_LDB(B1, 1, 1); PG8_SCHED; PG8_LDA(At, 1, 0); PG8_STAGE(PG8_SA(0, 1), a2, v1);
            PG8_WAIT_V(8); PG8_WAIT_L(0); PG8_BAR; PG8_MMA(0, 0, At, B0); PG8_MMA(0, 1, At, B1); PG8_BAR; PG8_SCHED;
            PG8_LDA(At, 1, 1); PG8_STAGE(PG8_SB(1, 0), b3, voffB); PG8_STAGE(PG8_SB(1, 1), b3 + hstep, voffB); PG8_STAGE(PG8_SA(1, 0), a3, v0);
            PG8_WAIT_V(8); PG8_WAIT_L(0); PG8_BAR; PG8_MMA(1, 0, At, B0); PG8_MMA(1, 1, At, B1); PG8_BAR; PG8_SCHED;
        }
        if constexpr (ALIGN_EPI) { if (wr == 0) PG8_BAR; }
        E(acc, cur, wr, wc, fr, fq);
        if (!has_next) break;
#pragma unroll
        for (int a = 0; a < 2; ++a)
#pragma unroll
            for (int b = 0; b < 2; ++b)
#pragma unroll
                for (int m = 0; m < 4; ++m)
#pragma unroll
                    for (int n = 0; n < 2; ++n) acc[a][b][m][n] = (f32x4){0.f, 0.f, 0.f, 0.f};
        cur = nxt; cA = nA; cB = nB; ++ui;
        if constexpr (Sched::SPLITB) dB2 = (S.bbase2(cur) - cB) - (long)nth * (long)kstep;
        if constexpr (Sched::GATHER) {
#pragma unroll
            for (int h = 0; h < 2; ++h)
#pragma unroll
                for (int i = 0; i < 2; ++i) vAc[h][i] = vAn[h][i]; }
        if constexpr (ALIGN_EPI) { if (wr == 1) PG8_BAR; }
    }
    PG8_WAIT_V(0);
    if constexpr (!ALIGN_EPI) { if (wr == 0) PG8_BAR; }
    PG8_BAR;
#undef PG8_SA
#undef PG8_SB
#undef PG8_STAGE
#undef PG8_LDA
#undef PG8_LDB
#undef PG8_MMA
#undef PG8_WAIT_V
#undef PG8_WAIT_L
#undef PG8_BAR
#undef PG8_SCHED
}
}


constexpr int MOE_TAB_OFF = SCR_BYTES + 1024;
__device__ __forceinline__ void moe_tables256(const int wv_, LAS unsigned char* lds, unsigned* cnt, unsigned* cntB) {
    LAS int* tstart = (LAS int*)(lds + MOE_TAB_OFF); LAS int* cnts = tstart + 64;
    __syncthreads();
    if (TIDX < 32) cnts[TIDX] = (int)__hip_atomic_load(cnt + TIDX * 64, __ATOMIC_RELAXED, __HIP_MEMORY_SCOPE_AGENT);
    else if (TIDX >= 64 && TIDX < 112) tstart[512 + TIDX - 64] = (int)__hip_atomic_load(cntB + (TIDX - 64) * 64, __ATOMIC_RELAXED, __HIP_MEMORY_SCOPE_AGENT);
    __syncthreads();
    if (TIDX == 0) { int t = 0; for (int e = 0; e < 32; ++e) { tstart[e] = t; t += (cnts[e] + 255) / 256; } tstart[32] = t; }
    else if (TIDX == 64) { int t = 0; for (int b = 0; b < 48; ++b) { tstart[448 + b] = t; t += (tstart[512 + b] + 255) / 256; } tstart[448 + 48] = t; }
    __syncthreads();
    for (int t = TIDX; t < tstart[32]; t += NTHREADS) { int e = 0; for (int k = 1; k < 32; ++k) e += (tstart[k] <= t) ? 1 : 0; tstart[128 + t] = e; }
    for (int t = TIDX; t < tstart[448 + 48]; t += NTHREADS) { int b = 0; for (int k = 1; k < 48; ++k) b += (tstart[448 + k] <= t) ? 1 : 0; tstart[576 + t] = b; }
    __syncthreads();
}
__device__ __forceinline__ void moe_up_phase256(const int wv_, LAS unsigned char* lds, const bf16* Hu, const u32x4* REC, const bf16* WupT, unsigned* cnt, unsigned* cntB, const unsigned* list, bf16* ACT2, unsigned* TOKOF,
                                                const float* cw_up, const float* cw_dn, bf16* cw_upT, bf16* cw_dnT, const float* cw_gain) {
    LAS int* tstart = (LAS int*)(lds + MOE_TAB_OFF); LAS int* cnts = tstart + 64;
    moe_tables256(wv_, lds, cnt, cntB);
    pg8::MoeGatherOrder S; S.init(Hu, WupT, 2 * DFF, DM, tstart, cnts); S.list = list;
    for (int o = blockIdx.x * NTHREADS + TIDX; o < NEXP * NTOK; o += gridDim.x * NTHREADS) { const int e = o >> 15, r = o & (NTOK - 1);
        if (r < cnts[e]) { const u32x4 rc = REC[o]; TOKOF[(size_t)tstart[448 + (rc.z >> 20)] * 256 + (rc.z & 0x7FFFFu)] = rc.w; } }
    pg8::EpiSwiglu E{ACT2, REC, tstart};
    pg8::gemm_phase<pg8::EpiSwiglu, pg8::MoeGatherOrder, true>(wv_, lds, DM, S, E);
    if (cw_up) {
        const int G = gridDim.x, units = tstart[32] * 4, rem = units % G; int first_idle = rem;
        if (rem == 0 || G - rem < G / 4) first_idle = 0;
        const int c = blockIdx.x;
        if (c >= first_idle) { const int wid = wv_, lane = TIDX & 63; LAS float* scr = (LAS float*)(lds + wid * 16384);
            const int gw = (c - first_idle) * NWAVES + wid, NGW = (G - first_idle) * NWAVES;
            cvt_mats<2, true>(cw_up, NEXP, DM, 2 * DFF, 2 * DFF, cw_upT, scr, gw, NGW, lane, cw_gain, 0);
            cvt_mats<0>(cw_dn, NEXP, DFF, DM, DM, cw_dnT, scr, gw, NGW, lane); }
    }
}
template <bool NEXT>
__device__ __forceinline__ void moe_down_phase256(const int wv_, LAS unsigned char* lds, const bf16* ACT2, const bf16* WdnT, unsigned* cnt, unsigned* cntB, const unsigned* TOKOF, bf16* XS, float* OUT, float* PART) {
    LAS int* tstart = (LAS int*)(lds + MOE_TAB_OFF);
    moe_tables256(wv_, lds, cnt, cntB);
    pg8::MoeBucketOrder S; S.init(ACT2, WdnT, tstart);
    pg8::EpiDown<NEXT> E{TOKOF, XS, OUT, PART};
    pg8::gemm_phase<pg8::EpiDown<NEXT>, pg8::MoeBucketOrder, true>(wv_, lds, 2 * DFF, S, E);
}
template <class Epi, bool ALIGN_EPI = true>
__device__ __forceinline__ void gemm_dense256(const int wv_, LAS unsigned char* lds, const bf16* A, const bf16* Bt, int M, int N, int K, const Epi& E) {
    pg8::DenseOrder S; S.init(A, Bt, M, N, K);
    pg8::gemm_phase<Epi, pg8::DenseOrder, ALIGN_EPI>(wv_, lds, K, S, E);
}

__device__ __forceinline__ void rstd_prepass(const int wv_, const float* PART, float* RSTD) {
    const int tid = TIDX;
    for (int row = blockIdx.x * (NTHREADS / 4) + (tid >> 2); row < NTOK; row += gridDim.x * (NTHREADS / 4)) {
        const f32x4 a = *(const f32x4*)(PART + (size_t)row * 32 + (tid & 3) * 8), b = *(const f32x4*)(PART + (size_t)row * 32 + (tid & 3) * 8 + 4);
        float s = ((a[0] + a[1]) + (a[2] + a[3])) + ((b[0] + b[1]) + (b[2] + b[3]));
        s += __shfl_xor(s, 1); s += __shfl_xor(s, 2);
        if ((tid & 3) == 0) RSTD[row] = 1.0f / sqrtf(s * (1.0f / DM) + EPS);
    }
}
template <bool RS>
__device__ __forceinline__ void sc_thin_phase(const int wv_, const bf16* Bg, const bf16* P, const float* cw  , bf16* Y, const float* RSTD) {
    const size_t total = (size_t)NTOK * (DM / 8), stride = (size_t)gridDim.x * NTHREADS;
    constexpr int NU = 4;
    for (size_t i0 = (size_t)blockIdx.x * NTHREADS + TIDX; i0 < total; i0 += NU * stride) {
        u32x4 p[NU][3], bb[NU]; float rr[NU][3];
#pragma unroll
        for (int k = 0; k < NU; ++k) { const size_t i = i0 + k * stride; const bool ok = i < total; const int n = ok ? (int)(i / (DM / 8)) : 0, d0 = ok ? (int)(i % (DM / 8)) * 8 : 0, t = n & (SEQ - 1);
#pragma unroll
            for (int j = 0; j < 3; ++j) { const int tt = t + j - 1; p[k][j] = (tt >= 0 && tt < SEQ) ? *(const u32x4*)(P + (size_t)(n + j - 1) * DM + d0) : (u32x4){0u, 0u, 0u, 0u};
                if constexpr (RS) rr[k][j] = (tt >= 0 && tt < SEQ) ? RSTD[n + j - 1] : 0.f; }
            bb[k] = *(const u32x4*)(Bg + (size_t)n * DM + d0); }
#pragma unroll
        for (int k = 0; k < NU; ++k) { const size_t i = i0 + k * stride; if (i >= total) continue; const int n = (int)(i / (DM / 8)), d0 = (int)(i % (DM / 8)) * 8;
            float acc[8];
#pragma unroll
            for (int q = 0; q < 8; ++q) acc[q] = 0.f;
#pragma unroll
            for (int j = 0; j < 3; ++j) { const u32x4 pp = p[k][j];
                f32x4 w0 = *(const f32x4*)(cw + j * DM + d0), w1 = *(const f32x4*)(cw + j * DM + d0 + 4);
                if constexpr (RS) { const float s2 = rr[k][j] * rr[k][j]; w0 *= s2; w1 *= s2; }
                acc[0] += bflo(pp.x) * w0[0]; acc[1] += bfhi(pp.x) * w0[1]; acc[2] += bflo(pp.y) * w0[2]; acc[3] += bfhi(pp.y) * w0[3];
                acc[4] += bflo(pp.z) * w1[0]; acc[5] += bfhi(pp.z) * w1[1]; acc[6] += bflo(pp.w) * w1[2]; acc[7] += bfhi(pp.w) * w1[3]; }
            const u32x4 b_ = bb[k];
            if constexpr (RS) {
#pragma unroll
                for (int q = 0; q < 8; ++q) acc[q] *= rr[k][1]; }
            u32x4 o; o.x = pk2(bflo(b_.x) * acc[0], bfhi(b_.x) * acc[1]); o.y = pk2(bflo(b_.y) * acc[2], bfhi(b_.y) * acc[3]);
            o.z = pk2(bflo(b_.z) * acc[4], bfhi(b_.z) * acc[5]); o.w = pk2(bflo(b_.w) * acc[6], bfhi(b_.w) * acc[7]);
            *(u32x4*)(Y + (size_t)n * DM + d0) = o; }
    }
}

__device__ __forceinline__ s16x4 tr_rd(unsigned addr) { s16x4 r; asm volatile("ds_read_b64_tr_b16 %0, %1" : "=v"(r) : "v"(addr) : "memory"); return r; }
__device__ __forceinline__ void hy_thin1_phase(const int wv_, const bf16* Z, const float* cw  , const float* cb  , bf16* X0, bf16* VT, LAS unsigned char* lds, const float* RSTD) {
    const int tid = TIDX, tl = tid >> 3, dc = tid & 7, lane = tid & 63, wv = wv_, grp = lane >> 4, li = lane & 15;
    const int items = (NTOK / 64) * (DM / 64);
    u32x4 z[3][3]; float zr[3];
#define T1_LOAD(it_) do { const int nt_ = (it_) / (DM / 64), db_ = (it_) % (DM / 64), n_ = nt_ * 64 + tl, t_ = n_ & (SEQ - 1), d0_ = db_ * 64 + dc * 8; \
        _Pragma("unroll") for (int j = 0; j < 3; ++j) { const int tt = t_ + j - 1; zr[j] = (tt >= 0 && tt < SEQ) ? RSTD[n_ + j - 1] : 0.f; } \
        _Pragma("unroll") for (int gI = 1; gI < 3; ++gI) _Pragma("unroll") for (int j = 0; j < 3; ++j) { const int tt = t_ + j - 1; \
            z[gI][j] = (tt >= 0 && tt < SEQ) ? *(const u32x4*)(Z + (size_t)(n_ + j - 1) * (3 * DM) + gI * DM + d0_) : (u32x4){0u, 0u, 0u, 0u}; } } while (0)
    if ((int)blockIdx.x < items) T1_LOAD(blockIdx.x);
    for (int it = blockIdx.x; it < items; it += gridDim.x) {
        const int nt = it / (DM / 64), db = it % (DM / 64), n = nt * 64 + tl, d0 = db * 64 + dc * 8;
        float u[3][8];
#pragma unroll
        for (int gI = 1; gI < 3; ++gI) { const int c0 = gI * DM + d0;
            const f32x4 b0 = *(const f32x4*)(cb + c0), b1 = *(const f32x4*)(cb + c0 + 4);
#pragma unroll
            for (int k = 0; k < 4; ++k) { u[gI][k] = b0[k]; u[gI][4 + k] = b1[k]; }
#pragma unroll
            for (int j = 0; j < 3; ++j) { const u32x4 zz = z[gI][j];
                const f32x4 w0 = *(const f32x4*)(cw + j * 3 * DM + c0) * zr[j], w1 = *(const f32x4*)(cw + j * 3 * DM + c0 + 4) * zr[j];
                u[gI][0] += bflo(zz.x) * w0[0]; u[gI][1] += bfhi(zz.x) * w0[1]; u[gI][2] += bflo(zz.y) * w0[2]; u[gI][3] += bfhi(zz.y) * w0[3];
                u[gI][4] += bflo(zz.z) * w1[0]; u[gI][5] += bfhi(zz.z) * w1[1]; u[gI][6] += bflo(zz.w) * w1[2]; u[gI][7] += bfhi(zz.w) * w1[3]; } }
        u32x4 vx; vx.x = pk2(u[2][0] * u[1][0], u[2][1] * u[1][1]); vx.y = pk2(u[2][2] * u[1][2], u[2][3] * u[1][3]); vx.z = pk2(u[2][4] * u[1][4], u[2][5] * u[1][5]); vx.w = pk2(u[2][6] * u[1][6], u[2][7] * u[1][7]);
        __syncthreads();
        *(LAS u32x4*)(lds + tl * 144 + dc * 16) = vx;
        if (it + (int)gridDim.x < items) T1_LOAD(it + gridDim.x);
        __syncthreads();
        { const unsigned a0 = (unsigned)(size_t)(lds + (32 * (wv >> 2) + 8 * grp + (li >> 2)) * 144 + (16 * (wv & 3) + 4 * (li & 3)) * 2);
            s16x4 lo = tr_rd(a0), hi = tr_rd(a0 + 4 * 144);
            asm volatile("s_waitcnt lgkmcnt(0)" : "+v"(lo), "+v"(hi) :: "memory");
            const int bidx = (nt * 64) / SEQ, t0 = (nt * 64) & (SEQ - 1);
            const bf16x8 ov = (bf16x8){lo[0], lo[1], lo[2], lo[3], hi[0], hi[1], hi[2], hi[3]};
            *(bf16x8*)(VT + ((size_t)bidx * DM + db * 64 + 16 * (wv & 3) + li) * SEQ + t0 + 32 * (wv >> 2) + 8 * grp) = ov; }
    }
#undef T1_LOAD
}

constexpr int LC_KR0 = 0, LC_KR1 = 16384 + 64, LC_V = 33024, LC_VROW = 2176;
__device__ __forceinline__ int lc_vrow_byte(int b) { return (b * LC_VROW + 4 * (b & 3)) * 4; }
__device__ __forceinline__ bf16x8 lc_ld_a(const LAS unsigned char* p) {
    const unsigned w0 = *(const LAS unsigned*)(p), w1 = *(const LAS unsigned*)(p + 4), w2 = *(const LAS unsigned*)(p + 8), w3 = *(const LAS unsigned*)(p + 12);
    u32x4 w = {w0, w1, w2, w3}; return __builtin_bit_cast(bf16x8, w);
}
__device__ __forceinline__ void longconv_phase(const int wv_, const bf16* KRB, const bf16* VT, const float* skip, bf16* YST, LAS unsigned char* lds) {
    const int tid = TIDX, lane = tid & 63, wid = wv_, r32 = lane & 31, hi = lane >> 5;
    for (int i = tid; i < 8 * 192; i += NTHREADS) { const int b = i / 192, j = i % 192, sp = j < 96 ? j : 4096 + j;
        *(LAS bf16*)(lds + LC_V + lc_vrow_byte(b) + 2 * sp) = 0; }
    const int T0 = 512 * wid, P = 4095 - T0 - r32 + 8 * hi, cpy = P & 1;
    const int Al = (cpy ? LC_KR1 : LC_KR0) + 2 * (P - cpy) - 960;
    const int q = r32 >> 3, bb = r32 & 7, Vl = LC_V + lc_vrow_byte(bb) + 64 * q + 16 * hi;
    u32x4 pk0, pk1, pk2_, pk3, vr[8];
#define LC_LOAD(dd) do { const u32x4* k0 = (const u32x4*)(KRB + (size_t)(dd) * 8192), * k1 = (const u32x4*)(KRB + (size_t)DM * 8192 + (size_t)(dd) * 8192); \
        pk0 = k0[tid]; pk1 = k0[tid + 512]; pk2_ = k1[tid]; pk3 = k1[tid + 512]; \
        _Pragma("unroll") for (int i = 0; i < 8; ++i) vr[i] = *((const u32x4*)(VT + ((size_t)i * DM + (dd)) * SEQ) + tid); } while (0)
    if ((int)blockIdx.x < DM) LC_LOAD(blockIdx.x);
    for (int d = blockIdx.x; d < DM; d += gridDim.x) {
        __syncthreads();
        *(LAS u32x4*)(lds + LC_KR0 + tid * 16) = pk0; *(LAS u32x4*)(lds + LC_KR0 + (tid + 512) * 16) = pk1;
        *(LAS u32x4*)(lds + LC_KR1 + tid * 16) = pk2_; *(LAS u32x4*)(lds + LC_KR1 + (tid + 512) * 16) = pk3;
#pragma unroll
        for (int i = 0; i < 8; ++i) *(LAS u32x4*)(lds + LC_V + lc_vrow_byte(i) + 192 + tid * 16) = vr[i];
        __syncthreads();
        if (d + (int)gridDim.x < DM) LC_LOAD(d + gridDim.x);
        f32x16 acc[4];
#pragma unroll
        for (int g = 0; g < 4; ++g)
#pragma unroll
            for (int r = 0; r < 16; ++r) acc[g][r] = 0.f;
        for (int a = 0; a < 8; ++a) {
            const LAS unsigned char* ab = lds + Al + 1024 * a; const LAS unsigned char* vb = lds + Vl + 1024 * a;
#pragma unroll
            for (int u = 0; u < 8; ++u) {
                bf16x8 At[7], Bt[4];
#pragma unroll
                for (int jp = 0; jp < 7; ++jp) At[jp] = lc_ld_a(ab + 768 + 32 * u - 256 * (jp - 3));
#pragma unroll
                for (int h = 0; h < 4; ++h) Bt[h] = *(const LAS bf16x8*)(vb + 32 * u + 256 * h);
#pragma unroll
                for (int h = 0; h < 4; ++h)
#pragma unroll
                    for (int g = 0; g < 4; ++g) acc[g] = __builtin_amdgcn_mfma_f32_32x32x16_bf16(At[g - h + 3], Bt[h], acc[g], 0, 0, 0);
            }
        }
        { const LAS unsigned char* ab = lds + Al + 8192; const LAS unsigned char* vb = lds + Vl + 8192;
#pragma unroll
            for (int u = 0; u < 6; ++u) {
                const bf16x8 B0 = *(const LAS bf16x8*)(vb + 32 * u);
#pragma unroll
                for (int g = 0; g < 4; ++g) { const bf16x8 A0 = lc_ld_a(ab + 768 + 32 * u - 256 * g); acc[g] = __builtin_amdgcn_mfma_f32_32x32x16_bf16(A0, B0, acc[g], 0, 0, 0); }
            } }
        const float sk = skip[d];
#pragma unroll
        for (int g = 0; g < 4; ++g)
#pragma unroll
            for (int rr = 0; rr < 4; ++rr) { const int t = T0 + 128 * g + 32 * q + 8 * rr + 4 * hi;
                const u32x2 vv = *(const LAS u32x2*)(lds + LC_V + lc_vrow_byte(bb) + (96 + t) * 2);
                u32x2 o; o.x = pk2(acc[g][4 * rr + 0] + bflo(vv.x) * sk, acc[g][4 * rr + 1] + bfhi(vv.x) * sk); o.y = pk2(acc[g][4 * rr + 2] + bflo(vv.y) * sk, acc[g][4 * rr + 3] + bfhi(vv.y) * sk);
                *(u32x2*)(YST + ((size_t)bb * DM + d) * SEQ + t) = o; }
    }
#undef LC_LOAD
}

__device__ __forceinline__ void hy_thin2_phase(const int wv_, const bf16* YST, const bf16* Z, const float* cw  , const float* cb  , const float* RSTD, bf16* G, LAS unsigned char* lds) {
    const int tid = TIDX, dl = tid >> 3, tc = tid & 7, lane = tid & 63, wv = wv_, grp = lane >> 4, li = lane & 15;
    constexpr int items = (NTOK / 64) * (DM / 64), NI = 4, TILE = 64 * 144;
    u32x4 yv[NI];
#define T2_LOAD(g_) do { _Pragma("unroll") for (int k = 0; k < NI; ++k) { const int it_ = (g_) * NI + k; if (it_ < items) { const int nt_ = it_ / (DM / 64), db_ = it_ % (DM / 64), bi_ = (nt_ * 64) / SEQ, t0_ = (nt_ * 64) & (SEQ - 1); \
        yv[k] = *(const u32x4*)(YST + ((size_t)bi_ * DM + db_ * 64 + dl) * SEQ + t0_ + tc * 8); } } } while (0)
    if ((int)blockIdx.x * NI < items) T2_LOAD(blockIdx.x);
    for (int gi = blockIdx.x; gi * NI < items; gi += gridDim.x) {
        u32x4 zq[NI][3]; float zs[NI][3]; size_t goff[NI]; int dq[NI];
#pragma unroll
        for (int k = 0; k < NI; ++k) { const int it = gi * NI + k < items ? gi * NI + k : items - 1; const int nt = it / (DM / 64), db = it % (DM / 64);
            const int n = nt * 64 + 16 * (wv & 3) + li, t = n & (SEQ - 1); dq[k] = db * 64 + 32 * (wv >> 2) + 8 * grp; goff[k] = (size_t)n * DM + dq[k];
#pragma unroll
            for (int j = 0; j < 3; ++j) { const int tt = t + j - 1; const bool ok = tt >= 0 && tt < SEQ;
                zq[k][j] = ok ? *(const u32x4*)(Z + (size_t)(n + j - 1) * (3 * DM) + dq[k]) : (u32x4){0u, 0u, 0u, 0u}; zs[k][j] = ok ? RSTD[n + j - 1] : 0.f; } }
        __syncthreads();
#pragma unroll
        for (int k = 0; k < NI; ++k) *(LAS u32x4*)(lds + k * TILE + dl * 144 + tc * 16) = yv[k];
        if ((gi + (int)gridDim.x) * NI < items) T2_LOAD(gi + gridDim.x);
        __syncthreads();
        const unsigned a0 = (unsigned)(size_t)(lds + (32 * (wv >> 2) + 8 * grp + (li >> 2)) * 144 + (16 * (wv & 3) + 4 * (li & 3)) * 2);
#pragma unroll
        for (int k = 0; k < NI; ++k) {
            s16x4 lo = tr_rd(a0 + k * TILE), hi = tr_rd(a0 + k * TILE + 4 * 144);
            asm volatile("s_waitcnt lgkmcnt(0)" : "+v"(lo), "+v"(hi) :: "memory");
            const u32x2 l2 = __builtin_bit_cast(u32x2, lo), h2 = __builtin_bit_cast(u32x2, hi);
            float x[8]; { const f32x4 b0 = *(const f32x4*)(cb + dq[k]), b1 = *(const f32x4*)(cb + dq[k] + 4);
#pragma unroll
                for (int e = 0; e < 4; ++e) { x[e] = b0[e]; x[4 + e] = b1[e]; } }
#pragma unroll
            for (int j = 0; j < 3; ++j) { const u32x4 zz = zq[k][j]; const f32x4 w0 = *(const f32x4*)(cw + j * 3 * DM + dq[k]) * zs[k][j], w1 = *(const f32x4*)(cw + j * 3 * DM + dq[k] + 4) * zs[k][j];
                x[0] += bflo(zz.x) * w0[0]; x[1] += bfhi(zz.x) * w0[1]; x[2] += bflo(zz.y) * w0[2]; x[3] += bfhi(zz.y) * w0[3];
                x[4] += bflo(zz.z) * w1[0]; x[5] += bfhi(zz.z) * w1[1]; x[6] += bflo(zz.w) * w1[2]; x[7] += bfhi(zz.w) * w1[3]; }
            u32x4 o; o.x = pk2(bflo(l2.x) * x[0], bfhi(l2.x) * x[1]); o.y = pk2(bflo(l2.y) * x[2], bfhi(l2.y) * x[3]);
            o.z = pk2(bflo(h2.x) * x[4], bfhi(h2.x) * x[5]); o.w = pk2(bflo(h2.y) * x[6], bfhi(h2.y) * x[7]);
            if (gi * NI + k < items) *(u32x4*)(G + goff[k]) = o; }
    }
#undef T2_LOAD
}

__device__ __forceinline__ void mla_thin1_phase(const int wv_, const bf16* DOWN, const float* qn, const float* kvn, bf16* CQ, bf16* CKV, const float* RSTD) {
    const int lane = TIDX & 63, wid = wv_;
    constexpr int NR = 4;
    for (int rg = blockIdx.x * NWAVES + wid; rg < NTOK / NR; rg += gridDim.x * NWAVES) {
        u32x2 va[NR][2], vb[NR][2];
#pragma unroll
        for (int r = 0; r < NR; ++r)
#pragma unroll
            for (int part = 0; part < 2; ++part) { const bf16* dp = DOWN + (size_t)(rg * NR + r) * NDOWNP + part * 512; va[r][part] = *(const u32x2*)(dp + lane * 4); vb[r][part] = *(const u32x2*)(dp + 256 + lane * 4); }
#pragma unroll
        for (int r = 0; r < NR; ++r)
#pragma unroll
            for (int part = 0; part < 2; ++part) { const int row = rg * NR + r; const float rsx = RSTD[row]; const u32x2 ua = va[r][part], ub = vb[r][part];
                const f32x4 a = (f32x4){bflo(ua.x), bfhi(ua.x), bflo(ua.y), bfhi(ua.y)} * rsx, b = (f32x4){bflo(ub.x), bfhi(ub.x), bflo(ub.y), bfhi(ub.y)} * rsx;
                float ss = a[0] * a[0] + a[1] * a[1] + a[2] * a[2] + a[3] * a[3] + b[0] * b[0] + b[1] * b[1] + b[2] * b[2] + b[3] * b[3];
                ss = wave_sum(ss); const float rs = 1.0f / sqrtf(ss * (1.0f / 512.0f) + EPS);
                const float* gn = part ? kvn : qn; const f32x4 ga = *(const f32x4*)(gn + lane * 4), gb = *(const f32x4*)(gn + 256 + lane * 4);
                bf16* o = (part ? CKV : CQ) + (size_t)row * 512;
                u32x2 oa, ob; oa.x = pk2(a[0] * rs * ga[0], a[1] * rs * ga[1]); oa.y = pk2(a[2] * rs * ga[2], a[3] * rs * ga[3]);
                ob.x = pk2(b[0] * rs * gb[0], b[1] * rs * gb[1]); ob.y = pk2(b[2] * rs * gb[2], b[3] * rs * gb[3]);
                *(u32x2*)(o + lane * 4) = oa; *(u32x2*)(o + 256 + lane * 4) = ob; }
    }
}
__device__ __forceinline__ void mla_thin2_phase(const int wv_, const bf16* QRAW, const bf16* KVRAW, const bf16* DOWN, const float* qg, const float* kg, const f32x2* ROPE, bf16* Q, bf16* K, const float* RSTD) {
    const int lane = TIDX & 63, wid = wv_, grp = lane >> 5, j = lane & 31, jc = j < 24 ? j : 23;
    const bool act = j < 24, isrope = j >= 16 && j < 24, isx2 = j >= 20;
    float qgv[8], kgv[8];
#pragma unroll
    for (int k = 0; k < 8; ++k) { qgv[k] = qg[8 * jc + k]; kgv[k] = kg[8 * jc + k]; }
    for (int row = blockIdx.x * NWAVES + wid; row < NTOK; row += gridDim.x * NWAVES) {
        const int t = row & (SEQ - 1);
        float cs[8], sn[8], kr[8];
#pragma unroll
        for (int k = 0; k < 8; ++k) { cs[k] = 1.f; sn[k] = 0.f; kr[k] = 0.f; }
        if (isrope) { const f32x4* rp = (const f32x4*)(ROPE + (size_t)t * 32 + 8 * ((j - 16) & 3));
            const f32x4 r0 = rp[0], r1 = rp[1], r2 = rp[2], r3 = rp[3];
            cs[0] = r0[0]; sn[0] = r0[1]; cs[1] = r0[2]; sn[1] = r0[3]; cs[2] = r1[0]; sn[2] = r1[1]; cs[3] = r1[2]; sn[3] = r1[3];
            cs[4] = r2[0]; sn[4] = r2[1]; cs[5] = r2[2]; sn[5] = r2[3]; cs[6] = r3[0]; sn[6] = r3[1]; cs[7] = r3[2]; sn[7] = r3[3];
            const u32x4 k0 = *(const u32x4*)(DOWN + (size_t)row * NDOWNP + 1024 + 8 * (j - 16));
            kr[0] = bflo(k0.x); kr[1] = bfhi(k0.x); kr[2] = bflo(k0.y); kr[3] = bfhi(k0.y); kr[4] = bflo(k0.z); kr[5] = bfhi(k0.z); kr[6] = bflo(k0.w); kr[7] = bfhi(k0.w);
            { const float rsx = RSTD[row];
#pragma unroll
                for (int k = 0; k < 8; ++k) kr[k] *= rsx; }
            if (!isx2) {
#pragma unroll
                for (int k = 0; k < 8; ++k) sn[k] = -sn[k]; } }
        u32x4 kx[NH / 2];
#pragma unroll
        for (int hp = 0; hp < NH / 2; ++hp) { const int h = 2 * hp + grp;
            kx[hp] = *(const u32x4*)(KVRAW + (size_t)row * 4096 + h * 256 + 8 * (j < 16 ? j : 0)); }
#pragma unroll
        for (int hp = 0; hp < NH / 2; ++hp) {
            const int h = 2 * hp + grp;
#pragma unroll
            for (int qk = 1; qk < 2; ++qk) {
                float v[8]; const u32x4 x = kx[hp];
                v[0] = bflo(x.x); v[1] = bfhi(x.x); v[2] = bflo(x.y); v[3] = bfhi(x.y); v[4] = bflo(x.z); v[5] = bfhi(x.z); v[6] = bflo(x.w); v[7] = bfhi(x.w);
                if (qk == 1 && j >= 16) {
#pragma unroll
                    for (int k = 0; k < 8; ++k) v[k] = kr[k]; }
                float ss = 0.f;
#pragma unroll
                for (int k = 0; k < 8; ++k) ss += v[k] * v[k];
                ss = act ? ss : 0.f;
                ss += __shfl_xor(ss, 1); ss += __shfl_xor(ss, 2); ss += __shfl_xor(ss, 4); ss += __shfl_xor(ss, 8); ss += __shfl_xor(ss, 16);
                const float rs = 1.0f / sqrtf(ss * (1.0f / 192.0f) + EPS);
                float o[8];
#pragma unroll
                for (int k = 0; k < 8; ++k) { const float n = v[k] * rs * (qk == 0 ? qgv[k] : kgv[k]); const float pr = __shfl_xor(n, 4); o[k] = n * cs[k] + pr * sn[k]; }
                if (act) { u32x4 w; w.x = pk2(o[0], o[1]); w.y = pk2(o[2], o[3]); w.z = pk2(o[4], o[5]); w.w = pk2(o[6], o[7]);
                    *(u32x4*)((qk == 0 ? Q : K) + (size_t)row * 3072 + h * DQK + 8 * j) = w; }
            }
        }
    }
}

namespace attn {
constexpr int KVBLK = 64, QBLK = 32;
constexpr float SCALE = 0.07216878364870322f;
constexpr float THR = 8.f;
constexpr int LDQ = 3072, LDK = 3072, LDV = 4096, LDO = 2048;
constexpr int SHM_V = KVBLK * DV * 2, SHM_K = KVBLK * DQK * 2;
#define KSWZ(row, colB) ((row) * 384 + ((colB) ^ ((((row) >> 1) & 7) << 4)))
#define SBAR() __builtin_amdgcn_sched_barrier(0)
__device__ __forceinline__ unsigned cvtpk(float lo, float hi) { unsigned r; asm volatile("v_cvt_pk_bf16_f32 %0, %1, %2" : "=v"(r) : "v"(lo), "v"(hi)); return r; }
__device__ __forceinline__ void partialSM(f32x16& p0, f32x16& p1, float& m_reg, float& mn, float& alpha) {
    constexpr float C = SCALE * 1.4426950408889634f;
    float pmax = p0[0];
#pragma unroll
    for (int r = 1; r < 16; ++r) pmax = fmaxf(pmax, p0[r]);
#pragma unroll
    for (int r = 0; r < 16; ++r) pmax = fmaxf(pmax, p1[r]);
    { auto rr = __builtin_amdgcn_permlane32_swap(__float_as_uint(pmax), __float_as_uint(pmax), false, false);
      pmax = fmaxf(__uint_as_float(rr[0]), __uint_as_float(rr[1])); }
    if (__builtin_expect(__all(pmax - m_reg <= THR / SCALE), 1)) { mn = m_reg; alpha = 1.f; }
    else { mn = fmaxf(m_reg, pmax); alpha = __builtin_amdgcn_exp2f((m_reg - mn) * C); m_reg = mn; }
    const float mnC = -mn * C;
#pragma unroll
    for (int r = 0; r < 16; ++r) p0[r] = fmaf(p0[r], C, mnC);
#pragma unroll
    for (int r = 0; r < 16; ++r) p1[r] = fmaf(p1[r], C, mnC);
#pragma unroll
    for (int r = 0; r < 16; ++r) p0[r] = __builtin_amdgcn_exp2f(p0[r]);
}
__device__ __forceinline__ void finishSM(f32x16& p0, f32x16& p1, float alpha, float& l_reg, bf16x8& pa0, bf16x8& pa1, bf16x8& pa2, bf16x8& pa3) {
#pragma unroll
    for (int r = 0; r < 16; ++r) p1[r] = __builtin_amdgcn_exp2f(p1[r]);
    float ps = 0;
#pragma unroll
    for (int r = 0; r < 16; ++r) ps += p0[r];
#pragma unroll
    for (int r = 0; r < 16; ++r) ps += p1[r];
    { auto rr = __builtin_amdgcn_permlane32_swap(__float_as_uint(ps), __float_as_uint(ps), false, false);
      ps = __uint_as_float(rr[0]) + __uint_as_float(rr[1]); }
    l_reg = l_reg * alpha + ps;
#define PK4(P, BASE, OUT) do { unsigned a0 = cvtpk(P[BASE + 0], P[BASE + 1]), a1 = cvtpk(P[BASE + 2], P[BASE + 3]);   \
    unsigned b0 = cvtpk(P[BASE + 4], P[BASE + 5]), b1 = cvtpk(P[BASE + 6], P[BASE + 7]);                              \
    auto r0 = __builtin_amdgcn_permlane32_swap(a0, b0, false, false); auto r1 = __builtin_amdgcn_permlane32_swap(a1, b1, false, false); \
    u32x4 w = {r0[0], r1[0], r0[1], r1[1]}; OUT = __builtin_bit_cast(bf16x8, w); } while (0)
    PK4(p0, 0, pa0); PK4(p0, 8, pa1); PK4(p1, 0, pa2); PK4(p1, 8, pa3);
#undef PK4
}
__device__ __forceinline__ void qkt(f32x16& p0, f32x16& p1, const LAS unsigned char* Ks, const bf16x8* qr, int r32, int hi) {
#pragma unroll
    for (int i = 0; i < 16; ++i) { p0[i] = 0.f; p1[i] = 0.f; }
#pragma unroll
    for (int d0 = 0; d0 < 12; ++d0) { const int cb = (d0 * 16 + hi * 8) * 2;
        const bf16x8 b0 = *(const LAS bf16x8*)(Ks + KSWZ(r32, cb));
        const bf16x8 b1 = *(const LAS bf16x8*)(Ks + KSWZ(32 + r32, cb));
        p0 = __builtin_amdgcn_mfma_f32_32x32x16_bf16(b0, qr[d0], p0, 0, 0, 0);
        p1 = __builtin_amdgcn_mfma_f32_32x32x16_bf16(b1, qr[d0], p1, 0, 0, 0); }
}
__device__ __forceinline__ int v_st(int k, int c) { const int kk = (k & ~0xC) | ((k & 4) << 1) | ((k & 8) >> 1); return ((kk >> 3) * 4 + (c >> 5)) * 512 + ((kk & 7) * 32 + (c & 31)) * 2; }
__device__ __forceinline__ int v_rd_base(int lane) { return ((lane & 3) << 3) | (((lane >> 2) & 3) << 6) | (((lane >> 4) & 1) << 5) | (((lane >> 5) & 1) << 8); }
constexpr int v_rd_off(int d0, int ks, int half) { return d0 * 512 + ks * 4096 + half * 2048; }
template <int OFF> __device__ __forceinline__ s16x4 tr_read(int vb) {
    s16x4 r; asm volatile("ds_read_b64_tr_b16 %0, %1 offset:%2" : "=&v"(r) : "v"(vb), "i"(OFF) : "memory"); return r;
}
template <int D0> __device__ __forceinline__ void pv_one(f32x16& od, int vb, bf16x8 pa0, bf16x8 pa1, bf16x8 pa2, bf16x8 pa3) {
    const s16x4 l0 = tr_read<v_rd_off(D0, 0, 0)>(vb), h0 = tr_read<v_rd_off(D0, 0, 1)>(vb), l1 = tr_read<v_rd_off(D0, 1, 0)>(vb), h1 = tr_read<v_rd_off(D0, 1, 1)>(vb);
    const s16x4 l2 = tr_read<v_rd_off(D0, 2, 0)>(vb), h2 = tr_read<v_rd_off(D0, 2, 1)>(vb), l3 = tr_read<v_rd_off(D0, 3, 0)>(vb), h3 = tr_read<v_rd_off(D0, 3, 1)>(vb);
    asm volatile("s_waitcnt lgkmcnt(0)" ::: "memory"); SBAR();
#define PKV(L, H) (bf16x8){L[0], L[1], L[2], L[3], H[0], H[1], H[2], H[3]}
    od = __builtin_amdgcn_mfma_f32_32x32x16_bf16(pa0, PKV(l0, h0), od, 0, 0, 0);
    od = __builtin_amdgcn_mfma_f32_32x32x16_bf16(pa1, PKV(l1, h1), od, 0, 0, 0);
    od = __builtin_amdgcn_mfma_f32_32x32x16_bf16(pa2, PKV(l2, h2), od, 0, 0, 0);
    od = __builtin_amdgcn_mfma_f32_32x32x16_bf16(pa3, PKV(l3, h3), od, 0, 0, 0);
#undef PKV
}
__device__ __forceinline__ void pv_d0(f32x16* o, int vb, bf16x8 pa0, bf16x8 pa1, bf16x8 pa2, bf16x8 pa3) {
    pv_one<0>(o[0], vb, pa0, pa1, pa2, pa3); pv_one<1>(o[1], vb, pa0, pa1, pa2, pa3); pv_one<2>(o[2], vb, pa0, pa1, pa2, pa3); pv_one<3>(o[3], vb, pa0, pa1, pa2, pa3);
}
__device__ __forceinline__ void unit(const int wv_, const bf16* __restrict__ Qb, const bf16* __restrict__ Kh, const bf16* __restrict__ Vh, bf16* __restrict__ Ob, int seq, LAS unsigned char* lds,
                                     const float* __restrict__ qg, const f32x2* __restrict__ ROPE, int t0) {
    const int tid = TIDX, wid = wv_, lane = tid & 63, r32 = lane & 31, hi = lane >> 5;
    LAS unsigned char* V_lds = lds; LAS unsigned char* K_lds = lds + 3 * SHM_V;
    LAS float* ws = (LAS float*)(lds + 3 * SHM_V + 3 * SHM_K) + wid * 64; LAS float* li_l = ws; LAS float* al_l = ws + 32;
    float m_reg = -1e30f, l_reg = 0; f32x16 o[4]; bf16x8 qr[12];
#pragma unroll
    for (int d = 0; d < 4; ++d)
#pragma unroll
        for (int r = 0; r < 16; ++r) o[d][r] = 0.f;
    const bf16* Qw = Qb + (long)(wid * QBLK + r32) * LDQ + hi * 8;
#pragma unroll
    for (int d0 = 0; d0 < 12; ++d0) qr[d0] = *(const bf16x8*)(Qw + d0 * 16);
    const int wu = wv_;
    int koff[3], voff[2];
#pragma unroll
    for (int i = 0; i < 3; ++i) { const int p = (i * 8 + wid) * 64 + lane, row = p / 24, cidx = p % 24; koff[i] = row * LDK + ((cidx ^ ((row >> 1) & 7)) * 8); }
#pragma unroll
    for (int i = 0; i < 2; ++i) { const int p = (i * 8 + wid) * 64 + lane, sub = p >> 5, q5 = p & 31, kk = (sub >> 2) * 8 + (q5 >> 2), k = (kk & ~0xC) | ((kk & 4) << 1) | ((kk & 8) >> 1), c = (sub & 3) * 32 + (q5 & 3) * 8;
        voff[i] = k * LDV + c; }
    const int vb0 = (int)(uintptr_t)V_lds + v_rd_base(lane);
#define DMA_TILE(b, k0) do { const bf16* Kt_ = Kh + (long)(k0) * LDK; const bf16* Vt_ = Vh + (long)(k0) * LDV; \
    _Pragma("unroll") for (int i = 0; i < 3; ++i) __builtin_amdgcn_global_load_lds((const GAS unsigned*)(Kt_ + koff[i]), (LAS unsigned*)(K_lds + (b) * SHM_K + (i * 8 + wu) * 1024), 16, 0, 0); \
    _Pragma("unroll") for (int i = 0; i < 2; ++i) __builtin_amdgcn_global_load_lds((const GAS unsigned*)(Vt_ + voff[i]), (LAS unsigned*)(V_lds + (b) * SHM_V + (i * 8 + wu) * 1024), 16, 0, 0); } while (0)
#define RESC(a) do { if (__any((a) < 1.f)) { if (hi == 0) al_l[r32] = (a); asm volatile("s_waitcnt lgkmcnt(0)" ::: "memory"); \
    _Pragma("unroll") for (int d = 0; d < 4; ++d) _Pragma("unroll") for (int r = 0; r < 16; ++r) o[d][r] *= al_l[crow(r, hi)]; } } while (0)
    f32x16 pA0, pA1, pB0, pB1; float mnA, mnB, alA, alB; bf16x8 pa0, pa1, pa2, pa3; const int NT = seq / KVBLK;
#define VMWAIT() asm volatile("s_waitcnt vmcnt(0)" ::: "memory")
    __syncthreads();
    DMA_TILE(0, 0);
    {
        float ss = 0.f;
#pragma unroll
        for (int d0 = 0; d0 < 12; ++d0) { const u32x4 w = __builtin_bit_cast(u32x4, qr[d0]);
            const float a0 = bflo(w.x), a1 = bfhi(w.x), a2 = bflo(w.y), a3 = bfhi(w.y), a4 = bflo(w.z), a5 = bfhi(w.z), a6 = bflo(w.w), a7 = bfhi(w.w);
            ss += a0 * a0 + a1 * a1 + a2 * a2 + a3 * a3 + a4 * a4 + a5 * a5 + a6 * a6 + a7 * a7; }
        ss += __shfl_xor(ss, 32);
        const float rs = 1.0f / sqrtf(ss * (1.0f / 192.0f) + EPS);
#pragma unroll
        for (int d0 = 0; d0 < 8; ++d0) { const u32x4 w = __builtin_bit_cast(u32x4, qr[d0]); const f32x4 g0 = *(const f32x4*)(qg + d0 * 16 + hi * 8) * rs, g1 = *(const f32x4*)(qg + d0 * 16 + hi * 8 + 4) * rs;
            u32x4 o_; o_.x = cvtpk(bflo(w.x) * g0[0], bfhi(w.x) * g0[1]); o_.y = cvtpk(bflo(w.y) * g0[2], bfhi(w.y) * g0[3]); o_.z = cvtpk(bflo(w.z) * g1[0], bfhi(w.z) * g1[1]); o_.w = cvtpk(bflo(w.w) * g1[2], bfhi(w.w) * g1[3]);
            qr[d0] = __builtin_bit_cast(bf16x8, o_); }
        const f32x2* rp = ROPE + (size_t)(t0 + wid * QBLK + r32) * 32 + hi * 8;
#pragma unroll
        for (int d0 = 8; d0 < 10; ++d0) { const u32x4 wa = __builtin_bit_cast(u32x4, qr[d0]), wb = __builtin_bit_cast(u32x4, qr[d0 + 2]);
            float a[8], b[8], oa[8], ob[8];
            a[0] = bflo(wa.x); a[1] = bfhi(wa.x); a[2] = bflo(wa.y); a[3] = bfhi(wa.y); a[4] = bflo(wa.z); a[5] = bfhi(wa.z); a[6] = bflo(wa.w); a[7] = bfhi(wa.w);
            b[0] = bflo(wb.x); b[1] = bfhi(wb.x); b[2] = bflo(wb.y); b[3] = bfhi(wb.y); b[4] = bflo(wb.z); b[5] = bfhi(wb.z); b[6] = bflo(wb.w); b[7] = bfhi(wb.w);
#pragma unroll
            for (int j4 = 0; j4 < 2; ++j4) { const f32x4 ga = *(const f32x4*)(qg + d0 * 16 + hi * 8 + 4 * j4) * rs, gb = *(const f32x4*)(qg + (d0 + 2) * 16 + hi * 8 + 4 * j4) * rs;
                const f32x4 c01 = *(const f32x4*)(rp + (d0 - 8) * 16 + 4 * j4), c23 = *(const f32x4*)(rp + (d0 - 8) * 16 + 4 * j4 + 2);
#pragma unroll
                for (int jj = 0; jj < 4; ++jj) { const int j = 4 * j4 + jj; const float cs = jj < 2 ? c01[2 * jj] : c23[2 * (jj - 2)], sn = jj < 2 ? c01[2 * jj + 1] : c23[2 * (jj - 2) + 1];
                    const float na = a[j] * ga[jj], nb = b[j] * gb[jj]; oa[j] = na * cs - nb * sn; ob[j] = nb * cs + na * sn; } }
            u32x4 pa_, pb_; pa_.x = cvtpk(oa[0], oa[1]); pa_.y = cvtpk(oa[2], oa[3]); pa_.z = cvtpk(oa[4], oa[5]); pa_.w = cvtpk(oa[6], oa[7]);
            pb_.x = cvtpk(ob[0], ob[1]); pb_.y = cvtpk(ob[2], ob[3]); pb_.z = cvtpk(ob[4], ob[5]); pb_.w = cvtpk(ob[6], ob[7]);
            qr[d0] = __builtin_bit_cast(bf16x8, pa_); qr[d0 + 2] = __builtin_bit_cast(bf16x8, pb_); }
    }
    VMWAIT(); __syncthreads();
    DMA_TILE(1, KVBLK);
    qkt(pA0, pA1, K_lds, qr, r32, hi); partialSM(pA0, pA1, m_reg, mnA, alA);
    VMWAIT(); __syncthreads();
    int bj = 1;
    for (int j = 1; j + 1 < NT; j += 2) {
        const int bp = bj == 0 ? 2 : bj - 1, bn = bj == 2 ? 0 : bj + 1, bnn = bn == 2 ? 0 : bn + 1;
        DMA_TILE(bn, (j + 1) * KVBLK);
        SBAR(); qkt(pB0, pB1, K_lds + bj * SHM_K, qr, r32, hi);
        finishSM(pA0, pA1, alA, l_reg, pa0, pa1, pa2, pa3); SBAR();
        pv_d0(o, vb0 + bp * SHM_V, pa0, pa1, pa2, pa3); partialSM(pB0, pB1, m_reg, mnB, alB);
        RESC(alB); VMWAIT(); __syncthreads();
        if (j + 2 < NT) DMA_TILE(bnn, (j + 2) * KVBLK);
        SBAR(); qkt(pA0, pA1, K_lds + bn * SHM_K, qr, r32, hi);
        finishSM(pB0, pB1, alB, l_reg, pa0, pa1, pa2, pa3); SBAR();
        pv_d0(o, vb0 + bj * SHM_V, pa0, pa1, pa2, pa3); partialSM(pA0, pA1, m_reg, mnA, alA);
        RESC(alA); VMWAIT(); __syncthreads();
        bj = bnn;
    }
    {
        const int bp = bj == 0 ? 2 : bj - 1;
        SBAR(); qkt(pB0, pB1, K_lds + bj * SHM_K, qr, r32, hi);
        finishSM(pA0, pA1, alA, l_reg, pa0, pa1, pa2, pa3); SBAR();
        pv_d0(o, vb0 + bp * SHM_V, pa0, pa1, pa2, pa3); partialSM(pB0, pB1, m_reg, mnB, alB);
        RESC(alB);
        finishSM(pB0, pB1, alB, l_reg, pa0, pa1, pa2, pa3); SBAR();
        pv_d0(o, vb0 + bj * SHM_V, pa0, pa1, pa2, pa3);
    }
#undef VMWAIT
    if (hi == 0) li_l[r32] = l_reg; asm volatile("s_waitcnt lgkmcnt(0)" ::: "memory");
    float rli[16];
#pragma unroll
    for (int r = 0; r < 16; ++r) rli[r] = __builtin_amdgcn_rcpf(li_l[crow(r, hi)]);
    bf16* Ow = Ob + (long)(wid * QBLK) * LDO;
#pragma unroll
    for (int r = 0; r < 16; ++r) { const int orow = crow(r, hi);
#pragma unroll
        for (int d0 = 0; d0 < 4; ++d0) Ow[(long)orow * LDO + d0 * 32 + r32] = (bf16)f2bf(o[d0][r] * rli[r]); }
#undef DMA_TILE
#undef RESC
}
}
__device__ __forceinline__ void attn_phase(const int wv_, const bf16* Q, const bf16* K, const bf16* KVRAW, bf16* O, LAS unsigned char* lds, const float* qg, const f32x2* ROPE) {
    const int G = gridDim.x, bx = blockIdx.x; const int vcu = (G % 8 == 0) ? (bx % 8) * (G / 8) + bx / 8 : bx;
    const int units = NBATCH * NH * (SEQ / 256);
    for (int u = vcu; u < units; u += G) {
        const int qb = u % 16, h = (u / 16) % NH, b = u / (16 * NH);
        const size_t row0 = (size_t)b * SEQ;
        attn::unit(wv_, Q + (row0 + qb * 256) * 3072 + h * DQK, K + row0 * 3072 + h * DQK, KVRAW + row0 * 4096 + h * 256 + 128, O + (row0 + qb * 256) * DM + h * DV, SEQ, lds, qg, ROPE, qb * 256);
    }
}

__device__ __forceinline__ void final_phase(const int wv_, float* X, const bf16* ym) {
    const size_t total = (size_t)NTOK * (DM / 4), stride = (size_t)gridDim.x * NTHREADS;
    for (size_t i0 = (size_t)blockIdx.x * NTHREADS + TIDX; i0 < total; i0 += 4 * stride) {
        f32x4 x[4]; u32x2 a[4];
#pragma unroll
        for (int k = 0; k < 4; ++k) { const size_t i = i0 + k * stride; if (i < total) { const size_t row = i / (DM / 4); const int col = (int)(i % (DM / 4)) * 4;
            x[k] = *(const f32x4*)(X + row * DM + col); a[k] = *(const u32x2*)(ym + row * DM + col); } }
#pragma unroll
        for (int k = 0; k < 4; ++k) { const size_t i = i0 + k * stride; if (i < total) { const size_t row = i / (DM / 4); const int col = (int)(i % (DM / 4)) * 4; f32x4 v = x[k];
            v[0] += bflo(a[k].x); v[1] += bfhi(a[k].x); v[2] += bflo(a[k].y); v[3] += bfhi(a[k].y);
            *(f32x4*)(X + row * DM + col) = v; } }
    }
}

struct Args { const float* in[31]; float* out; unsigned char* ws; int ph_lo, ph_hi; };
enum Phase { P_PRO = 0,
    P0_G1, P0_TH, P0_G2, P0_NR, P0_UP, P0_DN,
    P1_G1, P1_T1, P1_LC, P1_T2, P1_G2, P1_NR, P1_UP, P1_DN,
    P2_GD, P2_T1, P2_GU, P2_T2, P2_AT, P2_GO, P2_NR, P2_UP, P2_DN,
    P3_G1, P3_TH, P3_G2, P3_NR, P3_UP, P3_DN,
    N_PHASES };

__device__ __forceinline__ const float* kernarg_ptr(int i) {
    const unsigned long long v = ((volatile const __attribute__((address_space(4))) unsigned long long*)__builtin_amdgcn_kernarg_segment_ptr())[i];
    return (const float*)(const GAS float*)v;
}
#define INP(i) kernarg_ptr(i)
__global__ void __launch_bounds__(NTHREADS, 2) fwd(Args a) {
    extern __shared__ __attribute__((aligned(16))) unsigned char lds_raw[];
    LAS unsigned char* lds = (LAS unsigned char*)lds_raw;
    const int wv_ = __builtin_amdgcn_readfirstlane((int)threadIdx.x >> 6);
    volatile LAS unsigned* MISC = (volatile LAS unsigned*)(lds + MISC_OFF);
    const int tid = TIDX, lane = tid & 63, wid = wv_;
    unsigned char* ws = (unsigned char*)INP(32);
    unsigned* ctl = (unsigned*)(ws + WS_CTL);
    for (int u = tid; u < (LDS_BYTES - SCR_BYTES) / 4; u += NTHREADS) ((LAS unsigned*)(lds + SCR_BYTES))[u] = 0u;
    __syncthreads();
    XcdBarrier bar = xcd_barrier_post(wv_, ctl + CW_BAR, MISC + 8);
    const int lo = a.ph_lo, hi = a.ph_hi;
#ifndef ONLY_PHASE
#define ONLY_PHASE -1
#endif
#define IN(k) ((ONLY_PHASE < 0 || ONLY_PHASE == (k)) && lo <= (k) && (k) < hi)
#define SEAM(k) do { if (IN(k) && IN((k) + 1)) xcd_barrier(wv_, bar); } while (0)
#define x_in INP(0)
#define X ((float*)INP(31))
#define SCIN ((bf16*)(ws + WS_SCIN))
#define SCOUT ((bf16*)(ws + WS_SCOUT))
#define HYIN ((bf16*)(ws + WS_HYIN))
#define HYOUT ((bf16*)(ws + WS_HYOUT))
#define MDOWN ((bf16*)(ws + WS_MDOWN))
#define MUQ ((bf16*)(ws + WS_MUQ))
#define MUKV ((bf16*)(ws + WS_MUKV))
#define MWO ((bf16*)(ws + WS_MWO))
#define MOEUP ((bf16*)(ws + WS_MOEUP))
#define MOEDN ((bf16*)(ws + WS_MOEDN))
#define KERN ((bf16*)(ws + WS_KERN))
#define H ((bf16*)(ws + WS_H))
#define BIG ((bf16*)(ws + WS_BIG))
#define KVRAW ((bf16*)(ws + WS_KVRAW))
#define YB ((bf16*)(ws + WS_YB))
#define X0 ((bf16*)(ws + WS_X0))
#define VT ((bf16*)(ws + WS_VT))
#define YST ((bf16*)(ws + WS_YST))
#define DOWN ((bf16*)(ws + WS_DOWN))
#define CQ ((bf16*)(ws + WS_CQ))
#define CKV ((bf16*)(ws + WS_CKV))
#define QBUF ((bf16*)(ws + WS_Q))
#define KBUF ((bf16*)(ws + WS_K))
#define LIST ((unsigned*)(ws + WS_LIST))
#define GATE ((float*)(ws + WS_GATE))
#define ACT ((bf16*)(ws + WS_ACT))
#define YM ((bf16*)(ws + WS_YM))
#define RSTDB ((float*)(ws + WS_RSTD))
#define WRS ((bf16*)(ws + WS_WRS))
#define ROPEB ((f32x2*)(ws + WS_ROPE))
#define RECB ((u32x4*)(ws + WS_REC))
#define XS H
#define PARTB ((float*)(ws + WS_YM))
#define ACT2 BIG
#define TOKOF ((unsigned*)(ws + WS_ACT))

    if (IN(P_PRO)) {
        LAS float* scr = (LAS float*)(lds + wid * 16384);
        const int gw = blockIdx.x * NWAVES + wid, NGW = gridDim.x * NWAVES;
        cvt_mats<3, true>(INP(3), 2, DM, 3 * DM, 3 * DM, SCIN, scr, gw, NGW, lane, INP(1), 3 * DM);
        cvt_mats<0>(INP(5), 2, DM, DM, DM, SCOUT, scr, gw, NGW, lane);
        cvt_mats<0, true>(INP(6), 1, DM, 3 * DM, 3 * DM, HYIN, scr, gw, NGW, lane, INP(1) + 1 * DM, 0);
        cvt_mats<0>(INP(16), 1, DM, DM, DM, HYOUT, scr, gw, NGW, lane);
        cvt_mats<0, true>(INP(17), 1, DM, NDOWN, NDOWNP, MDOWN, scr, gw, NGW, lane, INP(1) + 2 * DM, 0);
        cvt_mats<0>(INP(20), 1, QRANK, NH * DQK, NH * DQK, MUQ, scr, gw, NGW, lane);
        cvt_mats<0>(INP(21), 1, KVRANK, NH * 256, NH * 256, MUKV, scr, gw, NGW, lane);
        cvt_mats<0>(INP(24), 1, DM, DM, DM, MWO, scr, gw, NGW, lane);
        cvt_mats<2, true>(INP(29), NEXP, DM, 2 * DFF, 2 * DFF, MOEUP, scr, gw, NGW, lane, INP(2), 0);
        cvt_mats<0>(INP(30), NEXP, DFF, DM, DM, MOEDN, scr, gw, NGW, lane);
        for (int i = blockIdx.x * NTHREADS + tid; i < 4 * 48 * DM; i += gridDim.x * NTHREADS) {
            const int d = i % DM, e = (i / DM) % 48, l = i / (DM * 48);
            float w = e < 8 ? INP(25)[((size_t)l * DM + d) * 8 + e] : (e < 40 ? INP(27)[((size_t)l * DM + d) * 32 + (e - 8)] : 0.f);
            w *= INP(2)[l * DM + d];
            const unsigned wh = f2bf(w); const float wr = w - __builtin_bit_cast(float, wh << 16);
            WRS[((size_t)(l * 2 + 0) * 48 + e) * DM + d] = (bf16)wh; WRS[((size_t)(l * 2 + 1) * 48 + e) * DM + d] = (bf16)f2bf(wr);
        }
        for (int i = blockIdx.x * NTHREADS + tid; i < SEQ * 32; i += gridDim.x * NTHREADS) { const int t = i >> 5, ii = i & 31;
            const float inv = exp2f(-(float)(2 * ii) * (13.287712379549449f / 64.0f)); float sn_, cs_; sincosf((float)t * inv, &sn_, &cs_); ROPEB[i] = (f32x2){cs_, sn_}; }
        __syncthreads();
        filter_phase(wv_, INP(9), INP(10), INP(11), INP(12), INP(13), INP(14), KERN, lds);
        __syncthreads();
        x0_phase(wv_, x_in, XS, RSTDB);
    }
    SEAM(P_PRO);

#define MOE_BLOCK(P, L) \
    if (IN(P)) router_phase(wv_, XS, WRS + (size_t)(L) * 2 * 48 * DM, INP(26) + (L) * 8, INP(28) + (L) * 32, ctl + CW_CNT + (L) * 2048, ctl + CW_CNTB + (L) * 4096, LIST, RECB, lds); \
    SEAM(P); \
    if (IN((P) + 1)) moe_up_phase256(wv_, lds, XS, RECB, MOEUP + (size_t)(L) * NEXP * 1024 * DM, ctl + CW_CNT + (L) * 2048, ctl + CW_CNTB + (L) * 4096, LIST, ACT2, TOKOF, \
        (L) < 3 ? INP(29) + (size_t)((L) + 1) * NEXP * DM * 2 * DFF : nullptr, (L) < 3 ? INP(30) + (size_t)((L) + 1) * NEXP * DFF * DM : nullptr, \
        MOEUP + (size_t)((L) + 1) * NEXP * 1024 * DM, MOEDN + (size_t)((L) + 1) * NEXP * DM * DFF, INP(2) + ((L) + 1) * DM); \
    SEAM((P) + 1); \
    if (IN((P) + 2)) moe_down_phase256<((L) < 3)>(wv_, lds, ACT2, MOEDN + (size_t)(L) * NEXP * DM * DFF, ctl + CW_CNT + (L) * 2048, ctl + CW_CNTB + (L) * 4096, TOKOF, XS, X, PARTB); \
    SEAM((P) + 2);

    if (IN(P0_G1)) gemm_dense256<pg8::EpiSC, true>(wv_, lds, XS, SCIN, NTOK, 3 * DM, DM, pg8::EpiSC{BIG, BIG + (size_t)NTOK * DM});
    SEAM(P0_G1);
    if (IN(P0_TH)) sc_thin_phase<true>(wv_, BIG, BIG + (size_t)NTOK * DM, INP(4), YB, RSTDB);
    SEAM(P0_TH);
    if (IN(P0_G2)) gemm_dense256<pg8::EpiRes, true>(wv_, lds, YB, SCOUT, NTOK, DM, DM, pg8::EpiRes{XS, XS});
    SEAM(P0_G2);
    MOE_BLOCK(P0_NR, 0)
    if (IN(P1_G1)) { rstd_prepass(wv_, PARTB, RSTDB); gemm_dense256<pg8::EpiBf16, true>(wv_, lds, XS, HYIN, NTOK, 3 * DM, DM, pg8::EpiBf16{BIG, 3 * DM}); }
    SEAM(P1_G1);
    if (IN(P1_T1)) hy_thin1_phase(wv_, BIG, INP(7), INP(8), X0, VT, lds, RSTDB);
    SEAM(P1_T1);
    if (IN(P1_LC)) longconv_phase(wv_, KERN, VT, INP(15), YST, lds);
    SEAM(P1_LC);
    if (IN(P1_T2)) hy_thin2_phase(wv_, YST, BIG, INP(7), INP(8), RSTDB, YB, lds);
    SEAM(P1_T2);
    if (IN(P1_G2)) gemm_dense256<pg8::EpiRes, true>(wv_, lds, YB, HYOUT, NTOK, DM, DM, pg8::EpiRes{XS, XS});
    SEAM(P1_G2);
    MOE_BLOCK(P1_NR, 1)
    if (IN(P2_GD)) { rstd_prepass(wv_, PARTB, RSTDB); gemm_dense256<pg8::EpiBf16, true>(wv_, lds, XS, MDOWN, NTOK, NDOWNP, DM, pg8::EpiBf16{DOWN, NDOWNP}); }
    SEAM(P2_GD);
    if (IN(P2_T1)) mla_thin1_phase(wv_, DOWN, INP(18), INP(19), CQ, CKV, RSTDB);
    SEAM(P2_T1);
    if (IN(P2_GU)) { gemm_dense256<pg8::EpiBf16, true>(wv_, lds, CQ, MUQ, NTOK, NH * DQK, QRANK, pg8::EpiBf16{BIG, NH * DQK}); gemm_dense256<pg8::EpiBf16, true>(wv_, lds, CKV, MUKV, NTOK, NH * 256, KVRANK, pg8::EpiBf16{KVRAW, NH * 256}); }
    SEAM(P2_GU);
    if (IN(P2_T2)) mla_thin2_phase(wv_, BIG, KVRAW, DOWN, INP(22), INP(23), ROPEB, QBUF, KBUF, RSTDB);
    SEAM(P2_T2);
    if (IN(P2_AT)) attn_phase(wv_, BIG, KBUF, KVRAW, YB, lds, INP(22), ROPEB);
    SEAM(P2_AT);
    if (IN(P2_GO)) gemm_dense256<pg8::EpiRes, true>(wv_, lds, YB, MWO, NTOK, DM, DM, pg8::EpiRes{XS, XS});
    SEAM(P2_GO);
    MOE_BLOCK(P2_NR, 2)
    if (IN(P3_G1)) { rstd_prepass(wv_, PARTB, RSTDB); gemm_dense256<pg8::EpiSC, true>(wv_, lds, XS, SCIN + (size_t)3 * DM * DM, NTOK, 3 * DM, DM, pg8::EpiSC{BIG, BIG + (size_t)NTOK * DM}); }
    SEAM(P3_G1);
    if (IN(P3_TH)) sc_thin_phase<true>(wv_, BIG, BIG + (size_t)NTOK * DM, INP(4) + 3 * DM, YB, RSTDB);
    SEAM(P3_TH);
    if (IN(P3_G2)) gemm_dense256<pg8::EpiRes, true>(wv_, lds, YB, SCOUT + (size_t)DM * DM, NTOK, DM, DM, pg8::EpiRes{XS, XS});
    SEAM(P3_G2);
    MOE_BLOCK(P3_NR, 3)
}

#ifndef N_LAUNCHES
#define N_LAUNCHES 1
#endif
extern "C" void kernel_launch(void* const* d_in, const int* in_sizes, int n_in, void* d_out, int out_size, void* d_ws, size_t ws_size, hipStream_t stream) {
    static int grid = 0;
    if (grid == 0) {
        if (n_in != 31 || out_size != NTOK * DM || ws_size < WS_END) { fprintf(stderr, "kernel_launch: bad shapes n_in %d out %d ws %zu (need %zu)\n", n_in, out_size, ws_size, (size_t)WS_END); grid = -1; return; }
        int dev = 0, cus = 0, per_cu = 0;
        if (hipGetDevice(&dev) != hipSuccess || hipDeviceGetAttribute(&cus, hipDeviceAttributeMultiprocessorCount, dev) != hipSuccess) { grid = -1; return; }
        if (hipFuncSetAttribute((const void*)fwd, hipFuncAttributeMaxDynamicSharedMemorySize, LDS_BYTES) != hipSuccess) { fprintf(stderr, "kernel_launch: hipFuncSetAttribute failed\n"); grid = -1; return; }
        if (hipOccupancyMaxActiveBlocksPerMultiprocessor(&per_cu, (const void*)fwd, NTHREADS, LDS_BYTES) != hipSuccess || per_cu < 1) fprintf(stderr, "kernel_launch: occupancy query says %d\n", per_cu);
        (void)hipGetLastError();
        grid = cus;
    }
    if (grid < 0) return;
    if (hipMemsetAsync((char*)d_ws + WS_CTL, 0, CTL_ZERO_BYTES, stream) != hipSuccess) return;
    Args a{};
    for (int i = 0; i < 31; ++i) a.in[i] = (const float*)d_in[i];
    a.out = (float*)d_out; a.ws = (unsigned char*)d_ws;
#if N_LAUNCHES == 1
    a.ph_lo = 0; a.ph_hi = N_PHASES;
    hipLaunchKernelGGL(fwd, dim3(grid), dim3(NTHREADS), LDS_BYTES, stream, a);
#else
    for (int p = 0; p < N_PHASES; ++p) { a.ph_lo = p; a.ph_hi = p + 1; hipLaunchKernelGGL(fwd, dim3(grid), dim3(NTHREADS), LDS_BYTES, stream, a); }
#endif
#ifdef PROBE_LO
    hipMemsetAsync((char*)d_ws + WS_CTL + CW_BAR * 4, 0, XCD_BAR_WORDS * 4, stream);
    a.ph_lo = PROBE_LO; a.ph_hi = PROBE_HI;
    hipLaunchKernelGGL(fwd, dim3(grid), dim3(NTHREADS), LDS_BYTES, stream, a);
#endif
    const hipError_t le = hipPeekAtLastError();
    if (le != hipSuccess) fprintf(stderr, "kernel_launch: launch failed: %s\n", hipGetErrorName(le));
}
```

```cpp
#include <hip/hip_runtime.h>
#include <cstdio>
#include <cstdint>

#define LAS __attribute__((address_space(3)))
#define GAS __attribute__((address_space(1)))
typedef unsigned short bf16;
typedef short bf16x8 __attribute__((ext_vector_type(8)));
typedef short s16x4 __attribute__((ext_vector_type(4)));
typedef float f32x4 __attribute__((ext_vector_type(4)));
typedef float f32x2 __attribute__((ext_vector_type(2)));
typedef float f32x16 __attribute__((ext_vector_type(16)));
typedef unsigned u32x4 __attribute__((ext_vector_type(4)));
typedef unsigned u32x2 __attribute__((ext_vector_type(2)));

constexpr int NTOK = 32768, DM = 2048, SEQ = 4096, NBATCH = 8;
constexpr int NH = 16, DQK = 192, DNOPE = 128, DROPE = 64, DV = 128, QRANK = 512, KVRANK = 512, NDOWN = 1088, NDOWNP = 1280;
constexpr int NEXP = 32, NGRP = 8, EPG = 4, DFF = 512;
constexpr int NTHREADS = 512, NWAVES = 8;
constexpr float EPS = 1e-6f;

constexpr size_t MiB = 1u << 20;
constexpr size_t WS_CTL = 0, CTL_ZERO_BYTES = 1 * MiB;
constexpr size_t WS_SCIN = 4 * MiB;
constexpr size_t WS_SCOUT = 52 * MiB;
constexpr size_t WS_HYIN = 68 * MiB;
constexpr size_t WS_HYOUT = 92 * MiB;
constexpr size_t WS_MDOWN = 100 * MiB;
constexpr size_t WS_MUQ = 106 * MiB;
constexpr size_t WS_MUKV = 109 * MiB;
constexpr size_t WS_MWO = 113 * MiB;
constexpr size_t WS_MOEUP = 128 * MiB;
constexpr size_t WS_MOEDN = 640 * MiB;
constexpr size_t WS_KERN = 896 * MiB;
constexpr size_t WS_H = 960 * MiB;
constexpr size_t WS_BIG = 1088 * MiB;
constexpr size_t WS_KVRAW = WS_BIG + 192 * MiB;
constexpr size_t WS_YB = 1600 * MiB;
constexpr size_t WS_X0 = 1728 * MiB;
constexpr size_t WS_VT = 1856 * MiB;
constexpr size_t WS_YST = 1984 * MiB;
constexpr size_t WS_DOWN = 2112 * MiB;
constexpr size_t WS_CQ = 2272 * MiB;
constexpr size_t WS_CKV = 2304 * MiB;
constexpr size_t WS_Q = 2336 * MiB;
constexpr size_t WS_K = 2528 * MiB;
constexpr size_t WS_LIST = 2720 * MiB;
constexpr size_t WS_GATE = 3064 * MiB;
constexpr size_t WS_ACT = 2726 * MiB;
constexpr size_t WS_YM = 2800 * MiB;
constexpr size_t WS_RSTD = 3068 * MiB;
constexpr size_t WS_WRS = 3058 * MiB;
constexpr size_t WS_ROPE = 3062 * MiB;
constexpr size_t WS_REC = 3072 * MiB;
constexpr size_t WS_END = 3092 * MiB;
constexpr int CW_CNT = 8192;
constexpr int CW_CNTB = 16384;
constexpr int CW_BAR = 4096;

constexpr int SCR_BYTES = 131072;
constexpr int MISC_OFF = SCR_BYTES + 320;
constexpr int LDS_BYTES = 147456;

__device__ __forceinline__ unsigned f2bf(float f) { unsigned u = __builtin_bit_cast(unsigned, f); return (u + 0x7fffu + ((u >> 16) & 1u)) >> 16; }
__device__ __forceinline__ unsigned pk2(float lo, float hi) { unsigned r; asm("v_cvt_pk_bf16_f32 %0, %1, %2" : "=v"(r) : "v"(lo), "v"(hi)); return r; }
__device__ __forceinline__ float bf2f(unsigned short b) { return __builtin_bit_cast(float, ((unsigned)b) << 16); }
__device__ __forceinline__ float bflo(unsigned w) { return __builtin_bit_cast(float, w << 16); }
__device__ __forceinline__ float bfhi(unsigned w) { return __builtin_bit_cast(float, w & 0xffff0000u); }
__device__ __forceinline__ int opaque_i(int x) { asm volatile("" : "+v"(x)); return x; }
__device__ __forceinline__ int lane_mb() { int l; asm volatile("v_mbcnt_lo_u32_b32 %0, -1, 0\n\tv_mbcnt_hi_u32_b32 %0, -1, %0" : "=v"(l)); return l; }
#define TIDX opaque_i((wv_ << 6) | lane_mb())
__device__ __forceinline__ float wave_sum(float v) {
#pragma unroll
    for (int o = 1; o < 64; o <<= 1) v += __shfl_xor(v, o);
    return v;
}
__device__ __forceinline__ int crow(int r, int hi) { return (r & 3) + 8 * (r >> 2) + 4 * hi; }

#define XB_TMO      128
#define XB_XCNT(j)  (256  + 64 * (j))
#define XB_XSUB(j)  (1280 + 64 * (j))
#define XB_XGEN(j)  (2304 + 64 * (j))
#define XB_TOP      3328
#define XB_TOPGEN   3392
#define XCD_BAR_WORDS 3456
#define XB_SPIN_CAP (1u << 22)
__device__ __forceinline__ unsigned xb_ld(unsigned* p)              { return __hip_atomic_load(p, __ATOMIC_RELAXED, __HIP_MEMORY_SCOPE_AGENT); }
__device__ __forceinline__ unsigned xb_add(unsigned* p, unsigned v) { return __hip_atomic_fetch_add(p, v, __ATOMIC_RELAXED, __HIP_MEMORY_SCOPE_AGENT); }
__device__ __forceinline__ unsigned xb_xcc_id() { return (unsigned)__builtin_amdgcn_s_getreg((3 << 11) | 20) & 0xFu; }
#define XB_SPIN(cond, bar) do { unsigned _sp = 0; while (cond) { __builtin_amdgcn_s_sleep(1); \
    if ((++_sp & 255u) == 0u) { if (xb_ld(&(bar)[XB_TMO])) break; if (_sp > XB_SPIN_CAP) { atomicAdd(&(bar)[XB_TMO], 1u); break; } } } } while (0)
struct XcdBarrier { unsigned* bar; unsigned x; volatile LAS unsigned* st; };
__device__ __forceinline__ XcdBarrier xcd_barrier_post(const int wv_, unsigned* bar, volatile LAS unsigned* st) {
    XcdBarrier b; b.bar = bar; b.x = xb_xcc_id(); b.st = st;
    if (TIDX == 0) (void)xb_add(&bar[XB_XCNT(b.x)], 1u);
    return b;
}
__device__ __forceinline__ void xcd_barrier_complete(unsigned* bar, unsigned x, unsigned& nloc, unsigned& nx) {
    const unsigned G = gridDim.x * gridDim.y * gridDim.z;
    unsigned sum, cnt, mine, sp = 0u;
    for (;;) {
        sum = 0u; cnt = 0u; mine = 0u;
#pragma unroll
        for (unsigned j = 0; j < 16; ++j) { const unsigned c = xb_ld(&bar[XB_XCNT(j)]); sum += c; cnt += (c > 0u) ? 1u : 0u; mine = (j == x) ? c : mine; }
        if (sum == G) break;
        __builtin_amdgcn_s_sleep(1);
        if ((++sp & 255u) == 0u) { if (xb_ld(&bar[XB_TMO])) break; if (sp > XB_SPIN_CAP) { atomicAdd(&bar[XB_TMO], 1u); break; } }
    }
    nloc = mine > 0u ? mine : 1u; nx = cnt > 0u ? cnt : 1u;
}
__device__ __forceinline__ void xcd_barrier(const int wv_, const XcdBarrier& b) {
    asm volatile("s_waitcnt vmcnt(0)" ::: "memory");
    __syncthreads();
    if (TIDX == 0) {
        unsigned* bar = b.bar;
        __builtin_amdgcn_s_waitcnt(0);
        unsigned nloc = b.st[0], nx = b.st[1];
        if (nloc == 0u) { xcd_barrier_complete(bar, b.x, nloc, nx); b.st[0] = nloc; b.st[1] = nx; }
        const unsigned old = xb_add(&bar[XB_XSUB(b.x)], 1u);
        const unsigned gen = old / nloc;
        if (old + 1u == (gen + 1u) * nloc) {
            __builtin_amdgcn_fence(__ATOMIC_RELEASE, "agent");
            asm volatile("s_waitcnt vmcnt(0)" ::: "memory");
            const unsigned og = xb_add(&bar[XB_TOP], 1u);
            const unsigned tg = og / nx;
            if (og + 1u == (tg + 1u) * nx) xb_add(&bar[XB_TOPGEN], 1u);
            else XB_SPIN(xb_ld(&bar[XB_TOPGEN]) == tg, bar);
            __builtin_amdgcn_fence(__ATOMIC_ACQUIRE, "agent");
            xb_add(&bar[XB_XGEN(b.x)], 1u);
            asm volatile("s_waitcnt vmcnt(0)" ::: "memory");
        } else {
            XB_SPIN(xb_ld(&bar[XB_XGEN(b.x)]) == gen, bar);
            __builtin_amdgcn_fence(__ATOMIC_ACQUIRE, "agent");
            asm volatile("s_waitcnt vmcnt(0)" ::: "memory");
        }
    }
    __syncthreads();
}

template <int MODE, bool GAIN = false>
__device__ __forceinline__ void cvt_mats(const float* W, int nmat, int K, int N, int NP, bf16* WT, LAS float* scr, int gw, int NGW, int lane, const float* gain = nullptr, int gms = 0) {
    const int nkb = K / 64, nnb = NP / 32, per = nkb * nnb; const long total = (long)nmat * per;
    f32x4 va[8], vb[8], vc[8]; size_t da = 0, db = 0, dc = 0; float ga[8], gb[8], gc[8];
#define CV_ISSUE(v_, d_, g_, it_) do { const long itx = (it_); if (itx < total) { \
        const int m = (int)(itx / per), r = (int)(itx % per), kb = r / nnb, nb = r % nnb, n0d = nb * 32; int n0s; \
        if (MODE == 2) { const int pn = n0d / 256, bj = (n0d / 128) & 1, i = n0d % 128; n0s = bj * 512 + 128 * pn + i; } \
        else if (MODE == 3) { if (n0d < DM) n0s = n0d; else { const int q = (n0d - DM) / 256, bj = ((n0d - DM) / 128) & 1, i = n0d % 128; n0s = DM + bj * DM + 128 * q + i; } } \
        else n0s = n0d < N ? n0d : -1; \
        d_ = (size_t)m * NP * K + (size_t)n0d * K + kb * 64; \
        if constexpr (GAIN) { _Pragma("unroll") for (int i = 0; i < 8; ++i) g_[i] = gain[m * gms + kb * 64 + (lane >> 3) + 8 * i]; } \
        if (n0s >= 0) { const float* src = W + (size_t)m * K * N + (size_t)(kb * 64 + (lane >> 3)) * N + n0s + (lane & 7) * 4; \
            _Pragma("unroll") for (int i = 0; i < 8; ++i) v_[i] = *(const f32x4*)(src + (size_t)(8 * i) * N); } \
        else { _Pragma("unroll") for (int i = 0; i < 8; ++i) v_[i] = (f32x4){0.f, 0.f, 0.f, 0.f}; } } } while (0)
#define CV_PROC(v_, d_, g_) do { \
        _Pragma("unroll") for (int i = 0; i < 8; ++i) { LAS float* d = scr + ((lane >> 3) + 8 * i) * 33 + (lane & 7) * 4; const f32x4 vv = GAIN ? v_[i] * g_[i] : v_[i]; d[0] = vv[0]; d[1] = vv[1]; d[2] = vv[2]; d[3] = vv[3]; } \
        asm volatile("s_waitcnt lgkmcnt(0)" ::: "memory"); \
        const int c = lane & 7; \
        _Pragma("unroll") for (int j = 0; j < 4; ++j) { const int n = (lane >> 3) + 8 * j; const LAS float* sp = scr + (8 * c) * 33 + n; \
            u32x4 o; o.x = pk2(sp[0 * 33], sp[1 * 33]); o.y = pk2(sp[2 * 33], sp[3 * 33]); o.z = pk2(sp[4 * 33], sp[5 * 33]); o.w = pk2(sp[6 * 33], sp[7 * 33]); \
            *(u32x4*)(WT + (d_) + (size_t)n * K + 8 * c) = o; } \
        asm volatile("s_waitcnt lgkmcnt(0)" ::: "memory"); } while (0)
    long it = gw;
    CV_ISSUE(va, da, ga, it); CV_ISSUE(vb, db, gb, it + NGW); CV_ISSUE(vc, dc, gc, it + 2L * NGW);
    while (it < total) {
        CV_PROC(va, da, ga); CV_ISSUE(va, da, ga, it + 3L * NGW);
        if (it + NGW < total) { CV_PROC(vb, db, gb); CV_ISSUE(vb, db, gb, it + 4L * NGW); }
        if (it + 2L * NGW < total) { CV_PROC(vc, dc, gc); CV_ISSUE(vc, dc, gc, it + 5L * NGW); }
        it += 3L * NGW;
    }
#undef CV_ISSUE
#undef CV_PROC
}

__device__ __forceinline__ void filter_phase(const int wv_, const float* w1, const float* b1, const float* whid, const float* bhid, const float* freq, const float* wout, bf16* KRB, LAS unsigned char* lds) {
    LAS float* z = (LAS float*)lds;
    LAS float* ha = z + 16 * 33;
    LAS float* hb = ha + 16 * 64;
    LAS float* hc = hb + 16 * 64;
    const int tid = TIDX;
    for (int pb = blockIdx.x; pb < SEQ / 16; pb += gridDim.x) {
        const int l0 = pb * 16;
        __syncthreads();
        for (int i = tid; i < 16 * 33; i += NTHREADS) {
            const int p = i / 33, f = i % 33, l = l0 + p; float v;
            if (f == 0) v = (float)l / (float)(SEQ - 1);
            else { const int j = (f - 1) & 15; const float band = 1e-4f + (float)j * ((15.0f - 1e-4f) / 15.0f); const float w = 6.283185307179586f * (float)l / (float)SEQ; const float a = band * w;
                v = (f <= 16) ? cosf(a) : -sinf(a); }
            z[i] = v;
        }
        __syncthreads();
        for (int i = tid; i < 16 * 64; i += NTHREADS) { const int p = i >> 6, j = i & 63; float s = b1[j];
            for (int k = 0; k < 33; ++k) s += z[p * 33 + k] * w1[k * 64 + j];
            ha[i] = sinf(freq[j] * s); }
        __syncthreads();
        for (int i = tid; i < 16 * 64; i += NTHREADS) { const int p = i >> 6, j = i & 63; float s = bhid[j];
            for (int k = 0; k < 64; ++k) s += ha[p * 64 + k] * whid[k * 64 + j];
            hb[i] = sinf(freq[64 + j] * s); }
        __syncthreads();
        for (int i = tid; i < 16 * 64; i += NTHREADS) { const int p = i >> 6, j = i & 63; float s = bhid[64 + j];
            for (int k = 0; k < 64; ++k) s += hb[p * 64 + k] * whid[4096 + k * 64 + j];
            hc[j * 16 + p] = sinf(freq[128 + j] * s); }
        __syncthreads();
#pragma unroll 1
        for (int qh = 0; qh < 2; ++qh) {
        float acc[4][16];
#pragma unroll
        for (int q = 0; q < 4; ++q)
#pragma unroll
            for (int p = 0; p < 16; ++p) acc[q][p] = 0.f;
#pragma unroll 1
        for (int k0 = 0; k0 < 64; k0 += 2) { float w[2][4];
#pragma unroll
            for (int kk = 0; kk < 2; ++kk)
#pragma unroll
                for (int q = 0; q < 4; ++q) w[kk][q] = wout[(size_t)(k0 + kk) * 4096 + tid + NTHREADS * (qh * 4 + q)];
#pragma unroll
            for (int kk = 0; kk < 2; ++kk) { const LAS f32x4* hp = (const LAS f32x4*)(hc + (k0 + kk) * 16); const f32x4 h0 = hp[0], h1 = hp[1], h2 = hp[2], h3 = hp[3];
#pragma unroll
                for (int q = 0; q < 4; ++q) { const float wv = w[kk][q];
#pragma unroll
                    for (int p = 0; p < 4; ++p) { acc[q][p] += h0[p] * wv; acc[q][4 + p] += h1[p] * wv; acc[q][8 + p] += h2[p] * wv; acc[q][12 + p] += h3[p] * wv; } } } }
        LAS bf16* T = (LAS bf16*)(lds + 16384);
        __syncthreads();
#pragma unroll
        for (int q = 0; q < 4; ++q) {
            const int c = tid + NTHREADS * (qh * 4 + q), d = c & (DM - 1);
            const float mind = -3.0701134573253946f, maxd = -15.350567286626973f;
            const float delta = fabsf(mind + (float)d * ((maxd - mind) / (float)(DM - 1)));
            unsigned pk[8];
#pragma unroll
            for (int p = 0; p < 16; p += 2) { const float t0 = (float)(l0 + p) / (float)(SEQ - 1), t1 = (float)(l0 + p + 1) / (float)(SEQ - 1);
                pk[p >> 1] = f2bf(acc[q][p] * expf(-t0 * delta)) | (f2bf(acc[q][p + 1] * expf(-t1 * delta)) << 16); }
            *(LAS u32x4*)(T + (size_t)d * 16) = (u32x4){pk[0], pk[1], pk[2], pk[3]}; *(LAS u32x4*)(T + (size_t)d * 16 + 8) = (u32x4){pk[4], pk[5], pk[6], pk[7]};
        }
        __syncthreads();
        { const bool bwd = qh == 1;
            for (int e = tid; e < DM * 16; e += NTHREADS) { const int d = e >> 4, p = e & 15, l = l0 + p; const bf16 hv = T[e];
                const int m = bwd ? 4095 + l : 4095 - l;
                if (!bwd || l > 0) KRB[(size_t)d * 8192 + m] = hv; } }
        }
    }
}

template <bool COMBINE>
__device__ __forceinline__ void norm_phase(const int wv_, const float* xin, float* xout, const bf16* ym, const float* g, bf16* H) {
    const int tid = TIDX, lane = tid & 63, wid = wv_;
    constexpr int NR = 4;
    for (int rg = blockIdx.x * NWAVES + wid; rg < NTOK / NR; rg += gridDim.x * NWAVES) {
        f32x4 v[NR][8]; float rstd[NR];
#pragma unroll
        for (int r = 0; r < NR; ++r) { const size_t row = (size_t)rg * NR + r; float ss = 0.f;
#pragma unroll
            for (int j = 0; j < 8; ++j) { const int col = j * 256 + lane * 4; f32x4 x = *(const f32x4*)(xin + row * DM + col);
                if (COMBINE) { const u32x2 a = *(const u32x2*)(ym + row * DM + col);
                    x[0] += bflo(a.x); x[1] += bfhi(a.x); x[2] += bflo(a.y); x[3] += bfhi(a.y);
                    *(f32x4*)(xout + row * DM + col) = x; }
                v[r][j] = x; ss += x[0] * x[0] + x[1] * x[1] + x[2] * x[2] + x[3] * x[3]; }
            ss = wave_sum(ss); rstd[r] = 1.0f / sqrtf(ss * (1.0f / DM) + EPS); }
#pragma unroll
        for (int j = 0; j < 8; ++j) { const int col = j * 256 + lane * 4; const f32x4 gv = *(const f32x4*)(g + col);
#pragma unroll
            for (int r = 0; r < NR; ++r) { const size_t row = (size_t)rg * NR + r; const f32x4 x = v[r][j] * rstd[r] * gv;
                u32x2 o; o.x = pk2(x[0], x[1]); o.y = pk2(x[2], x[3]); *(u32x2*)(H + row * DM + col) = o; } }
    }
}

__device__ __forceinline__ void x0_phase(const int wv_, const float* xin, bf16* XBo, float* RSTD) {
    const int tid = TIDX, lane = tid & 63, wid = wv_;
    constexpr int NR = 4;
    for (int rg = blockIdx.x * NWAVES + wid; rg < NTOK / NR; rg += gridDim.x * NWAVES) {
        f32x4 v[NR][8];
#pragma unroll
        for (int r = 0; r < NR; ++r) { const size_t row = (size_t)rg * NR + r;
#pragma unroll
            for (int j = 0; j < 8; ++j) v[r][j] = *(const f32x4*)(xin + row * DM + j * 256 + lane * 4); }
#pragma unroll
        for (int r = 0; r < NR; ++r) { const size_t row = (size_t)rg * NR + r; float ss = 0.f;
#pragma unroll
            for (int j = 0; j < 8; ++j) { const f32x4 x = v[r][j]; ss += x[0] * x[0] + x[1] * x[1] + x[2] * x[2] + x[3] * x[3];
                u32x2 o; o.x = pk2(x[0], x[1]); o.y = pk2(x[2], x[3]); *(u32x2*)(XBo + row * DM + j * 256 + lane * 4) = o; }
            ss = wave_sum(ss); if (lane == 0) RSTD[row] = 1.0f / sqrtf(ss * (1.0f / DM) + EPS); }
    }
}

constexpr int RT_BUF = 96 * 512, RT_LSCR = 2 * RT_BUF;
__device__ __forceinline__ unsigned cvtpk_(float lo, float hi) { unsigned r; asm volatile("v_cvt_pk_bf16_f32 %0, %1, %2" : "=v"(r) : "v"(lo), "v"(hi)); return r; }
__device__ __forceinline__ void router_phase(const int wv_, const bf16* X, const bf16* WTs, const float* bg, const float* be,
                                             unsigned* cnt, unsigned* cntB, unsigned* list, u32x4* rec, LAS unsigned char* lds) {
    const int tid = TIDX, lane = tid & 63, wid = wv_, i16 = lane & 15, kq = lane >> 4;
    LAS float* lscr = (LAS float*)lds + wid * (16 * 48);
    LAS unsigned* lcnt = (LAS unsigned*)(lds + RT_LSCR + 8192); LAS unsigned* lbase = lcnt + 32; LAS unsigned* lcntB = lcnt + 64; LAS unsigned* lbaseB = lcnt + 128;
    if (tid < 32) lcnt[tid] = 0u;
    if (tid < 48) lcntB[tid] = 0u;
    const unsigned voffW = (unsigned)(((2 * wid + (lane >> 5)) * DM + (((lane & 31) ^ ((2 * wid + (lane >> 5)) & 7)) * 8)) * 2);
    const int s7 = i16 & 7, d64 = (s7 & 4) ? 64 : 0, rb0 = i16 * 512 + 16 * (kq ^ (s7 & 3)), rbE = rb0 + d64, rbO = rb0 - d64;
    for (int it = blockIdx.x; it < NTOK / 128; it += gridDim.x) {
        const size_t row = (size_t)it * 128 + wid * 16 + i16;
        const bf16* xp = X + row * DM + 8 * kq;
        f32x4 acc[3]; float ss = 0.f;
#pragma unroll
        for (int n = 0; n < 3; ++n) acc[n] = (f32x4){0.f, 0.f, 0.f, 0.f};
        u32x4 xa[4], xb[4];
#define RT_LOADX(dst, c, h) do { _Pragma("unroll") for (int ks = 0; ks < 4; ++ks) dst[ks] = *(const GAS u32x4*)(xpc + (c) * 256 + ((h) * 4 + ks) * 32); } while (0)
#define RT_DMAW(c, buf) do { _Pragma("unroll") for (int i = 0; i < 6; ++i) \
        __builtin_amdgcn_global_load_lds((const unsigned*)(wpc + (size_t)(c) * 512 + (size_t)i * 16 * DM * 2), (LAS unsigned*)(lds + (buf) * RT_BUF + (i * 8 + wid) * 1024), 16, 0, 0); asm volatile("" ::: "memory"); } while (0)
#define RT_COMPUTE(xr, c, h, buf) do { _Pragma("unroll") for (int ks4 = 0; ks4 < 4; ++ks4) { const int ks = (h) * 4 + ks4; const u32x4 xh = xr[ks4]; \
            { const float q0 = bflo(xh.x), q1 = bfhi(xh.x), q2 = bflo(xh.y), q3 = bfhi(xh.y), q4 = bflo(xh.z), q5 = bfhi(xh.z), q6 = bflo(xh.w), q7 = bfhi(xh.w); \
              ss += q0 * q0 + q1 * q1 + q2 * q2 + q3 * q3 + q4 * q4 + q5 * q5 + q6 * q6 + q7 * q7; } \
            const bf16x8 ah = __builtin_bit_cast(bf16x8, xh); \
            _Pragma("unroll") for (int n = 0; n < 3; ++n) { const LAS unsigned char* wp = lds + (buf) * RT_BUF + n * 16 * 512 + ((ks & 1) ? rbO : rbE) + 64 * ks; \
                const bf16x8 bh = *(const LAS bf16x8*)wp, bl = *(const LAS bf16x8*)(wp + 48 * 512); \
                acc[n] = __builtin_amdgcn_mfma_f32_16x16x32_bf16(bh, ah, acc[n], 0, 0, 0); \
                acc[n] = __builtin_amdgcn_mfma_f32_16x16x32_bf16(bl, ah, acc[n], 0, 0, 0); } __builtin_amdgcn_sched_barrier(0); } } while (0)
        const GAS bf16* xpc = (const GAS bf16*)xp; const char* wpc = (const char*)WTs + voffW;
        __syncthreads();
        RT_DMAW(0, 0); RT_LOADX(xa, 0, 0); RT_LOADX(xb, 0, 1);
        for (int c = 0; c < 8; c += 2) {
            asm volatile("s_waitcnt vmcnt(4)" ::: "memory"); __syncthreads();
            RT_DMAW(1, 1);
            RT_COMPUTE(xa, 0, 0, 0); RT_LOADX(xa, 1, 0);
            RT_COMPUTE(xb, 0, 1, 0); RT_LOADX(xb, 1, 1);
            asm volatile("s_waitcnt vmcnt(4)" ::: "memory"); __syncthreads();
            if (c + 2 < 8) RT_DMAW(2, 0);
            RT_COMPUTE(xa, 1, 0, 1); if (c + 2 < 8) RT_LOADX(xa, 2, 0);
            RT_COMPUTE(xb, 1, 1, 1); if (c + 2 < 8) RT_LOADX(xb, 2, 1);
            xpc += 512; wpc += 1024;
            asm volatile("" : "+v"(xpc));
        }
#undef RT_LOADX
#undef RT_DMAW
#undef RT_COMPUTE
        ss += __shfl_xor(ss, 16); ss += __shfl_xor(ss, 32);
        const float rstd = 1.0f / sqrtf(ss * (1.0f / DM) + EPS);
#pragma unroll
        for (int n = 0; n < 3; ++n)
#pragma unroll
            for (int j = 0; j < 4; ++j) lscr[i16 * 48 + n * 16 + kq * 4 + j] = acc[n][j] * rstd;
        asm volatile("s_waitcnt lgkmcnt(0)" ::: "memory");
        unsigned e1 = 0, e2 = 0, l1 = 0, l2 = 0, bk = 0, lB = 0, h1 = 0; float g1 = 0.f, g2 = 0.f;
        if (lane < 16) { const LAS float* lg = lscr + lane * 48;
            int gs = 0; float gl_[8]; gl_[0] = lg[0] + bg[0]; float gm = gl_[0];
            for (int j = 1; j < 8; ++j) { gl_[j] = lg[j] + bg[j]; if (gl_[j] > gm) { gm = gl_[j]; gs = j; } }
            float den = 0.f; for (int j = 0; j < 8; ++j) den += expf(gl_[j] - gm);
            const float gp = 1.0f / den;
            float el[4]; for (int i = 0; i < 4; ++i) el[i] = lg[8 + gs * 4 + i] + be[gs * 4 + i];
            int i1 = 0; for (int i = 1; i < 4; ++i) if (el[i] > el[i1]) i1 = i;
            int i2 = (i1 == 0) ? 1 : 0; for (int i = 0; i < 4; ++i) if (i != i1 && el[i] > el[i2]) i2 = i;
            const float ex = expf(el[i2] - el[i1]); const float p1 = 1.0f / (1.0f + ex), p2 = ex / (1.0f + ex);
            e1 = gs * 4 + i1; e2 = gs * 4 + i2; g1 = gp * p1; g2 = gp * p2;
            const int lo = i1 < i2 ? i1 : i2, hi = i1 < i2 ? i2 : i1, pidx = lo == 0 ? hi - 1 : (lo == 1 ? hi + 1 : 5);
            bk = gs * 6 + pidx; h1 = (i1 == hi) ? 1u : 0u;
            l1 = __hip_atomic_fetch_add(lcnt + e1, 1u, __ATOMIC_RELAXED, __HIP_MEMORY_SCOPE_WORKGROUP);
            l2 = __hip_atomic_fetch_add(lcnt + e2, 1u, __ATOMIC_RELAXED, __HIP_MEMORY_SCOPE_WORKGROUP);
            lB = __hip_atomic_fetch_add(lcntB + bk, 1u, __ATOMIC_RELAXED, __HIP_MEMORY_SCOPE_WORKGROUP); }
        __syncthreads();
        if (tid < 32) { const unsigned c = lcnt[tid]; lbase[tid] = c ? __hip_atomic_fetch_add(cnt + tid * 64, c, __ATOMIC_RELAXED, __HIP_MEMORY_SCOPE_AGENT) : 0u; }
        else if (tid >= 64 && tid < 112) { const unsigned b = tid - 64, c = lcntB[b]; lbaseB[b] = c ? __hip_atomic_fetch_add(cntB + b * 64, c, __ATOMIC_RELAXED, __HIP_MEMORY_SCOPE_AGENT) : 0u; }
        __syncthreads();
        if (lane < 16) { const unsigned r = (unsigned)row; const size_t o1 = (size_t)e1 * NTOK + lbase[e1] + l1, o2 = (size_t)e2 * NTOK + lbase[e2] + l2;
            const unsigned slot = lbaseB[bk] + lB, c1 = (bk << 20) | (h1 << 19) | slot, c2 = (bk << 20) | ((1u - h1) << 19) | slot;
            list[o1] = r; list[o2] = r; const unsigned rb = __float_as_uint(rstd);
            rec[o1] = (u32x4){rb, __float_as_uint(g1), c1, r}; rec[o2] = (u32x4){rb, __float_as_uint(g2), c2, r}; }
        __syncthreads();
        if (tid < 32) lcnt[tid] = 0u;
        if (tid < 48) lcntB[tid] = 0u;
        asm volatile("s_waitcnt vmcnt(0) lgkmcnt(0)" ::: "memory");
    }
}


namespace pg8 {
constexpr int BM = 256, BK = 64, HALF = 128, HTB = HALF * BK * 2, STAGE_BYTES = 8 * HTB, NXCD = 8, WGM = 8;
__host__ __device__ __forceinline__ int lds_byte(int r, int c) { const int st = (r >> 4) * 2 + (c >> 5), rr = r & 15, cc = c & 31, ob = rr * 64 + cc * 2; return st * 1024 + (ob ^ (((ob >> 9) & 1) << 5)); }
__host__ __device__ __forceinline__ void stage_rc(int b, int& R, int& C) { const int st = b / 1024, sb = b % 1024, swz = sb ^ (((sb >> 9) & 1) << 5); R = (st >> 1) * 16 + swz / 64; C = (st & 1) * 32 + (swz % 64) / 2; }
__host__ __device__ __forceinline__ int perm32(int rho) { const int n = rho >> 4, i = rho & 15; return 8 * (i >> 2) + 4 * n + (i & 3); }
struct Unit { int pm, pn, e, r0, rows; };
__device__ __forceinline__ unsigned cvt_pk_bf16(float lo, float hi) { unsigned r; asm volatile("v_cvt_pk_bf16_f32 %0, %1, %2" : "=v"(r) : "v"(lo), "v"(hi)); return r; }

__device__ __forceinline__ void tile_of(int wgid, int nM, int nN, int& pm, int& pn) {
    const int nwg = nM * nN; { const int q = nwg / NXCD, r = nwg % NXCD, xcd = wgid % NXCD, off = wgid / NXCD; wgid = (xcd < r ? xcd * (q + 1) : r * (q + 1) + (xcd - r) * q) + off; }
    const int nig = WGM * nN, gid = wgid / nig, fm = gid * WGM, gsz = (nM - fm) < WGM ? (nM - fm) : WGM;
    pm = fm + ((wgid % nig) % gsz); pn = (wgid % nig) / gsz;
}
struct DenseOrder { static constexpr bool GATHER = false, SPLITB = false;
    const bf16* A; const bf16* Bt; int K, nM, nN, G, c;
    __device__ __forceinline__ void init(const bf16* A_, const bf16* Bt_, int M, int N, int K_) { A = A_; Bt = Bt_; K = K_; nM = M / BM; nN = N / BM; G = gridDim.x; c = blockIdx.x; }
    __device__ __forceinline__ bool next(int i, Unit& u) const { const long L = (long)i * G + c; if (L >= (long)nM * nN) return false; tile_of((int)L, nM, nN, u.pm, u.pn); u.e = 0; u.r0 = 0; u.rows = BM; return true; }
    __device__ __forceinline__ const char* abase(const Unit& u) const { return (const char*)A + (size_t)u.pm * BM * K * 2; }
    __device__ __forceinline__ const char* bbase(const Unit& u) const { return (const char*)Bt + (size_t)u.pn * BM * K * 2; }
    __device__ __forceinline__ int kb() const { return K; }
    __device__ __forceinline__ const char* bbase2(const Unit& u) const { return bbase(u) + K; }
    __device__ __forceinline__ void a_offs(const Unit&, unsigned (&vo)[2][2], const int (&R)[2], const int (&C)[2]) const {
#pragma unroll
        for (int h = 0; h < 2; ++h)
#pragma unroll
            for (int i = 0; i < 2; ++i) vo[h][i] = (unsigned)((R[i] + HALF * h) * K + C[i]) * 2u; }
};
struct MoeOrder { static constexpr bool GATHER = false, SPLITB = false;
    const bf16* A; const bf16* Bt; int K, N, nN, G, c; const LAS int* tstart; const LAS int* cnts;
    __device__ __forceinline__ void init(const bf16* A_, const bf16* Bt_, int N_, int K_, const LAS int* ts, const LAS int* cn) { A = A_; Bt = Bt_; K = K_; N = N_; nN = N_ / BM; G = gridDim.x; c = blockIdx.x; tstart = ts; cnts = cn; }
    __device__ __forceinline__ bool next(int i, Unit& u) const { const int nM = tstart[32]; const long L = (long)i * G + c; if (L >= (long)nM * nN) return false; tile_of((int)L, nM, nN, u.pm, u.pn);
        const int e = tstart[128 + u.pm]; u.e = e; u.r0 = (u.pm - tstart[e]) * BM; const int left = cnts[e] - u.r0; u.rows = left < BM ? left : BM; return true; }
    __device__ __forceinline__ const char* abase(const Unit& u) const { return (const char*)A + (size_t)u.pm * BM * K * 2; }
    __device__ __forceinline__ const char* bbase(const Unit& u) const { return (const char*)Bt + ((size_t)u.e * N + (size_t)u.pn * BM) * K * 2; }
    __device__ __forceinline__ int kb() const { return K; }
    __device__ __forceinline__ const char* bbase2(const Unit& u) const { return bbase(u) + K; }
    __device__ __forceinline__ void a_offs(const Unit&, unsigned (&vo)[2][2], const int (&R)[2], const int (&C)[2]) const {
#pragma unroll
        for (int h = 0; h < 2; ++h)
#pragma unroll
            for (int i = 0; i < 2; ++i) vo[h][i] = (unsigned)((R[i] + HALF * h) * K + C[i]) * 2u; }
};
struct MoeGatherOrder : MoeOrder { static constexpr bool GATHER = true;
    const unsigned* list;
    __device__ __forceinline__ const char* abase(const Unit&) const { return (const char*)A; }
    __device__ __forceinline__ void a_offs(const Unit& u, unsigned (&vo)[2][2], const int (&R)[2], const int (&C)[2]) const {
#pragma unroll
        for (int h = 0; h < 2; ++h)
#pragma unroll
            for (int i = 0; i < 2; ++i) { const int rl = R[i] + HALF * h, rc = rl < u.rows ? rl : u.rows - 1; const unsigned tok = list[(size_t)u.e * NTOK + u.r0 + rc]; vo[h][i] = (tok * (unsigned)K + (unsigned)C[i]) * 2u; } }
};
struct MoeBucketOrder { static constexpr bool GATHER = false, SPLITB = true;
    const bf16* A; const bf16* Bt; int nN, G, c; const LAS int* tab;
    __device__ __forceinline__ void init(const bf16* A_, const bf16* Bt_, const LAS int* t) { A = A_; Bt = Bt_; nN = DM / BM; G = gridDim.x; c = blockIdx.x; tab = t; }
    __device__ __forceinline__ bool next(int i, Unit& u) const { const int nM = tab[448 + 48]; const long L = (long)i * G + c; if (L >= (long)nM * nN) return false; tile_of((int)L, nM, nN, u.pm, u.pn);
        const int bk = tab[576 + u.pm], g = bk / 6, px = bk % 6, lo = px < 3 ? 0 : (px < 5 ? 1 : 2), hi = px < 3 ? px + 1 : (px < 5 ? px - 1 : 3);
        u.e = (g * 4 + lo) | ((g * 4 + hi) << 8); u.r0 = (u.pm - tab[448 + bk]) * BM; const int left = tab[512 + bk] - u.r0; u.rows = left < BM ? left : BM; return true; }
    __device__ __forceinline__ const char* abase(const Unit& u) const { return (const char*)A + (size_t)u.pm * BM * (2 * DFF) * 2; }
    __device__ __forceinline__ const char* bbase(const Unit& u) const { return (const char*)Bt + ((size_t)(u.e & 255) * DM + (size_t)u.pn * BM) * DFF * 2; }
    __device__ __forceinline__ const char* bbase2(const Unit& u) const { return (const char*)Bt + ((size_t)(u.e >> 8) * DM + (size_t)u.pn * BM) * DFF * 2; }
    __device__ __forceinline__ int kb() const { return DFF; }
    __device__ __forceinline__ void a_offs(const Unit&, unsigned (&vo)[2][2], const int (&R)[2], const int (&C)[2]) const {
#pragma unroll
        for (int h = 0; h < 2; ++h)
#pragma unroll
            for (int i = 0; i < 2; ++i) vo[h][i] = (unsigned)((R[i] + HALF * h) * (2 * DFF) + C[i]) * 2u; }
};
struct EpiBf16 { static constexpr bool PERM = true; bf16* O; int ldc;
    __device__ __forceinline__ void operator()(const f32x4 (&acc)[2][2][4][2], const Unit& u, int wr, int wc, int fr, int fq) const {
        const int row0 = u.pm * BM + wr * 64 + fr, col0 = u.pn * BM + wc * 32 + 8 * fq;
#pragma unroll
        for (int ai = 0; ai < 2; ++ai)
#pragma unroll
            for (int m = 0; m < 4; ++m) { bf16* rowp = O + (size_t)(row0 + ai * HALF + m * 16) * ldc + col0;
#pragma unroll
                for (int bj = 0; bj < 2; ++bj) { const f32x4 v0 = acc[ai][bj][m][0], v1 = acc[ai][bj][m][1];
                    u32x4 w; w.x = cvt_pk_bf16(v0[0], v0[1]); w.y = cvt_pk_bf16(v0[2], v0[3]); w.z = cvt_pk_bf16(v1[0], v1[1]); w.w = cvt_pk_bf16(v1[2], v1[3]);
                    *(u32x4*)(rowp + bj * HALF) = w; } }
    } };
struct EpiF32 { static constexpr bool PERM = false; float* C; int ldc;
    __device__ __forceinline__ void operator()(const f32x4 (&acc)[2][2][4][2], const Unit& u, int wr, int wc, int fr, int fq) const {
        const int row0 = u.pm * BM + wr * 64 + fr, col0 = u.pn * BM + wc * 32 + 4 * fq;
#pragma unroll
        for (int ai = 0; ai < 2; ++ai)
#pragma unroll
            for (int m = 0; m < 4; ++m) { float* rowp = C + (size_t)(row0 + ai * HALF + m * 16) * ldc + col0;
#pragma unroll
                for (int bj = 0; bj < 2; ++bj)
#pragma unroll
                    for (int n = 0; n < 2; ++n) *(f32x4*)(rowp + bj * HALF + n * 16) = acc[ai][bj][m][n]; }
    } };
struct EpiRes { static constexpr bool PERM = true; const bf16* res; bf16* out;
    __device__ __forceinline__ void operator()(const f32x4 (&acc)[2][2][4][2], const Unit& u, int wr, int wc, int fr, int fq) const {
        const int row0 = u.pm * BM + wr * 64 + fr, col0 = u.pn * BM + wc * 32 + 8 * fq;
#pragma unroll
        for (int ai = 0; ai < 2; ++ai) { u32x4 b[4][2];
#pragma unroll
            for (int m = 0; m < 4; ++m) { const size_t off = (size_t)(row0 + ai * HALF + m * 16) * DM + col0;
#pragma unroll
                for (int bj = 0; bj < 2; ++bj) b[m][bj] = *(const u32x4*)(res + off + bj * HALF); }
            asm volatile("" ::: "memory");
#pragma unroll
            for (int m = 0; m < 4; ++m) { const size_t off = (size_t)(row0 + ai * HALF + m * 16) * DM + col0;
#pragma unroll
                for (int bj = 0; bj < 2; ++bj) { const u32x4 r = b[m][bj]; const f32x4 a0 = acc[ai][bj][m][0], a1 = acc[ai][bj][m][1];
                    u32x4 w; w.x = cvt_pk_bf16(bflo(r.x) + a0[0], bfhi(r.x) + a0[1]); w.y = cvt_pk_bf16(bflo(r.y) + a0[2], bfhi(r.y) + a0[3]);
                    w.z = cvt_pk_bf16(bflo(r.z) + a1[0], bfhi(r.z) + a1[1]); w.w = cvt_pk_bf16(bflo(r.w) + a1[2], bfhi(r.w) + a1[3]);
                    *(u32x4*)(out + off + bj * HALF) = w; } }
            asm volatile("" ::: "memory"); }
    } };
struct EpiSC { static constexpr bool PERM = true; bf16* Bg; bf16* P;
    __device__ __forceinline__ void operator()(const f32x4 (&acc)[2][2][4][2], const Unit& u, int wr, int wc, int fr, int fq) const {
        const int row0 = u.pm * BM + wr * 64 + fr;
        if (u.pn < 8) { const int col0 = u.pn * BM + wc * 32 + 8 * fq;
#pragma unroll
            for (int ai = 0; ai < 2; ++ai)
#pragma unroll
                for (int m = 0; m < 4; ++m) { bf16* rowp = Bg + (size_t)(row0 + ai * HALF + m * 16) * DM + col0;
#pragma unroll
                    for (int bj = 0; bj < 2; ++bj) { const f32x4 v0 = acc[ai][bj][m][0], v1 = acc[ai][bj][m][1];
                        u32x4 w; w.x = cvt_pk_bf16(v0[0], v0[1]); w.y = cvt_pk_bf16(v0[2], v0[3]); w.z = cvt_pk_bf16(v1[0], v1[1]); w.w = cvt_pk_bf16(v1[2], v1[3]);
                        *(u32x4*)(rowp + bj * HALF) = w; } }
        } else { const int col0 = (u.pn - 8) * HALF + wc * 32 + 8 * fq;
#pragma unroll
            for (int ai = 0; ai < 2; ++ai)
#pragma unroll
                for (int m = 0; m < 4; ++m) { const f32x4 v0 = acc[ai][0][m][0] * acc[ai][1][m][0], v1 = acc[ai][0][m][1] * acc[ai][1][m][1];
                    u32x4 w; w.x = cvt_pk_bf16(v0[0], v0[1]); w.y = cvt_pk_bf16(v0[2], v0[3]); w.z = cvt_pk_bf16(v1[0], v1[1]); w.w = cvt_pk_bf16(v1[2], v1[3]);
                    *(u32x4*)(P + (size_t)(row0 + ai * HALF + m * 16) * DM + col0) = w; }
        }
    } };
struct EpiSwiglu { static constexpr bool PERM = true; bf16* ACT2; const u32x4* REC; const LAS int* tab;
    __device__ __forceinline__ void operator()(const f32x4 (&acc)[2][2][4][2], const Unit& u, int wr, int wc, int fr, int fq) const {
        const int col0 = u.pn * HALF + wc * 32 + 8 * fq; const u32x4* rp = REC + (size_t)u.e * NTOK + u.r0 + wr * 64 + fr;
#pragma unroll
        for (int ai = 0; ai < 2; ++ai) {
            u32x4 rc[4];
#pragma unroll
            for (int m = 0; m < 4; ++m) rc[m] = rp[ai * HALF + m * 16];
#pragma unroll
            for (int m = 0; m < 4; ++m) { const int rl = ai * HALF + wr * 64 + m * 16 + fr;
                if (rl < u.rows) { float o[8]; const float rs = __uint_as_float(rc[m].x), gt = __uint_as_float(rc[m].y); const unsigned cd = rc[m].z;
                    const unsigned doff = (((unsigned)tab[448 + (cd >> 20)] * (unsigned)BM + (cd & 0x7FFFFu)) * (unsigned)(2 * DFF) + ((cd >> 19) & 1u) * (unsigned)DFF + (unsigned)col0) * 2u;
#pragma unroll
                    for (int n = 0; n < 2; ++n)
#pragma unroll
                        for (int j = 0; j < 4; ++j) { const float g = acc[ai][0][m][n][j] * rs, up = acc[ai][1][m][n][j] * rs;
                            o[n * 4 + j] = g * __builtin_amdgcn_rcpf(1.0f + __builtin_amdgcn_exp2f(-1.4426950408889634f * g)) * up * gt; }
                    u32x4 w; w.x = cvt_pk_bf16(o[0], o[1]); w.y = cvt_pk_bf16(o[2], o[3]); w.z = cvt_pk_bf16(o[4], o[5]); w.w = cvt_pk_bf16(o[6], o[7]);
                    *(u32x4*)((char*)ACT2 + doff) = w;
                } }
            asm volatile("" ::: "memory"); }
    } };
template <bool NEXT>
struct EpiDown { static constexpr bool PERM = true; const unsigned* TOKOF; bf16* XS; float* OUT; float* PART;
    __device__ __forceinline__ void operator()(const f32x4 (&acc)[2][2][4][2], const Unit& u, int wr, int wc, int fr, int fq) const {
        const int col0 = u.pn * BM + wc * 32 + 8 * fq;
        unsigned tk[2][4];
#pragma unroll
        for (int ai = 0; ai < 2; ++ai)
#pragma unroll
            for (int m = 0; m < 4; ++m) { const int rl = ai * HALF + wr * 64 + m * 16 + fr; tk[ai][m] = TOKOF[(size_t)u.pm * BM + rl]; }
#pragma unroll
        for (int ai = 0; ai < 2; ++ai) { u32x4 b[4][2];
#pragma unroll
            for (int m = 0; m < 4; ++m) { const int rl = ai * HALF + wr * 64 + m * 16 + fr; const unsigned t = rl < u.rows ? tk[ai][m] : 0u;
                const bf16* rowp = XS + (size_t)t * DM + col0;
#pragma unroll
                for (int bj = 0; bj < 2; ++bj) b[m][bj] = *(const u32x4*)(rowp + bj * HALF); }
            asm volatile("" ::: "memory");
#pragma unroll
            for (int m = 0; m < 4; ++m) { const int rl = ai * HALF + wr * 64 + m * 16 + fr; const bool ok = rl < u.rows; const size_t ro = (size_t)tk[ai][m] * DM + col0;
                float ss = 0.f;
#pragma unroll
                for (int bj = 0; bj < 2; ++bj) { const u32x4 r = b[m][bj];
                    const f32x4 x0 = (f32x4){bflo(r.x), bfhi(r.x), bflo(r.y), bfhi(r.y)} + acc[ai][bj][m][0], x1 = (f32x4){bflo(r.z), bfhi(r.z), bflo(r.w), bfhi(r.w)} + acc[ai][bj][m][1];
                    if constexpr (NEXT) {
                        ss += x0[0] * x0[0] + x0[1] * x0[1] + x0[2] * x0[2] + x0[3] * x0[3] + x1[0] * x1[0] + x1[1] * x1[1] + x1[2] * x1[2] + x1[3] * x1[3];
                        u32x4 w; w.x = cvt_pk_bf16(x0[0], x0[1]); w.y = cvt_pk_bf16(x0[2], x0[3]); w.z = cvt_pk_bf16(x1[0], x1[1]); w.w = cvt_pk_bf16(x1[2], x1[3]);
                        if (ok) *(u32x4*)(XS + ro + bj * HALF) = w;
                    } else { if (ok) { *(f32x4*)(OUT + ro + bj * HALF) = x0; *(f32x4*)(OUT + ro + bj * HALF + 4) = x1; } } }
                if constexpr (NEXT) { ss += __shfl_xor(ss, 16); ss += __shfl_xor(ss, 32);
                    if (ok && fq == 0) PART[(size_t)tk[ai][m] * 32 + u.pn * 4 + wc] = ss; } }
            asm volatile("" ::: "memory"); }
    } };

template <class Epi, class Sched, bool ALIGN_EPI = true>
__device__ __forceinline__ void gemm_phase(const int wv_, LAS unsigned char* lds, const int K, const Sched& S, const Epi& E) {
    const int tid = TIDX, wid = wv_, lane = tid & 63, wr = wid >> 2, wc = wid & 3, fr = lane & 15, fq = lane >> 4;
    const int nt = K / BK;
    unsigned voffB[2]; int Ra[2], Ca[2];
#pragma unroll
    for (int i = 0; i < 2; ++i) { int R, C; stage_rc(tid * 16 + i * 8192, R, C); const int Rb = Epi::PERM ? ((R & ~31) + perm32(R & 31)) : R;
        Ra[i] = R; Ca[i] = C; voffB[i] = (unsigned)(Rb * S.kb() + C) * 2u; }
    unsigned vAc[2][2], vAn[2][2];
    const size_t kstep = (size_t)(BK * 2);
    const size_t hstep = (size_t)HALF * S.kb() * 2;
    const int nth = nt / 2;
    const unsigned ldsw = (unsigned)wid * 1024u;
    const int aoff = lds_byte(wr * 64 + fr, fq * 8), boff = lds_byte(wc * 32 + fr, fq * 8);
#define PG8_SA(b, h) (((b) * 2 + (h)) * HTB)
#define PG8_SB(b, h) ((4 + (b) * 2 + (h)) * HTB)
#define PG8_STAGE(bufoff, gbase, voff) do { _Pragma("unroll") for (int _i = 0; _i < 2; ++_i) \
        __builtin_amdgcn_global_load_lds((const unsigned*)((const char*)(gbase) + (voff)[_i]), (LAS unsigned*)(lds + (bufoff) + ldsw + _i * 8192), 16, 0, 0); } while (0)
#define PG8_LDA(dst, b, h) do { _Pragma("unroll") for (int m = 0; m < 4; ++m) _Pragma("unroll") for (int k = 0; k < 2; ++k) dst[m][k] = *(const LAS bf16x8*)(lds + PG8_SA(b, h) + aoff + m * 2048 + k * 1024); } while (0)
#define PG8_LDB(dst, b, h) do { _Pragma("unroll") for (int n = 0; n < 2; ++n) _Pragma("unroll") for (int k = 0; k < 2; ++k) dst[n][k] = *(const LAS bf16x8*)(lds + PG8_SB(b, h) + boff + n * 2048 + k * 1024); } while (0)
#define PG8_MMA(ai, bj, At, Bt) do { __builtin_amdgcn_s_setprio(1); _Pragma("unroll") for (int m = 0; m < 4; ++m) _Pragma("unroll") for (int n = 0; n < 2; ++n) _Pragma("unroll") for (int k = 0; k < 2; ++k) \
        acc[ai][bj][m][n] = __builtin_amdgcn_mfma_f32_16x16x32_bf16(Bt[n][k], At[m][k], acc[ai][bj][m][n], 0, 0, 0); __builtin_amdgcn_s_setprio(0); } while (0)
#define PG8_WAIT_V(n) asm volatile("s_waitcnt vmcnt(" #n ")" ::: "memory")
#define PG8_WAIT_L(n) asm volatile("s_waitcnt lgkmcnt(" #n ")" ::: "memory")
#define PG8_BAR __builtin_amdgcn_s_barrier()
#define PG8_SCHED __builtin_amdgcn_sched_barrier(0)
    Unit cur, nxt; int ui = 0;
    if (!S.next(0, cur)) return;
    f32x4 acc[2][2][4][2];
#pragma unroll
    for (int a = 0; a < 2; ++a)
#pragma unroll
        for (int b = 0; b < 2; ++b)
#pragma unroll
            for (int m = 0; m < 4; ++m)
#pragma unroll
                for (int n = 0; n < 2; ++n) acc[a][b][m][n] = (f32x4){0.f, 0.f, 0.f, 0.f};
    bf16x8 At[4][2], B0[2][2], B1[2][2];
    const char* cA = S.abase(cur); const char* cB = S.bbase(cur); long dB2 = 0;
    if constexpr (Sched::SPLITB) dB2 = (S.bbase2(cur) - cB) - (long)nth * (long)kstep;
    S.a_offs(cur, vAc, Ra, Ca);
    PG8_STAGE(PG8_SB(0, 0), cB, voffB); PG8_STAGE(PG8_SB(0, 1), cB + hstep, voffB); PG8_STAGE(PG8_SA(0, 0), cA, vAc[0]); PG8_STAGE(PG8_SA(0, 1), cA, vAc[1]);
    if (wr == 1) PG8_BAR;
    PG8_WAIT_V(2); PG8_BAR;
    PG8_STAGE(PG8_SB(1, 0), cB + kstep, voffB); PG8_STAGE(PG8_SA(1, 0), cA + kstep, vAc[0]); PG8_STAGE(PG8_SB(1, 1), cB + hstep + kstep, voffB);
    PG8_WAIT_V(6); PG8_BAR;
    for (;;) {
        const bool has_next = S.next(ui + 1, nxt);
        const char* nA = has_next ? S.abase(nxt) : cA; const char* nB = has_next ? S.bbase(nxt) : cB;
        if constexpr (Sched::GATHER) {
            if (has_next) S.a_offs(nxt, vAn, Ra, Ca);
            else {
#pragma unroll
                for (int h = 0; h < 2; ++h)
#pragma unroll
                    for (int i = 0; i < 2; ++i) vAn[h][i] = vAc[h][i]; } }
        for (int t = 0; t < nt; t += 2) {
            const bool last = (t == nt - 2);
            const char* a1 = cA + (size_t)(t + 1) * kstep;
            const char* a2 = last ? nA : cA + (size_t)(t + 2) * kstep; const char* b2 = last ? nB : cB + (size_t)(t + 2) * kstep;
            if constexpr (Sched::SPLITB) { if (!last && t + 2 >= nth) b2 += dB2; }
            const char* a3 = a2 + kstep; const char* b3 = b2 + kstep;
            unsigned v0[2], v1[2];
#pragma unroll
            for (int i = 0; i < 2; ++i) { v0[i] = (Sched::GATHER && last) ? vAn[0][i] : vAc[0][i]; v1[i] = (Sched::GATHER && last) ? vAn[1][i] : vAc[1][i]; }
            PG8_LDB(B0, 0, 0); PG8_LDB(B1, 0, 1); PG8_SCHED; PG8_LDA(At, 0, 0); PG8_STAGE(PG8_SA(1, 1), a1, vAc[1]);
            PG8_WAIT_V(8); PG8_WAIT_L(0); PG8_BAR; PG8_MMA(0, 0, At, B0); PG8_MMA(0, 1, At, B1); PG8_BAR; PG8_SCHED;
            PG8_LDA(At, 0, 1); PG8_STAGE(PG8_SB(0, 0), b2, voffB); PG8_STAGE(PG8_SB(0, 1), b2 + hstep, voffB); PG8_STAGE(PG8_SA(0, 0), a2, v0);
            PG8_WAIT_V(8); PG8_WAIT_L(0); PG8_BAR; PG8_MMA(1, 0, At, B0); PG8_MMA(1, 1, At, B1); PG8_BAR; PG8_SCHED;
            PG8_LDB(B0, 1, 0); PG8_LDB(B1, 1, 1); PG8_SCHED; PG8_LDA(At, 1, 0); PG8_STAGE(PG8_SA(0, 1), a2, v1);
            PG8_WAIT_V(8); PG8_WAIT_L(0); PG8_BAR; PG8_MMA(0, 0, At, B0); PG8_MMA(0, 1, At, B1); PG8_BAR; PG8_SCHED;
            PG8_LDA(At, 1, 1); PG8_STAGE(PG8_SB(1, 0), b3, voffB); PG8_STAGE(PG8_SB(1, 1), b3 + hstep, voffB); PG8_STAGE(PG8_SA(1, 0), a3, v0);
            PG8_WAIT_V(8); PG8_WAIT_L(0); PG8_BAR; PG8_MMA(1, 0, At, B0); PG8_MMA(1, 1, At, B1); PG8_BAR; PG8_SCHED;
        }
        if constexpr (ALIGN_EPI) { if (wr == 0) PG8_BAR; }
        E(acc, cur, wr, wc, fr, fq);
        if (!has_next) break;
#pragma unroll
        for (int a = 0; a < 2; ++a)
#pragma unroll
            for (int b = 0; b < 2; ++b)
#pragma unroll
                for (int m = 0; m < 4; ++m)
#pragma unroll
                    for (int n = 0; n < 2; ++n) acc[a][b][m][n] = (f32x4){0.f, 0.f, 0.f, 0.f};
        cur = nxt; cA = nA; cB = nB; ++ui;
        if constexpr (Sched::SPLITB) dB2 = (S.bbase2(cur) - cB) - (long)nth * (long)kstep;
        if constexpr (Sched::GATHER) {
#pragma unroll
            for (int h = 0; h < 2; ++h)
#pragma unroll
                for (int i = 0; i < 2; ++i) vAc[h][i] = vAn[h][i]; }
        if constexpr (ALIGN_EPI) { if (wr == 1) PG8_BAR; }
    }
    PG8_WAIT_V(0);
    if constexpr (!ALIGN_EPI) { if (wr == 0) PG8_BAR; }
    PG8_BAR;
#undef PG8_SA
#undef PG8_SB
#undef PG8_STAGE
#undef PG8_LDA
#undef PG8_LDB
#undef PG8_MMA
#undef PG8_WAIT_V
#undef PG8_WAIT_L
#undef PG8_BAR
#undef PG8_SCHED
}
}


constexpr int MOE_TAB_OFF = SCR_BYTES + 1024;
__device__ __forceinline__ void moe_tables256(const int wv_, LAS unsigned char* lds, unsigned* cnt, unsigned* cntB) {
    LAS int* tstart = (LAS int*)(lds + MOE_TAB_OFF); LAS int* cnts = tstart + 64;
    __syncthreads();
    if (TIDX < 32) cnts[TIDX] = (int)__hip_atomic_load(cnt + TIDX * 64, __ATOMIC_RELAXED, __HIP_MEMORY_SCOPE_AGENT);
    else if (TIDX >= 64 && TIDX < 112) tstart[512 + TIDX - 64] = (int)__hip_atomic_load(cntB + (TIDX - 64) * 64, __ATOMIC_RELAXED, __HIP_MEMORY_SCOPE_AGENT);
    __syncthreads();
    if (TIDX == 0) { int t = 0; for (int e = 0; e < 32; ++e) { tstart[e] = t; t += (cnts[e] + 255) / 256; } tstart[32] = t; }
    else if (TIDX == 64) { int t = 0; for (int b = 0; b < 48; ++b) { tstart[448 + b] = t; t += (tstart[512 + b] + 255) / 256; } tstart[448 + 48] = t; }
    __syncthreads();
    for (int t = TIDX; t < tstart[32]; t += NTHREADS) { int e = 0; for (int k = 1; k < 32; ++k) e += (tstart[k] <= t) ? 1 : 0; tstart[128 + t] = e; }
    for (int t = TIDX; t < tstart[448 + 48]; t += NTHREADS) { int b = 0; for (int k = 1; k < 48; ++k) b += (tstart[448 + k] <= t) ? 1 : 0; tstart[576 + t] = b; }
    __syncthreads();
}
__device__ __forceinline__ void moe_up_phase256(const int wv_, LAS unsigned char* lds, const bf16* Hu, const u32x4* REC, const bf16* WupT, unsigned* cnt, unsigned* cntB, const unsigned* list, bf16* ACT2, unsigned* TOKOF,
                                                const float* cw_up, const float* cw_dn, bf16* cw_upT, bf16* cw_dnT, const float* cw_gain) {
    LAS int* tstart = (LAS int*)(lds + MOE_TAB_OFF); LAS int* cnts = tstart + 64;
    moe_tables256(wv_, lds, cnt, cntB);
    pg8::MoeGatherOrder S; S.init(Hu, WupT, 2 * DFF, DM, tstart, cnts); S.list = list;
    for (int o = blockIdx.x * NTHREADS + TIDX; o < NEXP * NTOK; o += gridDim.x * NTHREADS) { const int e = o >> 15, r = o & (NTOK - 1);
        if (r < cnts[e]) { const u32x4 rc = REC[o]; TOKOF[(size_t)tstart[448 + (rc.z >> 20)] * 256 + (rc.z & 0x7FFFFu)] = rc.w; } }
    pg8::EpiSwiglu E{ACT2, REC, tstart};
    pg8::gemm_phase<pg8::EpiSwiglu, pg8::MoeGatherOrder, true>(wv_, lds, DM, S, E);
    if (cw_up) {
        const int G = gridDim.x, units = tstart[32] * 4, rem = units % G; int first_idle = rem;
        if (rem == 0 || G - rem < G / 4) first_idle = 0;
        const int c = blockIdx.x;
        if (c >= first_idle) { const int wid = wv_, lane = TIDX & 63; LAS float* scr = (LAS float*)(lds + wid * 16384);
            const int gw = (c - first_idle) * NWAVES + wid, NGW = (G - first_idle) * NWAVES;
            cvt_mats<2, true>(cw_up, NEXP, DM, 2 * DFF, 2 * DFF, cw_upT, scr, gw, NGW, lane, cw_gain, 0);
            cvt_mats<0>(cw_dn, NEXP, DFF, DM, DM, cw_dnT, scr, gw, NGW, lane); }
    }
}
template <bool NEXT>
__device__ __forceinline__ void moe_down_phase256(const int wv_, LAS unsigned char* lds, const bf16* ACT2, const bf16* WdnT, unsigned* cnt, unsigned* cntB, const unsigned* TOKOF, bf16* XS, float* OUT, float* PART) {
    LAS int* tstart = (LAS int*)(lds + MOE_TAB_OFF);
    moe_tables256(wv_, lds, cnt, cntB);
    pg8::MoeBucketOrder S; S.init(ACT2, WdnT, tstart);
    pg8::EpiDown<NEXT> E{TOKOF, XS, OUT, PART};
    pg8::gemm_phase<pg8::EpiDown<NEXT>, pg8::MoeBucketOrder, true>(wv_, lds, 2 * DFF, S, E);
}
template <class Epi, bool ALIGN_EPI = true>
__device__ __forceinline__ void gemm_dense256(const int wv_, LAS unsigned char* lds, const bf16* A, const bf16* Bt, int M, int N, int K, const Epi& E) {
    pg8::DenseOrder S; S.init(A, Bt, M, N, K);
    pg8::gemm_phase<Epi, pg8::DenseOrder, ALIGN_EPI>(wv_, lds, K, S, E);
}

__device__ __forceinline__ void rstd_prepass(const int wv_, const float* PART, float* RSTD) {
    const int tid = TIDX;
    for (int row = blockIdx.x * (NTHREADS / 4) + (tid >> 2); row < NTOK; row += gridDim.x * (NTHREADS / 4)) {
        const f32x4 a = *(const f32x4*)(PART + (size_t)row * 32 + (tid & 3) * 8), b = *(const f32x4*)(PART + (size_t)row * 32 + (tid & 3) * 8 + 4);
        float s = ((a[0] + a[1]) + (a[2] + a[3])) + ((b[0] + b[1]) + (b[2] + b[3]));
        s += __shfl_xor(s, 1); s += __shfl_xor(s, 2);
        if ((tid & 3) == 0) RSTD[row] = 1.0f / sqrtf(s * (1.0f / DM) + EPS);
    }
}
template <bool RS>
__device__ __forceinline__ void sc_thin_phase(const int wv_, const bf16* Bg, const bf16* P, const float* cw  , bf16* Y, const float* RSTD) {
    const size_t total = (size_t)NTOK * (DM / 8), stride = (size_t)gridDim.x * NTHREADS;
    constexpr int NU = 4;
    for (size_t i0 = (size_t)blockIdx.x * NTHREADS + TIDX; i0 < total; i0 += NU * stride) {
        u32x4 p[NU][3], bb[NU]; float rr[NU][3];
#pragma unroll
        for (int k = 0; k < NU; ++k) { const size_t i = i0 + k * stride; const bool ok = i < total; const int n = ok ? (int)(i / (DM / 8)) : 0, d0 = ok ? (int)(i % (DM / 8)) * 8 : 0, t = n & (SEQ - 1);
#pragma unroll
            for (int j = 0; j < 3; ++j) { const int tt = t + j - 1; p[k][j] = (tt >= 0 && tt < SEQ) ? *(const u32x4*)(P + (size_t)(n + j - 1) * DM + d0) : (u32x4){0u, 0u, 0u, 0u};
                if constexpr (RS) rr[k][j] = (tt >= 0 && tt < SEQ) ? RSTD[n + j - 1] : 0.f; }
            bb[k] = *(const u32x4*)(Bg + (size_t)n * DM + d0); }
#pragma unroll
        for (int k = 0; k < NU; ++k) { const size_t i = i0 + k * stride; if (i >= total) continue; const int n = (int)(i / (DM / 8)), d0 = (int)(i % (DM / 8)) * 8;
            float acc[8];
#pragma unroll
            for (int q = 0; q < 8; ++q) acc[q] = 0.f;
#pragma unroll
            for (int j = 0; j < 3; ++j) { const u32x4 pp = p[k][j];
                f32x4 w0 = *(const f32x4*)(cw + j * DM + d0), w1 = *(const f32x4*)(cw + j * DM + d0 + 4);
                if constexpr (RS) { const float s2 = rr[k][j] * rr[k][j]; w0 *= s2; w1 *= s2; }
                acc[0] += bflo(pp.x) * w0[0]; acc[1] += bfhi(pp.x) * w0[1]; acc[2] += bflo(pp.y) * w0[2]; acc[3] += bfhi(pp.y) * w0[3];
                acc[4] += bflo(pp.z) * w1[0]; acc[5] += bfhi(pp.z) * w1[1]; acc[6] += bflo(pp.w) * w1[2]; acc[7] += bfhi(pp.w) * w1[3]; }
            const u32x4 b_ = bb[k];
            if constexpr (RS) {
#pragma unroll
                for (int q = 0; q < 8; ++q) acc[q] *= rr[k][1]; }
            u32x4 o; o.x = pk2(bflo(b_.x) * acc[0], bfhi(b_.x) * acc[1]); o.y = pk2(bflo(b_.y) * acc[2], bfhi(b_.y) * acc[3]);
            o.z = pk2(bflo(b_.z) * acc[4], bfhi(b_.z) * acc[5]); o.w = pk2(bflo(b_.w) * acc[6], bfhi(b_.w) * acc[7]);
            *(u32x4*)(Y + (size_t)n * DM + d0) = o; }
    }
}

__device__ __forceinline__ s16x4 tr_rd(unsigned addr) { s16x4 r; asm volatile("ds_read_b64_tr_b16 %0, %1" : "=v"(r) : "v"(addr) : "memory"); return r; }
__device__ __forceinline__ void hy_thin1_phase(const int wv_, const bf16* Z, const float* cw  , const float* cb  , bf16* X0, bf16* VT, LAS unsigned char* lds, const float* RSTD) {
    const int tid = TIDX, tl = tid >> 3, dc = tid & 7, lane = tid & 63, wv = wv_, grp = lane >> 4, li = lane & 15;
    const int items = (NTOK / 64) * (DM / 64);
    u32x4 z[3][3]; float zr[3];
#define T1_LOAD(it_) do { const int nt_ = (it_) / (DM / 64), db_ = (it_) % (DM / 64), n_ = nt_ * 64 + tl, t_ = n_ & (SEQ - 1), d0_ = db_ * 64 + dc * 8; \
        _Pragma("unroll") for (int j = 0; j < 3; ++j) { const int tt = t_ + j - 1; zr[j] = (tt >= 0 && tt < SEQ) ? RSTD[n_ + j - 1] : 0.f; } \
        _Pragma("unroll") for (int gI = 1; gI < 3; ++gI) _Pragma("unroll") for (int j = 0; j < 3; ++j) { const int tt = t_ + j - 1; \
            z[gI][j] = (tt >= 0 && tt < SEQ) ? *(const u32x4*)(Z + (size_t)(n_ + j - 1) * (3 * DM) + gI * DM + d0_) : (u32x4){0u, 0u, 0u, 0u}; } } while (0)
    if ((int)blockIdx.x < items) T1_LOAD(blockIdx.x);
    for (int it = blockIdx.x; it < items; it += gridDim.x) {
        const int nt = it / (DM / 64), db = it % (DM / 64), n = nt * 64 + tl, d0 = db * 64 + dc * 8;
        float u[3][8];
#pragma unroll
        for (int gI = 1; gI < 3; ++gI) { const int c0 = gI * DM + d0;
            const f32x4 b0 = *(const f32x4*)(cb + c0), b1 = *(const f32x4*)(cb + c0 + 4);
#pragma unroll
            for (int k = 0; k < 4; ++k) { u[gI][k] = b0[k]; u[gI][4 + k] = b1[k]; }
#pragma unroll
            for (int j = 0; j < 3; ++j) { const u32x4 zz = z[gI][j];
                const f32x4 w0 = *(const f32x4*)(cw + j * 3 * DM + c0) * zr[j], w1 = *(const f32x4*)(cw + j * 3 * DM + c0 + 4) * zr[j];
                u[gI][0] += bflo(zz.x) * w0[0]; u[gI][1] += bfhi(zz.x) * w0[1]; u[gI][2] += bflo(zz.y) * w0[2]; u[gI][3] += bfhi(zz.y) * w0[3];
                u[gI][4] += bflo(zz.z) * w1[0]; u[gI][5] += bfhi(zz.z) * w1[1]; u[gI][6] += bflo(zz.w) * w1[2]; u[gI][7] += bfhi(zz.w) * w1[3]; } }
        u32x4 vx; vx.x = pk2(u[2][0] * u[1][0], u[2][1] * u[1][1]); vx.y = pk2(u[2][2] * u[1][2], u[2][3] * u[1][3]); vx.z = pk2(u[2][4] * u[1][4], u[2][5] * u[1][5]); vx.w = pk2(u[2][6] * u[1][6], u[2][7] * u[1][7]);
        __syncthreads();
        *(LAS u32x4*)(lds + tl * 144 + dc * 16) = vx;
        if (it + (int)gridDim.x < items) T1_LOAD(it + gridDim.x);
        __syncthreads();
        { const unsigned a0 = (unsigned)(size_t)(lds + (32 * (wv >> 2) + 8 * grp + (li >> 2)) * 144 + (16 * (wv & 3) + 4 * (li & 3)) * 2);
            s16x4 lo = tr_rd(a0), hi = tr_rd(a0 + 4 * 144);
            asm volatile("s_waitcnt lgkmcnt(0)" : "+v"(lo), "+v"(hi) :: "memory");
            const int bidx = (nt * 64) / SEQ, t0 = (nt * 64) & (SEQ - 1);
            const bf16x8 ov = (bf16x8){lo[0], lo[1], lo[2], lo[3], hi[0], hi[1], hi[2], hi[3]};
            *(bf16x8*)(VT + ((size_t)bidx * DM + db * 64 + 16 * (wv & 3) + li) * SEQ + t0 + 32 * (wv >> 2) + 8 * grp) = ov; }
    }
#undef T1_LOAD
}

constexpr int LC_KR0 = 0, LC_KR1 = 16384 + 64, LC_V = 33024, LC_VROW = 2176;
__device__ __forceinline__ int lc_vrow_byte(int b) { return (b * LC_VROW + 4 * (b & 3)) * 4; }
__device__ __forceinline__ bf16x8 lc_ld_a(const LAS unsigned char* p) {
    const unsigned w0 = *(const LAS unsigned*)(p), w1 = *(const LAS unsigned*)(p + 4), w2 = *(const LAS unsigned*)(p + 8), w3 = *(const LAS unsigned*)(p + 12);
    u32x4 w = {w0, w1, w2, w3}; return __builtin_bit_cast(bf16x8, w);
}
__device__ __forceinline__ void longconv_phase(const int wv_, const bf16* KRB, const bf16* VT, const float* skip, bf16* YST, LAS unsigned char* lds) {
    const int tid = TIDX, lane = tid & 63, wid = wv_, r32 = lane & 31, hi = lane >> 5;
    for (int i = tid; i < 8 * 192; i += NTHREADS) { const int b = i / 192, j = i % 192, sp = j < 96 ? j : 4096 + j;
        *(LAS bf16*)(lds + LC_V + lc_vrow_byte(b) + 2 * sp) = 0; }
    const int T0 = 512 * wid, P = 4095 - T0 - r32 + 8 * hi, cpy = P & 1;
    const int Al = (cpy ? LC_KR1 : LC_KR0) + 2 * (P - cpy) - 960;
    const int q = r32 >> 3, bb = r32 & 7, Vl = LC_V + lc_vrow_byte(bb) + 64 * q + 16 * hi;
    u32x4 pk0, pk1, pk2_, pk3, vr[8]; unsigned ex0 = 0, ex1 = 0;
#define LC_LOAD(dd) do { const bf16* kr_ = KRB + (size_t)(dd) * 8192; const u32x4* k0 = (const u32x4*)kr_; \
        pk0 = k0[tid]; pk1 = k0[tid + 512]; ex0 = kr_[8 * tid + 8]; ex1 = tid < 511 ? kr_[4096 + 8 * tid + 8] : (bf16)0; \
        _Pragma("unroll") for (int i = 0; i < 8; ++i) vr[i] = *((const u32x4*)(VT + ((size_t)i * DM + (dd)) * SEQ) + tid); } while (0)
    if ((int)blockIdx.x < DM) LC_LOAD(blockIdx.x);
    for (int d = blockIdx.x; d < DM; d += gridDim.x) {
        __syncthreads();
        pk2_ = (u32x4){(pk0.x >> 16) | (pk0.y << 16), (pk0.y >> 16) | (pk0.z << 16), (pk0.z >> 16) | (pk0.w << 16), (pk0.w >> 16) | (ex0 << 16)};
        pk3 = (u32x4){(pk1.x >> 16) | (pk1.y << 16), (pk1.y >> 16) | (pk1.z << 16), (pk1.z >> 16) | (pk1.w << 16), (pk1.w >> 16) | (ex1 << 16)};
        *(LAS u32x4*)(lds + LC_KR0 + tid * 16) = pk0; *(LAS u32x4*)(lds + LC_KR0 + (tid + 512) * 16) = pk1;
        *(LAS u32x4*)(lds + LC_KR1 + tid * 16) = pk2_; *(LAS u32x4*)(lds + LC_KR1 + (tid + 512) * 16) = pk3;
#pragma unroll
        for (int i = 0; i < 8; ++i) *(LAS u32x4*)(lds + LC_V + lc_vrow_byte(i) + 192 + tid * 16) = vr[i];
        __syncthreads();
        if (d + (int)gridDim.x < DM) LC_LOAD(d + gridDim.x);
        f32x16 acc[4];
#pragma unroll
        for (int g = 0; g < 4; ++g)
#pragma unroll
            for (int r = 0; r < 16; ++r) acc[g][r] = 0.f;
        for (int a = 0; a < 8; ++a) {
            const LAS unsigned char* ab = lds + Al + 1024 * a; const LAS unsigned char* vb = lds + Vl + 1024 * a;
#pragma unroll
            for (int u = 0; u < 8; ++u) {
                bf16x8 At[7], Bt[4];
#pragma unroll
                for (int jp = 0; jp < 7; ++jp) At[jp] = lc_ld_a(ab + 768 + 32 * u - 256 * (jp - 3));
#pragma unroll
                for (int h = 0; h < 4; ++h) Bt[h] = *(const LAS bf16x8*)(vb + 32 * u + 256 * h);
#pragma unroll
                for (int h = 0; h < 4; ++h)
#pragma unroll
                    for (int g = 0; g < 4; ++g) acc[g] = __builtin_amdgcn_mfma_f32_32x32x16_bf16(At[g - h + 3], Bt[h], acc[g], 0, 0, 0);
            }
        }
        { const LAS unsigned char* ab = lds + Al + 8192; const LAS unsigned char* vb = lds + Vl + 8192;
#pragma unroll
            for (int u = 0; u < 6; ++u) {
                const bf16x8 B0 = *(const LAS bf16x8*)(vb + 32 * u);
#pragma unroll
                for (int g = 0; g < 4; ++g) { const bf16x8 A0 = lc_ld_a(ab + 768 + 32 * u - 256 * g); acc[g] = __builtin_amdgcn_mfma_f32_32x32x16_bf16(A0, B0, acc[g], 0, 0, 0); }
            } }
        const float sk = skip[d];
#pragma unroll
        for (int g = 0; g < 4; ++g)
#pragma unroll
            for (int rp = 0; rp < 4; rp += 2) { u32x2 o[2];
#pragma unroll
                for (int k = 0; k < 2; ++k) { const int rr = rp + k, t = T0 + 128 * g + 32 * q + 8 * rr + 4 * hi;
                    const u32x2 vv = *(const LAS u32x2*)(lds + LC_V + lc_vrow_byte(bb) + (96 + t) * 2);
                    o[k].x = pk2(acc[g][4 * rr + 0] + bflo(vv.x) * sk, acc[g][4 * rr + 1] + bfhi(vv.x) * sk); o[k].y = pk2(acc[g][4 * rr + 2] + bflo(vv.y) * sk, acc[g][4 * rr + 3] + bfhi(vv.y) * sk); }
                asm volatile("s_nop 1" : "+v"(o[0].x), "+v"(o[0].y), "+v"(o[1].x), "+v"(o[1].y));
                auto r0 = __builtin_amdgcn_permlane32_swap(o[0].x, o[1].x, false, false); auto r1 = __builtin_amdgcn_permlane32_swap(o[0].y, o[1].y, false, false);
                const u32x4 w = {r0[0], r1[0], r0[1], r1[1]};
                *(u32x4*)(YST + ((size_t)bb * DM + d) * SEQ + T0 + 128 * g + 32 * q + 8 * (rp + hi)) = w; }
    }
#undef LC_LOAD
}

__device__ __forceinline__ void hy_thin2_phase(const int wv_, const bf16* YST, const bf16* Z, const float* cw  , const float* cb  , const float* RSTD, bf16* G, LAS unsigned char* lds) {
    const int tid = TIDX, dl = tid >> 3, tc = tid & 7, lane = tid & 63, wv = wv_, grp = lane >> 4, li = lane & 15;
    constexpr int items = (NTOK / 64) * (DM / 64), NI = 4, TILE = 64 * 144;
    u32x4 yv[NI];
#define T2_LOAD(g_) do { _Pragma("unroll") for (int k = 0; k < NI; ++k) { const int it_ = (g_) * NI + k; if (it_ < items) { const int nt_ = it_ / (DM / 64), db_ = it_ % (DM / 64), bi_ = (nt_ * 64) / SEQ, t0_ = (nt_ * 64) & (SEQ - 1); \
        yv[k] = *(const u32x4*)(YST + ((size_t)bi_ * DM + db_ * 64 + dl) * SEQ + t0_ + tc * 8); } } } while (0)
    if ((int)blockIdx.x * NI < items) T2_LOAD(blockIdx.x);
    for (int gi = blockIdx.x; gi * NI < items; gi += gridDim.x) {
        u32x4 zq[NI][3]; float zs[NI][3]; size_t goff[NI]; int dq[NI];
#pragma unroll
        for (int k = 0; k < NI; ++k) { const int it = gi * NI + k < items ? gi * NI + k : items - 1; const int nt = it / (DM / 64), db = it % (DM / 64);
            const int n = nt * 64 + 16 * (wv & 3) + li, t = n & (SEQ - 1); dq[k] = db * 64 + 32 * (wv >> 2) + 8 * grp; goff[k] = (size_t)n * DM + dq[k];
#pragma unroll
            for (int j = 0; j < 3; ++j) { const int tt = t + j - 1; const bool ok = tt >= 0 && tt < SEQ;
                zq[k][j] = ok ? *(const u32x4*)(Z + (size_t)(n + j - 1) * (3 * DM) + dq[k]) : (u32x4){0u, 0u, 0u, 0u}; zs[k][j] = ok ? RSTD[n + j - 1] : 0.f; } }
        __syncthreads();
#pragma unroll
        for (int k = 0; k < NI; ++k) *(LAS u32x4*)(lds + k * TILE + dl * 144 + tc * 16) = yv[k];
        if ((gi + (int)gridDim.x) * NI < items) T2_LOAD(gi + gridDim.x);
        __syncthreads();
        const unsigned a0 = (unsigned)(size_t)(lds + (32 * (wv >> 2) + 8 * grp + (li >> 2)) * 144 + (16 * (wv & 3) + 4 * (li & 3)) * 2);
#pragma unroll
        for (int k = 0; k < NI; ++k) {
            s16x4 lo = tr_rd(a0 + k * TILE), hi = tr_rd(a0 + k * TILE + 4 * 144);
            asm volatile("s_waitcnt lgkmcnt(0)" : "+v"(lo), "+v"(hi) :: "memory");
            const u32x2 l2 = __builtin_bit_cast(u32x2, lo), h2 = __builtin_bit_cast(u32x2, hi);
            float x[8]; { const f32x4 b0 = *(const f32x4*)(cb + dq[k]), b1 = *(const f32x4*)(cb + dq[k] + 4);
#pragma unroll
                for (int e = 0; e < 4; ++e) { x[e] = b0[e]; x[4 + e] = b1[e]; } }
#pragma unroll
            for (int j = 0; j < 3; ++j) { const u32x4 zz = zq[k][j]; const f32x4 w0 = *(const f32x4*)(cw + j * 3 * DM + dq[k]) * zs[k][j], w1 = *(const f32x4*)(cw + j * 3 * DM + dq[k] + 4) * zs[k][j];
                x[0] += bflo(zz.x) * w0[0]; x[1] += bfhi(zz.x) * w0[1]; x[2] += bflo(zz.y) * w0[2]; x[3] += bfhi(zz.y) * w0[3];
                x[4] += bflo(zz.z) * w1[0]; x[5] += bfhi(zz.z) * w1[1]; x[6] += bflo(zz.w) * w1[2]; x[7] += bfhi(zz.w) * w1[3]; }
            u32x4 o; o.x = pk2(bflo(l2.x) * x[0], bfhi(l2.x) * x[1]); o.y = pk2(bflo(l2.y) * x[2], bfhi(l2.y) * x[3]);
            o.z = pk2(bflo(h2.x) * x[4], bfhi(h2.x) * x[5]); o.w = pk2(bflo(h2.y) * x[6], bfhi(h2.y) * x[7]);
            if (gi * NI + k < items) *(u32x4*)(G + goff[k]) = o; }
    }
#undef T2_LOAD
}

__device__ __forceinline__ void mla_thin1_phase(const int wv_, const bf16* DOWN, const float* qn, const float* kvn, bf16* CQ, bf16* CKV, const float* RSTD) {
    const int lane = TIDX & 63, wid = wv_;
    constexpr int NR = 4;
    for (int rg = blockIdx.x * NWAVES + wid; rg < NTOK / NR; rg += gridDim.x * NWAVES) {
        u32x2 va[NR][2], vb[NR][2];
#pragma unroll
        for (int r = 0; r < NR; ++r)
#pragma unroll
            for (int part = 0; part < 2; ++part) { const bf16* dp = DOWN + (size_t)(rg * NR + r) * NDOWNP + part * 512; va[r][part] = *(const u32x2*)(dp + lane * 4); vb[r][part] = *(const u32x2*)(dp + 256 + lane * 4); }
#pragma unroll
        for (int r = 0; r < NR; ++r)
#pragma unroll
            for (int part = 0; part < 2; ++part) { const int row = rg * NR + r; const float rsx = RSTD[row]; const u32x2 ua = va[r][part], ub = vb[r][part];
                const f32x4 a = (f32x4){bflo(ua.x), bfhi(ua.x), bflo(ua.y), bfhi(ua.y)} * rsx, b = (f32x4){bflo(ub.x), bfhi(ub.x), bflo(ub.y), bfhi(ub.y)} * rsx;
                float ss = a[0] * a[0] + a[1] * a[1] + a[2] * a[2] + a[3] * a[3] + b[0] * b[0] + b[1] * b[1] + b[2] * b[2] + b[3] * b[3];
                ss = wave_sum(ss); const float rs = 1.0f / sqrtf(ss * (1.0f / 512.0f) + EPS);
                const float* gn = part ? kvn : qn; const f32x4 ga = *(const f32x4*)(gn + lane * 4), gb = *(const f32x4*)(gn + 256 + lane * 4);
                bf16* o = (part ? CKV : CQ) + (size_t)row * 512;
                u32x2 oa, ob; oa.x = pk2(a[0] * rs * ga[0], a[1] * rs * ga[1]); oa.y = pk2(a[2] * rs * ga[2], a[3] * rs * ga[3]);
                ob.x = pk2(b[0] * rs * gb[0], b[1] * rs * gb[1]); ob.y = pk2(b[2] * rs * gb[2], b[3] * rs * gb[3]);
                *(u32x2*)(o + lane * 4) = oa; *(u32x2*)(o + 256 + lane * 4) = ob; }
    }
}
__device__ __forceinline__ void mla_thin2_phase(const int wv_, const bf16* QRAW, const bf16* KVRAW, const bf16* DOWN, const float* qg, const float* kg, const f32x2* ROPE, bf16* Q, bf16* K, const float* RSTD) {
    const int lane = TIDX & 63, wid = wv_, grp = lane >> 5, j = lane & 31, jc = j < 24 ? j : 23;
    const bool act = j < 24, isrope = j >= 16 && j < 24, isx2 = j >= 20;
    float qgv[8], kgv[8];
#pragma unroll
    for (int k = 0; k < 8; ++k) { qgv[k] = qg[8 * jc + k]; kgv[k] = kg[8 * jc + k]; }
    for (int row = blockIdx.x * NWAVES + wid; row < NTOK; row += gridDim.x * NWAVES) {
        const int t = row & (SEQ - 1);
        float cs[8], sn[8], kr[8];
#pragma unroll
        for (int k = 0; k < 8; ++k) { cs[k] = 1.f; sn[k] = 0.f; kr[k] = 0.f; }
        if (isrope) { const f32x4* rp = (const f32x4*)(ROPE + (size_t)t * 32 + 8 * ((j - 16) & 3));
            const f32x4 r0 = rp[0], r1 = rp[1], r2 = rp[2], r3 = rp[3];
            cs[0] = r0[0]; sn[0] = r0[1]; cs[1] = r0[2]; sn[1] = r0[3]; cs[2] = r1[0]; sn[2] = r1[1]; cs[3] = r1[2]; sn[3] = r1[3];
            cs[4] = r2[0]; sn[4] = r2[1]; cs[5] = r2[2]; sn[5] = r2[3]; cs[6] = r3[0]; sn[6] = r3[1]; cs[7] = r3[2]; sn[7] = r3[3];
            const u32x4 k0 = *(const u32x4*)(DOWN + (size_t)row * NDOWNP + 1024 + 8 * (j - 16));
            kr[0] = bflo(k0.x); kr[1] = bfhi(k0.x); kr[2] = bflo(k0.y); kr[3] = bfhi(k0.y); kr[4] = bflo(k0.z); kr[5] = bfhi(k0.z); kr[6] = bflo(k0.w); kr[7] = bfhi(k0.w);
            { const float rsx = RSTD[row];
#pragma unroll
                for (int k = 0; k < 8; ++k) kr[k] *= rsx; }
            if (!isx2) {
#pragma unroll
                for (int k = 0; k < 8; ++k) sn[k] = -sn[k]; } }
        u32x4 kx[NH / 2];
#pragma unroll
        for (int hp = 0; hp < NH / 2; ++hp) { const int h = 2 * hp + grp;
            kx[hp] = *(const u32x4*)(KVRAW + (size_t)row * 4096 + h * 256 + 8 * (j < 16 ? j : 0)); }
#pragma unroll
        for (int hp = 0; hp < NH / 2; ++hp) {
            const int h = 2 * hp + grp;
#pragma unroll
            for (int qk = 1; qk < 2; ++qk) {
                float v[8]; const u32x4 x = kx[hp];
                v[0] = bflo(x.x); v[1] = bfhi(x.x); v[2] = bflo(x.y); v[3] = bfhi(x.y); v[4] = bflo(x.z); v[5] = bfhi(x.z); v[6] = bflo(x.w); v[7] = bfhi(x.w);
                if (qk == 1 && j >= 16) {
#pragma unroll
                    for (int k = 0; k < 8; ++k) v[k] = kr[k]; }
                float ss = 0.f;
#pragma unroll
                for (int k = 0; k < 8; ++k) ss += v[k] * v[k];
                ss = act ? ss : 0.f;
                ss += __shfl_xor(ss, 1); ss += __shfl_xor(ss, 2); ss += __shfl_xor(ss, 4); ss += __shfl_xor(ss, 8); ss += __shfl_xor(ss, 16);
                const float rs = 1.0f / sqrtf(ss * (1.0f / 192.0f) + EPS);
                float o[8];
#pragma unroll
                for (int k = 0; k < 8; ++k) { const float n = v[k] * rs * (qk == 0 ? qgv[k] : kgv[k]); const float pr = __shfl_xor(n, 4); o[k] = n * cs[k] + pr * sn[k]; }
                if (act) { u32x4 w; w.x = pk2(o[0], o[1]); w.y = pk2(o[2], o[3]); w.z = pk2(o[4], o[5]); w.w = pk2(o[6], o[7]);
                    *(u32x4*)((qk == 0 ? Q : K) + (size_t)row * 3072 + h * DQK + 8 * j) = w; }
            }
        }
    }
}

namespace attn {
constexpr int KVBLK = 64, QBLK = 32;
constexpr float SCALE = 0.07216878364870322f;
constexpr float THR = 8.f;
constexpr int LDQ = 3072, LDK = 3072, LDV = 4096, LDO = 2048;
constexpr int SHM_V = KVBLK * DV * 2, SHM_K = KVBLK * DQK * 2;
#define KSWZ(row, colB) ((row) * 384 + ((colB) ^ ((((row) >> 1) & 7) << 4)))
#define SBAR() __builtin_amdgcn_sched_barrier(0)
__device__ __forceinline__ unsigned cvtpk(float lo, float hi) { unsigned r; asm volatile("v_cvt_pk_bf16_f32 %0, %1, %2" : "=v"(r) : "v"(lo), "v"(hi)); return r; }
__device__ __forceinline__ void partialSM(f32x16& p0, f32x16& p1, float& m_reg, float& mn, float& alpha) {
    constexpr float C = SCALE * 1.4426950408889634f;
    float pmax = p0[0];
#pragma unroll
    for (int r = 1; r < 16; ++r) pmax = fmaxf(pmax, p0[r]);
#pragma unroll
    for (int r = 0; r < 16; ++r) pmax = fmaxf(pmax, p1[r]);
    { auto rr = __builtin_amdgcn_permlane32_swap(__float_as_uint(pmax), __float_as_uint(pmax), false, false);
      pmax = fmaxf(__uint_as_float(rr[0]), __uint_as_float(rr[1])); }
    if (__builtin_expect(__all(pmax - m_reg <= THR / SCALE), 1)) { mn = m_reg; alpha = 1.f; }
    else { mn = fmaxf(m_reg, pmax); alpha = __builtin_amdgcn_exp2f((m_reg - mn) * C); m_reg = mn; }
    const float mnC = -mn * C;
#pragma unroll
    for (int r = 0; r < 16; ++r) p0[r] = fmaf(p0[r], C, mnC);
#pragma unroll
    for (int r = 0; r < 16; ++r) p1[r] = fmaf(p1[r], C, mnC);
#pragma unroll
    for (int r = 0; r < 16; ++r) p0[r] = __builtin_amdgcn_exp2f(p0[r]);
}
__device__ __forceinline__ void finishSM(f32x16& p0, f32x16& p1, float alpha, float& l_reg, bf16x8& pa0, bf16x8& pa1, bf16x8& pa2, bf16x8& pa3) {
#pragma unroll
    for (int r = 0; r < 16; ++r) p1[r] = __builtin_amdgcn_exp2f(p1[r]);
    float ps = 0;
#pragma unroll
    for (int r = 0; r < 16; ++r) ps += p0[r];
#pragma unroll
    for (int r = 0; r < 16; ++r) ps += p1[r];
    { auto rr = __builtin_amdgcn_permlane32_swap(__float_as_uint(ps), __float_as_uint(ps), false, false);
      ps = __uint_as_float(rr[0]) + __uint_as_float(rr[1]); }
    l_reg = l_reg * alpha + ps;
#define PK4(P, BASE, OUT) do { unsigned a0 = cvtpk(P[BASE + 0], P[BASE + 1]), a1 = cvtpk(P[BASE + 2], P[BASE + 3]);   \
    unsigned b0 = cvtpk(P[BASE + 4], P[BASE + 5]), b1 = cvtpk(P[BASE + 6], P[BASE + 7]);                              \
    auto r0 = __builtin_amdgcn_permlane32_swap(a0, b0, false, false); auto r1 = __builtin_amdgcn_permlane32_swap(a1, b1, false, false); \
    u32x4 w = {r0[0], r1[0], r0[1], r1[1]}; OUT = __builtin_bit_cast(bf16x8, w); } while (0)
    PK4(p0, 0, pa0); PK4(p0, 8, pa1); PK4(p1, 0, pa2); PK4(p1, 8, pa3);
#undef PK4
}
__device__ __forceinline__ void qkt(f32x16& p0, f32x16& p1, const LAS unsigned char* Ks, const bf16x8* qr, int r32, int hi) {
#pragma unroll
    for (int i = 0; i < 16; ++i) { p0[i] = 0.f; p1[i] = 0.f; }
#pragma unroll
    for (int d0 = 0; d0 < 12; ++d0) { const int cb = (d0 * 16 + hi * 8) * 2;
        const bf16x8 b0 = *(const LAS bf16x8*)(Ks + KSWZ(r32, cb));
        const bf16x8 b1 = *(const LAS bf16x8*)(Ks + KSWZ(32 + r32, cb));
        p0 = __builtin_amdgcn_mfma_f32_32x32x16_bf16(b0, qr[d0], p0, 0, 0, 0);
        p1 = __builtin_amdgcn_mfma_f32_32x32x16_bf16(b1, qr[d0], p1, 0, 0, 0); }
}
__device__ __forceinline__ int v_st(int k, int c) { const int kk = (k & ~0xC) | ((k & 4) << 1) | ((k & 8) >> 1); return ((kk >> 3) * 4 + (c >> 5)) * 512 + ((kk & 7) * 32 + (c & 31)) * 2; }
__device__ __forceinline__ int v_rd_base(int lane) { return ((lane & 3) << 3) | (((lane >> 2) & 3) << 6) | (((lane >> 4) & 1) << 5) | (((lane >> 5) & 1) << 8); }
constexpr int v_rd_off(int d0, int ks, int half) { return d0 * 512 + ks * 4096 + half * 2048; }
template <int OFF> __device__ __forceinline__ s16x4 tr_read(int vb) {
    s16x4 r; asm volatile("ds_read_b64_tr_b16 %0, %1 offset:%2" : "=&v"(r) : "v"(vb), "i"(OFF) : "memory"); return r;
}
template <int D0> __device__ __forceinline__ void pv_one(f32x16& od, int vb, bf16x8 pa0, bf16x8 pa1, bf16x8 pa2, bf16x8 pa3) {
    const s16x4 l0 = tr_read<v_rd_off(D0, 0, 0)>(vb), h0 = tr_read<v_rd_off(D0, 0, 1)>(vb), l1 = tr_read<v_rd_off(D0, 1, 0)>(vb), h1 = tr_read<v_rd_off(D0, 1, 1)>(vb);
    const s16x4 l2 = tr_read<v_rd_off(D0, 2, 0)>(vb), h2 = tr_read<v_rd_off(D0, 2, 1)>(vb), l3 = tr_read<v_rd_off(D0, 3, 0)>(vb), h3 = tr_read<v_rd_off(D0, 3, 1)>(vb);
    asm volatile("s_waitcnt lgkmcnt(0)" ::: "memory"); SBAR();
#define PKV(L, H) (bf16x8){L[0], L[1], L[2], L[3], H[0], H[1], H[2], H[3]}
    od = __builtin_amdgcn_mfma_f32_32x32x16_bf16(pa0, PKV(l0, h0), od, 0, 0, 0);
    od = __builtin_amdgcn_mfma_f32_32x32x16_bf16(pa1, PKV(l1, h1), od, 0, 0, 0);
    od = __builtin_amdgcn_mfma_f32_32x32x16_bf16(pa2, PKV(l2, h2), od, 0, 0, 0);
    od = __builtin_amdgcn_mfma_f32_32x32x16_bf16(pa3, PKV(l3, h3), od, 0, 0, 0);
#undef PKV
}
__device__ __forceinline__ void pv_d0(f32x16* o, int vb, bf16x8 pa0, bf16x8 pa1, bf16x8 pa2, bf16x8 pa3) {
    pv_one<0>(o[0], vb, pa0, pa1, pa2, pa3); pv_one<1>(o[1], vb, pa0, pa1, pa2, pa3); pv_one<2>(o[2], vb, pa0, pa1, pa2, pa3); pv_one<3>(o[3], vb, pa0, pa1, pa2, pa3);
}
__device__ __forceinline__ void unit(const int wv_, const bf16* __restrict__ Qb, const bf16* __restrict__ Kh, const bf16* __restrict__ Vh, bf16* __restrict__ Ob, int seq, LAS unsigned char* lds,
                                     const float* __restrict__ qg, const f32x2* __restrict__ ROPE, int t0) {
    const int tid = TIDX, wid = wv_, lane = tid & 63, r32 = lane & 31, hi = lane >> 5;
    LAS unsigned char* V_lds = lds; LAS unsigned char* K_lds = lds + 3 * SHM_V;
    LAS float* ws = (LAS float*)(lds + 3 * SHM_V + 3 * SHM_K) + wid * 64; LAS float* li_l = ws; LAS float* al_l = ws + 32;
    float m_reg = -1e30f, l_reg = 0; f32x16 o[4]; bf16x8 qr[12];
#pragma unroll
    for (int d = 0; d < 4; ++d)
#pragma unroll
        for (int r = 0; r < 16; ++r) o[d][r] = 0.f;
    const bf16* Qw = Qb + (long)(wid * QBLK + r32) * LDQ + hi * 8;
#pragma unroll
    for (int d0 = 0; d0 < 12; ++d0) qr[d0] = *(const bf16x8*)(Qw + d0 * 16);
    const int wu = wv_;
    int koff[3], voff[2];
#pragma unroll
    for (int i = 0; i < 3; ++i) { const int p = (i * 8 + wid) * 64 + lane, row = p / 24, cidx = p % 24; koff[i] = row * LDK + ((cidx ^ ((row >> 1) & 7)) * 8); }
#pragma unroll
    for (int i = 0; i < 2; ++i) { const int p = (i * 8 + wid) * 64 + lane, sub = p >> 5, q5 = p & 31, kk = (sub >> 2) * 8 + (q5 >> 2), k = (kk & ~0xC) | ((kk & 4) << 1) | ((kk & 8) >> 1), c = (sub & 3) * 32 + (q5 & 3) * 8;
        voff[i] = k * LDV + c; }
    const int vb0 = (int)(uintptr_t)V_lds + v_rd_base(lane);
#define DMA_TILE(b, k0) do { const bf16* Kt_ = Kh + (long)(k0) * LDK; const bf16* Vt_ = Vh + (long)(k0) * LDV; \
    _Pragma("unroll") for (int i = 0; i < 3; ++i) __builtin_amdgcn_global_load_lds((const GAS unsigned*)(Kt_ + koff[i]), (LAS unsigned*)(K_lds + (b) * SHM_K + (i * 8 + wu) * 1024), 16, 0, 0); \
    _Pragma("unroll") for (int i = 0; i < 2; ++i) __builtin_amdgcn_global_load_lds((const GAS unsigned*)(Vt_ + voff[i]), (LAS unsigned*)(V_lds + (b) * SHM_V + (i * 8 + wu) * 1024), 16, 0, 0); } while (0)
#define RESC(a) do { if (__any((a) < 1.f)) { if (hi == 0) al_l[r32] = (a); asm volatile("s_waitcnt lgkmcnt(0)" ::: "memory"); \
    _Pragma("unroll") for (int d = 0; d < 4; ++d) _Pragma("unroll") for (int r = 0; r < 16; ++r) o[d][r] *= al_l[crow(r, hi)]; } } while (0)
    f32x16 pA0, pA1, pB0, pB1; float mnA, mnB, alA, alB; bf16x8 pa0, pa1, pa2, pa3; const int NT = seq / KVBLK;
#define VMWAIT() asm volatile("s_waitcnt vmcnt(0)" ::: "memory")
    __syncthreads();
    DMA_TILE(0, 0);
    {
        float ss = 0.f;
#pragma unroll
        for (int d0 = 0; d0 < 12; ++d0) { const u32x4 w = __builtin_bit_cast(u32x4, qr[d0]);
            const float a0 = bflo(w.x), a1 = bfhi(w.x), a2 = bflo(w.y), a3 = bfhi(w.y), a4 = bflo(w.z), a5 = bfhi(w.z), a6 = bflo(w.w), a7 = bfhi(w.w);
            ss += a0 * a0 + a1 * a1 + a2 * a2 + a3 * a3 + a4 * a4 + a5 * a5 + a6 * a6 + a7 * a7; }
        ss += __shfl_xor(ss, 32);
        const float rs = 1.0f / sqrtf(ss * (1.0f / 192.0f) + EPS);
#pragma unroll
        for (int d0 = 0; d0 < 8; ++d0) { const u32x4 w = __builtin_bit_cast(u32x4, qr[d0]); const f32x4 g0 = *(const f32x4*)(qg + d0 * 16 + hi * 8) * rs, g1 = *(const f32x4*)(qg + d0 * 16 + hi * 8 + 4) * rs;
            u32x4 o_; o_.x = cvtpk(bflo(w.x) * g0[0], bfhi(w.x) * g0[1]); o_.y = cvtpk(bflo(w.y) * g0[2], bfhi(w.y) * g0[3]); o_.z = cvtpk(bflo(w.z) * g1[0], bfhi(w.z) * g1[1]); o_.w = cvtpk(bflo(w.w) * g1[2], bfhi(w.w) * g1[3]);
            qr[d0] = __builtin_bit_cast(bf16x8, o_); }
        const f32x2* rp = ROPE + (size_t)(t0 + wid * QBLK + r32) * 32 + hi * 8;
#pragma unroll
        for (int d0 = 8; d0 < 10; ++d0) { const u32x4 wa = __builtin_bit_cast(u32x4, qr[d0]), wb = __builtin_bit_cast(u32x4, qr[d0 + 2]);
            float a[8], b[8], oa[8], ob[8];
            a[0] = bflo(wa.x); a[1] = bfhi(wa.x); a[2] = bflo(wa.y); a[3] = bfhi(wa.y); a[4] = bflo(wa.z); a[5] = bfhi(wa.z); a[6] = bflo(wa.w); a[7] = bfhi(wa.w);
            b[0] = bflo(wb.x); b[1] = bfhi(wb.x); b[2] = bflo(wb.y); b[3] = bfhi(wb.y); b[4] = bflo(wb.z); b[5] = bfhi(wb.z); b[6] = bflo(wb.w); b[7] = bfhi(wb.w);
#pragma unroll
            for (int j4 = 0; j4 < 2; ++j4) { const f32x4 ga = *(const f32x4*)(qg + d0 * 16 + hi * 8 + 4 * j4) * rs, gb = *(const f32x4*)(qg + (d0 + 2) * 16 + hi * 8 + 4 * j4) * rs;
                const f32x4 c01 = *(const f32x4*)(rp + (d0 - 8) * 16 + 4 * j4), c23 = *(const f32x4*)(rp + (d0 - 8) * 16 + 4 * j4 + 2);
#pragma unroll
                for (int jj = 0; jj < 4; ++jj) { const int j = 4 * j4 + jj; const float cs = jj < 2 ? c01[2 * jj] : c23[2 * (jj - 2)], sn = jj < 2 ? c01[2 * jj + 1] : c23[2 * (jj - 2) + 1];
                    const float na = a[j] * ga[jj], nb = b[j] * gb[jj]; oa[j] = na * cs - nb * sn; ob[j] = nb * cs + na * sn; } }
            u32x4 pa_, pb_; pa_.x = cvtpk(oa[0], oa[1]); pa_.y = cvtpk(oa[2], oa[3]); pa_.z = cvtpk(oa[4], oa[5]); pa_.w = cvtpk(oa[6], oa[7]);
            pb_.x = cvtpk(ob[0], ob[1]); pb_.y = cvtpk(ob[2], ob[3]); pb_.z = cvtpk(ob[4], ob[5]); pb_.w = cvtpk(ob[6], ob[7]);
            qr[d0] = __builtin_bit_cast(bf16x8, pa_); qr[d0 + 2] = __builtin_bit_cast(bf16x8, pb_); }
    }
    VMWAIT(); __syncthreads();
    DMA_TILE(1, KVBLK);
    qkt(pA0, pA1, K_lds, qr, r32, hi); partialSM(pA0, pA1, m_reg, mnA, alA);
    VMWAIT(); __syncthreads();
    int bj = 1;
    for (int j = 1; j + 1 < NT; j += 2) {
        const int bp = bj == 0 ? 2 : bj - 1, bn = bj == 2 ? 0 : bj + 1, bnn = bn == 2 ? 0 : bn + 1;
        DMA_TILE(bn, (j + 1) * KVBLK);
        SBAR(); qkt(pB0, pB1, K_lds + bj * SHM_K, qr, r32, hi);
        finishSM(pA0, pA1, alA, l_reg, pa0, pa1, pa2, pa3); SBAR();
        pv_d0(o, vb0 + bp * SHM_V, pa0, pa1, pa2, pa3); partialSM(pB0, pB1, m_reg, mnB, alB);
        RESC(alB); VMWAIT(); __syncthreads();
        if (j + 2 < NT) DMA_TILE(bnn, (j + 2) * KVBLK);
        SBAR(); qkt(pA0, pA1, K_lds + bn * SHM_K, qr, r32, hi);
        finishSM(pB0, pB1, alB, l_reg, pa0, pa1, pa2, pa3); SBAR();
        pv_d0(o, vb0 + bj * SHM_V, pa0, pa1, pa2, pa3); partialSM(pA0, pA1, m_reg, mnA, alA);
        RESC(alA); VMWAIT(); __syncthreads();
        bj = bnn;
    }
    {
        const int bp = bj == 0 ? 2 : bj - 1;
        SBAR(); qkt(pB0, pB1, K_lds + bj * SHM_K, qr, r32, hi);
        finishSM(pA0, pA1, alA, l_reg, pa0, pa1, pa2, pa3); SBAR();
        pv_d0(o, vb0 + bp * SHM_V, pa0, pa1, pa2, pa3); partialSM(pB0, pB1, m_reg, mnB, alB);
        RESC(alB);
        finishSM(pB0, pB1, alB, l_reg, pa0, pa1, pa2, pa3); SBAR();
        pv_d0(o, vb0 + bj * SHM_V, pa0, pa1, pa2, pa3);
    }
#undef VMWAIT
    if (hi == 0) li_l[r32] = l_reg; asm volatile("s_waitcnt lgkmcnt(0)" ::: "memory");
    float rli[16];
#pragma unroll
    for (int r = 0; r < 16; ++r) rli[r] = __builtin_amdgcn_rcpf(li_l[crow(r, hi)]);
    bf16* Ow = Ob + (long)(wid * QBLK) * LDO;
#pragma unroll
    for (int r = 0; r < 16; ++r) { const int orow = crow(r, hi);
#pragma unroll
        for (int d0 = 0; d0 < 4; ++d0) Ow[(long)orow * LDO + d0 * 32 + r32] = (bf16)f2bf(o[d0][r] * rli[r]); }
#undef DMA_TILE
#undef RESC
}
}
__device__ __forceinline__ void attn_phase(const int wv_, const bf16* Q, const bf16* K, const bf16* KVRAW, bf16* O, LAS unsigned char* lds, const float* qg, const f32x2* ROPE) {
    const int G = gridDim.x, bx = blockIdx.x; const int vcu = (G % 8 == 0) ? (bx % 8) * (G / 8) + bx / 8 : bx;
    const int units = NBATCH * NH * (SEQ / 256);
    for (int u = vcu; u < units; u += G) {
        const int qb = u % 16, h = (u / 16) % NH, b = u / (16 * NH);
        const size_t row0 = (size_t)b * SEQ;
        attn::unit(wv_, Q + (row0 + qb * 256) * 3072 + h * DQK, K + row0 * 3072 + h * DQK, KVRAW + row0 * 4096 + h * 256 + 128, O + (row0 + qb * 256) * DM + h * DV, SEQ, lds, qg, ROPE, qb * 256);
    }
}

__device__ __forceinline__ void final_phase(const int wv_, float* X, const bf16* ym) {
    const size_t total = (size_t)NTOK * (DM / 4), stride = (size_t)gridDim.x * NTHREADS;
    for (size_t i0 = (size_t)blockIdx.x * NTHREADS + TIDX; i0 < total; i0 += 4 * stride) {
        f32x4 x[4]; u32x2 a[4];
#pragma unroll
        for (int k = 0; k < 4; ++k) { const size_t i = i0 + k * stride; if (i < total) { const size_t row = i / (DM / 4); const int col = (int)(i % (DM / 4)) * 4;
            x[k] = *(const f32x4*)(X + row * DM + col); a[k] = *(const u32x2*)(ym + row * DM + col); } }
#pragma unroll
        for (int k = 0; k < 4; ++k) { const size_t i = i0 + k * stride; if (i < total) { const size_t row = i / (DM / 4); const int col = (int)(i % (DM / 4)) * 4; f32x4 v = x[k];
            v[0] += bflo(a[k].x); v[1] += bfhi(a[k].x); v[2] += bflo(a[k].y); v[3] += bfhi(a[k].y);
            *(f32x4*)(X + row * DM + col) = v; } }
    }
}

struct Args { const float* in[31]; float* out; unsigned char* ws; int ph_lo, ph_hi; };
enum Phase { P_PRO = 0,
    P0_G1, P0_TH, P0_G2, P0_NR, P0_UP, P0_DN,
    P1_G1, P1_T1, P1_LC, P1_T2, P1_G2, P1_NR, P1_UP, P1_DN,
    P2_GD, P2_T1, P2_GU, P2_T2, P2_AT, P2_GO, P2_NR, P2_UP, P2_DN,
    P3_G1, P3_TH, P3_G2, P3_NR, P3_UP, P3_DN,
    N_PHASES };

__device__ __forceinline__ const float* kernarg_ptr(int i) {
    const unsigned long long v = ((volatile const __attribute__((address_space(4))) unsigned long long*)__builtin_amdgcn_kernarg_segment_ptr())[i];
    return (const float*)(const GAS float*)v;
}
#define INP(i) kernarg_ptr(i)
__global__ void __launch_bounds__(NTHREADS, 2) fwd(Args a) {
    extern __shared__ __attribute__((aligned(16))) unsigned char lds_raw[];
    LAS unsigned char* lds = (LAS unsigned char*)lds_raw;
    const int wv_ = __builtin_amdgcn_readfirstlane((int)threadIdx.x >> 6);
    volatile LAS unsigned* MISC = (volatile LAS unsigned*)(lds + MISC_OFF);
    const int tid = TIDX, lane = tid & 63, wid = wv_;
    unsigned char* ws = (unsigned char*)INP(32);
    unsigned* ctl = (unsigned*)(ws + WS_CTL);
    for (int u = tid; u < (LDS_BYTES - SCR_BYTES) / 4; u += NTHREADS) ((LAS unsigned*)(lds + SCR_BYTES))[u] = 0u;
    __syncthreads();
    XcdBarrier bar = xcd_barrier_post(wv_, ctl + CW_BAR, MISC + 8);
    const int lo = a.ph_lo, hi = a.ph_hi;
#ifndef ONLY_PHASE
#define ONLY_PHASE -1
#endif
#define IN(k) ((ONLY_PHASE < 0 || ONLY_PHASE == (k)) && lo <= (k) && (k) < hi)
#define SEAM(k) do { if (IN(k) && IN((k) + 1)) xcd_barrier(wv_, bar); } while (0)
#define x_in INP(0)
#define X ((float*)INP(31))
#define SCIN ((bf16*)(ws + WS_SCIN))
#define SCOUT ((bf16*)(ws + WS_SCOUT))
#define HYIN ((bf16*)(ws + WS_HYIN))
#define HYOUT ((bf16*)(ws + WS_HYOUT))
#define MDOWN ((bf16*)(ws + WS_MDOWN))
#define MUQ ((bf16*)(ws + WS_MUQ))
#define MUKV ((bf16*)(ws + WS_MUKV))
#define MWO ((bf16*)(ws + WS_MWO))
#define MOEUP ((bf16*)(ws + WS_MOEUP))
#define MOEDN ((bf16*)(ws + WS_MOEDN))
#define KERN ((bf16*)(ws + WS_KERN))
#define H ((bf16*)(ws + WS_H))
#define BIG ((bf16*)(ws + WS_BIG))
#define KVRAW ((bf16*)(ws + WS_KVRAW))
#define YB ((bf16*)(ws + WS_YB))
#define X0 ((bf16*)(ws + WS_X0))
#define VT ((bf16*)(ws + WS_VT))
#define YST ((bf16*)(ws + WS_YST))
#define DOWN ((bf16*)(ws + WS_DOWN))
#define CQ ((bf16*)(ws + WS_CQ))
#define CKV ((bf16*)(ws + WS_CKV))
#define QBUF ((bf16*)(ws + WS_Q))
#define KBUF ((bf16*)(ws + WS_K))
#define LIST ((unsigned*)(ws + WS_LIST))
#define GATE ((float*)(ws + WS_GATE))
#define ACT ((bf16*)(ws + WS_ACT))
#define YM ((bf16*)(ws + WS_YM))
#define RSTDB ((float*)(ws + WS_RSTD))
#define WRS ((bf16*)(ws + WS_WRS))
#define ROPEB ((f32x2*)(ws + WS_ROPE))
#define RECB ((u32x4*)(ws + WS_REC))
#define XS H
#define PARTB ((float*)(ws + WS_YM))
#define ACT2 BIG
#define TOKOF ((unsigned*)(ws + WS_ACT))

    if (IN(P_PRO)) {
        LAS float* scr = (LAS float*)(lds + wid * 16384);
        const int gw = blockIdx.x * NWAVES + wid, NGW = gridDim.x * NWAVES;
        cvt_mats<3, true>(INP(3), 2, DM, 3 * DM, 3 * DM, SCIN, scr, gw, NGW, lane, INP(1), 3 * DM);
        cvt_mats<0>(INP(5), 2, DM, DM, DM, SCOUT, scr, gw, NGW, lane);
        cvt_mats<0, true>(INP(6), 1, DM, 3 * DM, 3 * DM, HYIN, scr, gw, NGW, lane, INP(1) + 1 * DM, 0);
        cvt_mats<0>(INP(16), 1, DM, DM, DM, HYOUT, scr, gw, NGW, lane);
        cvt_mats<0, true>(INP(17), 1, DM, NDOWN, NDOWNP, MDOWN, scr, gw, NGW, lane, INP(1) + 2 * DM, 0);
        cvt_mats<0>(INP(20), 1, QRANK, NH * DQK, NH * DQK, MUQ, scr, gw, NGW, lane);
        cvt_mats<0>(INP(21), 1, KVRANK, NH * 256, NH * 256, MUKV, scr, gw, NGW, lane);
        cvt_mats<0>(INP(24), 1, DM, DM, DM, MWO, scr, gw, NGW, lane);
        cvt_mats<2, true>(INP(29), NEXP, DM, 2 * DFF, 2 * DFF, MOEUP, scr, gw, NGW, lane, INP(2), 0);
        cvt_mats<0>(INP(30), NEXP, DFF, DM, DM, MOEDN, scr, gw, NGW, lane);
        for (int i = blockIdx.x * NTHREADS + tid; i < 4 * 48 * DM; i += gridDim.x * NTHREADS) {
            const int d = i % DM, e = (i / DM) % 48, l = i / (DM * 48);
            float w = e < 8 ? INP(25)[((size_t)l * DM + d) * 8 + e] : (e < 40 ? INP(27)[((size_t)l * DM + d) * 32 + (e - 8)] : 0.f);
            w *= INP(2)[l * DM + d];
            const unsigned wh = f2bf(w); const float wr = w - __builtin_bit_cast(float, wh << 16);
            WRS[((size_t)(l * 2 + 0) * 48 + e) * DM + d] = (bf16)wh; WRS[((size_t)(l * 2 + 1) * 48 + e) * DM + d] = (bf16)f2bf(wr);
        }
        for (int i = blockIdx.x * NTHREADS + tid; i < SEQ * 32; i += gridDim.x * NTHREADS) { const int t = i >> 5, ii = i & 31;
            const float inv = exp2f(-(float)(2 * ii) * (13.287712379549449f / 64.0f)); float sn_, cs_; sincosf((float)t * inv, &sn_, &cs_); ROPEB[i] = (f32x2){cs_, sn_}; }
        __syncthreads();
        filter_phase(wv_, INP(9), INP(10), INP(11), INP(12), INP(13), INP(14), KERN, lds);
        __syncthreads();
        x0_phase(wv_, x_in, XS, RSTDB);
    }
    SEAM(P_PRO);

#define MOE_BLOCK(P, L) \
    if (IN(P)) router_phase(wv_, XS, WRS + (size_t)(L) * 2 * 48 * DM, INP(26) + (L) * 8, INP(28) + (L) * 32, ctl + CW_CNT + (L) * 2048, ctl + CW_CNTB + (L) * 4096, LIST, RECB, lds); \
    SEAM(P); \
    if (IN((P) + 1)) moe_up_phase256(wv_, lds, XS, RECB, MOEUP + (size_t)(L) * NEXP * 1024 * DM, ctl + CW_CNT + (L) * 2048, ctl + CW_CNTB + (L) * 4096, LIST, ACT2, TOKOF, \
        (L) < 3 ? INP(29) + (size_t)((L) + 1) * NEXP * DM * 2 * DFF : nullptr, (L) < 3 ? INP(30) + (size_t)((L) + 1) * NEXP * DFF * DM : nullptr, \
        MOEUP + (size_t)((L) + 1) * NEXP * 1024 * DM, MOEDN + (size_t)((L) + 1) * NEXP * DM * DFF, INP(2) + ((L) + 1) * DM); \
    SEAM((P) + 1); \
    if (IN((P) + 2)) moe_down_phase256<((L) < 3)>(wv_, lds, ACT2, MOEDN + (size_t)(L) * NEXP * DM * DFF, ctl + CW_CNT + (L) * 2048, ctl + CW_CNTB + (L) * 4096, TOKOF, XS, X, PARTB); \
    SEAM((P) + 2);

    if (IN(P0_G1)) gemm_dense256<pg8::EpiSC, true>(wv_, lds, XS, SCIN, NTOK, 3 * DM, DM, pg8::EpiSC{BIG, BIG + (size_t)NTOK * DM});
    SEAM(P0_G1);
    if (IN(P0_TH)) sc_thin_phase<true>(wv_, BIG, BIG + (size_t)NTOK * DM, INP(4), YB, RSTDB);
    SEAM(P0_TH);
    if (IN(P0_G2)) gemm_dense256<pg8::EpiRes, true>(wv_, lds, YB, SCOUT, NTOK, DM, DM, pg8::EpiRes{XS, XS});
    SEAM(P0_G2);
    MOE_BLOCK(P0_NR, 0)
    if (IN(P1_G1)) { rstd_prepass(wv_, PARTB, RSTDB); gemm_dense256<pg8::EpiBf16, true>(wv_, lds, XS, HYIN, NTOK, 3 * DM, DM, pg8::EpiBf16{BIG, 3 * DM}); }
    SEAM(P1_G1);
    if (IN(P1_T1)) hy_thin1_phase(wv_, BIG, INP(7), INP(8), X0, VT, lds, RSTDB);
    SEAM(P1_T1);
    if (IN(P1_LC)) longconv_phase(wv_, KERN, VT, INP(15), YST, lds);
    SEAM(P1_LC);
    if (IN(P1_T2)) hy_thin2_phase(wv_, YST, BIG, INP(7), INP(8), RSTDB, YB, lds);
    SEAM(P1_T2);
    if (IN(P1_G2)) gemm_dense256<pg8::EpiRes, true>(wv_, lds, YB, HYOUT, NTOK, DM, DM, pg8::EpiRes{XS, XS});
    SEAM(P1_G2);
    MOE_BLOCK(P1_NR, 1)
    if (IN(P2_GD)) { rstd_prepass(wv_, PARTB, RSTDB); gemm_dense256<pg8::EpiBf16, true>(wv_, lds, XS, MDOWN, NTOK, NDOWNP, DM, pg8::EpiBf16{DOWN, NDOWNP}); }
    SEAM(P2_GD);
    if (IN(P2_T1)) mla_thin1_phase(wv_, DOWN, INP(18), INP(19), CQ, CKV, RSTDB);
    SEAM(P2_T1);
    if (IN(P2_GU)) { gemm_dense256<pg8::EpiBf16, true>(wv_, lds, CQ, MUQ, NTOK, NH * DQK, QRANK, pg8::EpiBf16{BIG, NH * DQK}); gemm_dense256<pg8::EpiBf16, true>(wv_, lds, CKV, MUKV, NTOK, NH * 256, KVRANK, pg8::EpiBf16{KVRAW, NH * 256}); }
    SEAM(P2_GU);
    if (IN(P2_T2)) mla_thin2_phase(wv_, BIG, KVRAW, DOWN, INP(22), INP(23), ROPEB, QBUF, KBUF, RSTDB);
    SEAM(P2_T2);
    if (IN(P2_AT)) attn_phase(wv_, BIG, KBUF, KVRAW, YB, lds, INP(22), ROPEB);
    SEAM(P2_AT);
    if (IN(P2_GO)) gemm_dense256<pg8::EpiRes, true>(wv_, lds, YB, MWO, NTOK, DM, DM, pg8::EpiRes{XS, XS});
    SEAM(P2_GO);
    MOE_BLOCK(P2_NR, 2)
    if (IN(P3_G1)) { rstd_prepass(wv_, PARTB, RSTDB); gemm_dense256<pg8::EpiSC, true>(wv_, lds, XS, SCIN + (size_t)3 * DM * DM, NTOK, 3 * DM, DM, pg8::EpiSC{BIG, BIG + (size_t)NTOK * DM}); }
    SEAM(P3_G1);
    if (IN(P3_TH)) sc_thin_phase<true>(wv_, BIG, BIG + (size_t)NTOK * DM, INP(4) + 3 * DM, YB, RSTDB);
    SEAM(P3_TH);
    if (IN(P3_G2)) gemm_dense256<pg8::EpiRes, true>(wv_, lds, YB, SCOUT + (size_t)DM * DM, NTOK, DM, DM, pg8::EpiRes{XS, XS});
    SEAM(P3_G2);
    MOE_BLOCK(P3_NR, 3)
}

#ifndef N_LAUNCHES
#define N_LAUNCHES 1
#endif
extern "C" void kernel_launch(void* const* d_in, const int* in_sizes, int n_in, void* d_out, int out_size, void* d_ws, size_t ws_size, hipStream_t stream) {
    static int grid = 0;
    if (grid == 0) {
        if (n_in != 31 || out_size != NTOK * DM || ws_size < WS_END) { fprintf(stderr, "kernel_launch: bad shapes n_in %d out %d ws %zu (need %zu)\n", n_in, out_size, ws_size, (size_t)WS_END); grid = -1; return; }
        int dev = 0, cus = 0, per_cu = 0;
        if (hipGetDevice(&dev) != hipSuccess || hipDeviceGetAttribute(&cus, hipDeviceAttributeMultiprocessorCount, dev) != hipSuccess) { grid = -1; return; }
        if (hipFuncSetAttribute((const void*)fwd, hipFuncAttributeMaxDynamicSharedMemorySize, LDS_BYTES) != hipSuccess) { fprintf(stderr, "kernel_launch: hipFuncSetAttribute failed\n"); grid = -1; return; }
        if (hipOccupancyMaxActiveBlocksPerMultiprocessor(&per_cu, (const void*)fwd, NTHREADS, LDS_BYTES) != hipSuccess || per_cu < 1) fprintf(stderr, "kernel_launch: occupancy query says %d\n", per_cu);
        (void)hipGetLastError();
        grid = cus;
    }
    if (grid < 0) return;
    if (hipMemsetAsync((char*)d_ws + WS_CTL, 0, CTL_ZERO_BYTES, stream) != hipSuccess) return;
    Args a{};
    for (int i = 0; i < 31; ++i) a.in[i] = (const float*)d_in[i];
    a.out = (float*)d_out; a.ws = (unsigned char*)d_ws;
#if N_LAUNCHES == 1
    a.ph_lo = 0; a.ph_hi = N_PHASES;
    hipLaunchKernelGGL(fwd, dim3(grid), dim3(NTHREADS), LDS_BYTES, stream, a);
#else
    for (int p = 0; p < N_PHASES; ++p) { a.ph_lo = p; a.ph_hi = p + 1; hipLaunchKernelGGL(fwd, dim3(grid), dim3(NTHREADS), LDS_BYTES, stream, a); }
#endif
#ifdef PROBE_LO
    hipMemsetAsync((char*)d_ws + WS_CTL + CW_BAR * 4, 0, XCD_BAR_WORDS * 4, stream);
    a.ph_lo = PROBE_LO; a.ph_hi = PROBE_HI;
    hipLaunchKernelGGL(fwd, dim3(grid), dim3(NTHREADS), LDS_BYTES, stream, a);
#endif
    const hipError_t le = hipPeekAtLastError();
    if (le != hipSuccess) fprintf(stderr, "kernel_launch: launch failed: %s\n", hipGetErrorName(le));
}
```
